# Optimizing an MI355X kernel written in HIP

```python
import math
import jax, jax.numpy as jnp
from jax import lax
import numpy as np

D_MODEL = 1024
BATCH = 16
SEQ = 256
DEPTH = 4
DEC_BATCH = 2
DEC_SEQ = 4096
PAST_LEN = 256

GRID_W = 64
D_MIX = D_MODEL
BR = D_MIX // 4
POOL_WINDOWS = (2, 4, 8, 16)
POOL_GROUPS = len(POOL_WINDOWS)
POOL_GD = BR // POOL_GROUPS
DN_HEADS = 4
DN_HEAD_DIM = BR // DN_HEADS
CONV_K = 5
CHUNK = 64
S5_P = 16
S5_G = BR // S5_P
S5_N = 64
FT_HEADS = 4
FT_HD = BR // FT_HEADS
SPLIT_SIZES = (BR, BR, 3 * BR, BR, 2 * DN_HEADS, 2 * DN_HEADS, BR, BR, BR, BR)
D_IN_PROJ = sum(SPLIT_SIZES)
EPS = 1e-6
F32 = jnp.float32

kernel_name = 'hybrid_pool_deltanet_s5_fourier_diffusion_step'


def rmsnorm(x, g):
    x32 = x.astype(F32)
    return x32 * lax.rsqrt(jnp.mean(x32 * x32, axis=-1, keepdims=True) + EPS) * g


def l2norm(x):
    return x * lax.rsqrt(jnp.sum(x * x, axis=-1, keepdims=True) + EPS)


def box_mean(x, w, axis):
    L = x.shape[axis]
    pos = np.arange(L)
    lo = np.clip(pos - w // 2, 0, L)
    hi = np.clip(pos - w // 2 + w, 0, L)
    pad = [(0, 0)] * x.ndim
    pad[axis] = (1, 0)
    cs = jnp.pad(jnp.cumsum(x, axis=axis), pad)
    cnt_shape = [1] * x.ndim
    cnt_shape[axis] = L
    cnt = (hi - lo).astype(np.float32).reshape(cnt_shape)
    return (jnp.take(cs, hi, axis=axis) - jnp.take(cs, lo, axis=axis)) / cnt


def pool_branch(u, pool_w, pool_scale, rows):
    B, T, _ = u.shape
    outs = []
    for gi, w in enumerate(POOL_WINDOWS):
        ug = u[..., gi * POOL_GD:(gi + 1) * POOL_GD]
        if rows is None:
            pooled = box_mean(ug, w, 1)
        else:
            ug2 = ug.reshape(B, rows, GRID_W, POOL_GD)
            pooled = box_mean(box_mean(ug2, w, 1), w, 2).reshape(B, T, POOL_GD)
        outs.append(pooled - ug)
    p = jnp.stack(outs, axis=2)
    p = jnp.einsum('btgc,gcd->btgd', p, pool_w).reshape(B, T, BR)
    return p * pool_scale


def short_conv(u, w):
    C = u.shape[-1]
    return lax.conv_general_dilated(
        u, w.astype(u.dtype)[:, None, :], window_strides=(1,),
        padding=[(CONV_K // 2, CONV_K // 2)],
        dimension_numbers=('NWC', 'WIO', 'NWC'), feature_group_count=C)


def gated_delta_chunked(q, k, v, g, beta, s0):
    B, T, H, DK = q.shape
    DV = v.shape[-1]
    n = T // CHUNK

    def chunks(a):
        a = a.reshape((B, n, CHUNK, H) + a.shape[3:])
        return jnp.moveaxis(a, (1, 3), (0, 2))

    qc = chunks(q) * (DK ** -0.5)
    kc = chunks(k)
    vc = chunks(v)
    bc = chunks(beta)
    gc = jnp.cumsum(chunks(g), axis=-1)
    incl = np.tril(np.ones((CHUNK, CHUNK), dtype=bool))
    strict = np.tril(np.ones((CHUNK, CHUNK), dtype=bool), -1)
    diff = gc[..., :, None] - gc[..., None, :]
    decay = jnp.where(incl, jnp.exp(jnp.where(incl, diff, 0.0)), 0.0)
    kk = jnp.einsum('nbhik,nbhjk->nbhij', kc, kc)
    a_mat = jnp.where(strict, kk * decay * bc[..., :, None], 0.0)
    rhs = jnp.concatenate([kc * (bc * jnp.exp(gc))[..., None], vc * bc[..., None]], axis=-1)
    sol = lax.linalg.triangular_solve(a_mat, rhs, left_side=True, lower=True, unit_diagonal=True)
    w_c, u_c = sol[..., :DK], sol[..., DK:]
    aqk = jnp.where(incl, jnp.einsum('nbhik,nbhjk->nbhij', qc, kc) * decay, 0.0)

    def step(S, xs):
        q_i, k_i, w_i, u_i, g_i, a_i = xs
        v_new = u_i - jnp.einsum('bhck,bhkv->bhcv', w_i, S)
        o = (jnp.einsum('bhck,bhkv->bhcv', q_i * jnp.exp(g_i)[..., None], S)
             + jnp.einsum('bhij,bhjv->bhiv', a_i, v_new))
        g_last = g_i[..., -1:]
        S = (S * jnp.exp(g_last)[..., None]
             + jnp.einsum('bhck,bhcv->bhkv', k_i * jnp.exp(g_last - g_i)[..., None], v_new))
        return S, o

    s_fin, o = lax.scan(step, s0, (qc, kc, w_c, u_c, gc, aqk))
    o = jnp.moveaxis(o, (0, 2), (1, 3)).reshape(B, T, H, DV)
    return o, s_fin


def delta_branch(qkv, b_raw, a_raw, lp, s0):
    B, T, _ = qkv.shape
    qkv = jax.nn.silu(short_conv(qkv, lp['dn_conv']))
    q, k, v = jnp.split(qkv, 3, axis=-1)
    shp = (B, T, DN_HEADS, DN_HEAD_DIM)
    q = l2norm(q.reshape(shp))
    k = l2norm(k.reshape(shp))
    v = v.reshape(shp)
    beta = jax.nn.sigmoid(b_raw).reshape(B, T, 2, DN_HEADS)
    g = -jnp.exp(lp['dn_a_log']) * jax.nn.softplus(a_raw.reshape(B, T, 2, DN_HEADS) + lp['dn_dt_bias'])
    o_f, s_f = gated_delta_chunked(q, k, v, g[:, :, 0], beta[:, :, 0], s0[:, 0])
    rev = lambda a: jnp.flip(a, axis=1)
    o_b, s_b = gated_delta_chunked(rev(q), rev(k), rev(v), rev(g[:, :, 1]), rev(beta[:, :, 1]), s0[:, 1])
    o = rmsnorm(o_f + rev(o_b), lp['dn_norm_g']).reshape(B, T, BR)
    return o, jnp.stack([s_f, s_b], axis=1)


def s5_scan(u, a_re, a_im, log_dt, b_re, b_im, c_re, c_im, s0_re, s0_im, reverse):
    dt = jnp.exp(log_dt)[:, None]
    mag = jnp.exp(a_re * dt)
    ab_re = mag * jnp.cos(a_im * dt)
    ab_im = mag * jnp.sin(a_im * dt)
    den = a_re * a_re + a_im * a_im
    nr = ab_re - 1.0
    coef_re = (nr * a_re + ab_im * a_im) / den
    coef_im = (ab_im * a_re - nr * a_im) / den
    bb_re = coef_re[..., None] * b_re - coef_im[..., None] * b_im
    bb_im = coef_re[..., None] * b_im + coef_im[..., None] * b_re
    bu_re = jnp.einsum('btgp,gnp->btgn', u, bb_re)
    bu_im = jnp.einsum('btgp,gnp->btgn', u, bb_im)
    if reverse:
        bu_re = jnp.flip(bu_re, axis=1)
        bu_im = jnp.flip(bu_im, axis=1)
    bu_re = bu_re.at[:, 0].add(ab_re * s0_re - ab_im * s0_im)
    bu_im = bu_im.at[:, 0].add(ab_re * s0_im + ab_im * s0_re)
    a_seq_re = jnp.broadcast_to(ab_re, bu_re.shape)
    a_seq_im = jnp.broadcast_to(ab_im, bu_im.shape)

    def combine(e1, e2):
        a1r, a1i, b1r, b1i = e1
        a2r, a2i, b2r, b2i = e2
        return (a2r * a1r - a2i * a1i, a2r * a1i + a2i * a1r,
                a2r * b1r - a2i * b1i + b2r, a2r * b1i + a2i * b1r + b2i)

    _, _, s_re, s_im = lax.associative_scan(combine, (a_seq_re, a_seq_im, bu_re, bu_im), axis=1)
    fin = (s_re[:, -1], s_im[:, -1])
    if reverse:
        s_re = jnp.flip(s_re, axis=1)
        s_im = jnp.flip(s_im, axis=1)
    y = jnp.einsum('btgn,gpn->btgp', s_re, c_re) - jnp.einsum('btgn,gpn->btgp', s_im, c_im)
    return y, fin


def s5_branch(u, lp, s0):
    B, T, _ = u.shape
    ug = u.reshape(B, T, S5_G, S5_P)
    ys, fins = [], []
    for d in range(2):
        y_d, fin_d = s5_scan(ug, lp['s5_a_re'][d], lp['s5_a_im'][d], lp['s5_log_dt'][d],
                             lp['s5_b_re'][d], lp['s5_b_im'][d], lp['s5_c_re'][d], lp['s5_c_im'][d],
                             s0[:, d, 0], s0[:, d, 1], reverse=(d == 1))
        ys.append(y_d)
        fins.append(jnp.stack(fin_d, axis=1))
    y = ys[0] + ys[1] + lp['s5_d'].reshape(S5_G, S5_P) * ug
    y = jax.nn.gelu(y.reshape(B, T, BR))
    y = y * jax.nn.sigmoid(y @ lp['s5_glu_w'] + lp['s5_glu_b'])
    return y, jnp.stack(fins, axis=1)


def fourier_branch(u):
    B, T, _ = u.shape
    f = jnp.fft.fftn(u.reshape(B, T, FT_HEADS, FT_HD), axes=(1, 3), norm='ortho').real
    return f.reshape(B, T, BR)


def trunk_layer(x, cond, lp, s_dn0, s_s50, rows):
    B = x.shape[0]
    if s_dn0 is None:
        s_dn0 = jnp.zeros((B, 2, DN_HEADS, DN_HEAD_DIM, DN_HEAD_DIM), F32)
        s_s50 = jnp.zeros((B, 2, 2, S5_G, S5_N), F32)
    ada = jax.nn.silu(cond) @ lp['w_ada'] + lp['b_ada']
    shift, scale, gate = jnp.split(ada[:, None, :], 3, axis=-1)
    h = rmsnorm(x, lp['norm_g']) * (1.0 + scale) + shift
    idx = [int(i) for i in np.cumsum(SPLIT_SIZES)[:-1]]
    pool_u, pool_z, dn_qkv, dn_z, dn_b, dn_a, s5_u, s5_z, ft_u, ft_z = jnp.split(h @ lp['w_in'], idx, axis=-1)
    y_pool = pool_branch(pool_u, lp['pool_w'], lp['pool_scale'], rows) * jax.nn.silu(pool_z)
    y_dn, st_dn = delta_branch(dn_qkv, dn_b, dn_a, lp, s_dn0)
    y_dn = y_dn * jax.nn.silu(dn_z)
    y_s5, st_s5 = s5_branch(s5_u, lp, s_s50)
    y_s5 = y_s5 * jax.nn.silu(s5_z)
    y_ft = (fourier_branch(ft_u) @ lp['ft_w']) * jax.nn.silu(ft_z)
    y = jnp.concatenate([y_pool, y_dn, y_s5, y_ft], axis=-1) @ lp['w_out']
    return x + gate * y, st_dn, st_s5


def setup_inputs(seed: int = 0) -> dict:
    key = jax.random.key(seed)
    ks = iter(jax.random.split(key, 40))
    nrm = lambda shape, s: jax.random.normal(next(ks), shape, jnp.float32) * s
    uni = lambda shape, lo, hi: jax.random.uniform(next(ks), shape, jnp.float32, minval=lo, maxval=hi)
    L = DEPTH
    x_prompt = nrm((BATCH, SEQ, D_MODEL), 1.0)
    x_sample = nrm((DEC_BATCH, DEC_SEQ, D_MODEL), 1.0)
    c = nrm((DEC_BATCH, D_MODEL), 1.0)
    state_delta = nrm((DEC_BATCH, DEPTH, 2, DN_HEADS, DN_HEAD_DIM, DN_HEAD_DIM), 0.1)
    state_s5 = nrm((DEC_BATCH, DEPTH, 2, 2, S5_G, S5_N), 0.3)
    c_ctx = nrm((D_MODEL,), 1.0)
    w_ada = nrm((L, D_MODEL, 3 * D_MODEL), 0.2 * D_MODEL ** -0.5)
    b_ada = nrm((L, 3 * D_MODEL), 0.02)
    norm_g = 1.0 + nrm((L, D_MODEL), 0.02)
    w_in = nrm((L, D_MODEL, D_IN_PROJ), D_MODEL ** -0.5)
    pool_w = nrm((L, POOL_GROUPS, POOL_GD, POOL_GD), POOL_GD ** -0.5)
    pool_scale = 1.0 + nrm((L, BR), 0.02)
    dn_conv = nrm((L, CONV_K, 3 * BR), CONV_K ** -0.5)
    dn_a_log = jnp.log(uni((L, 2, DN_HEADS), 1.0, 16.0))
    dn_dt = jnp.exp(uni((L, 2, DN_HEADS), math.log(1e-3), math.log(1e-1)))
    dn_dt_bias = dn_dt + jnp.log(-jnp.expm1(-dn_dt))
    dn_norm_g = 1.0 + nrm((L, DN_HEAD_DIM), 0.02)
    s5_a_re = -0.5 + nrm((L, 2, S5_G, S5_N), 0.01)
    s5_a_im = math.pi * jnp.arange(S5_N, dtype=jnp.float32) + nrm((L, 2, S5_G, S5_N), 0.01)
    s5_log_dt = uni((L, 2, S5_G), math.log(1e-3), math.log(1e-1))
    s5_b_re = nrm((L, 2, S5_G, S5_N, S5_P), (2 * S5_P) ** -0.5)
    s5_b_im = nrm((L, 2, S5_G, S5_N, S5_P), (2 * S5_P) ** -0.5)
    s5_c_re = nrm((L, 2, S5_G, S5_P, S5_N), (2 * S5_N) ** -0.5)
    s5_c_im = nrm((L, 2, S5_G, S5_P, S5_N), (2 * S5_N) ** -0.5)
    s5_d = nrm((L, BR), 1.0)
    s5_glu_w = nrm((L, BR, BR), BR ** -0.5)
    s5_glu_b = nrm((L, BR), 0.02)
    ft_w = nrm((L, BR, BR), BR ** -0.5)
    w_out = nrm((L, D_MIX, D_MODEL), D_MIX ** -0.5)
    final_g = 1.0 + nrm((D_MODEL,), 0.02)
    return {'x_prompt': x_prompt, 'x_sample': x_sample, 'c': c,
            'state_delta': state_delta, 'state_s5': state_s5, 'c_ctx': c_ctx,
            'w_ada': w_ada, 'b_ada': b_ada, 'norm_g': norm_g, 'w_in': w_in,
            'pool_w': pool_w, 'pool_scale': pool_scale,
            'dn_conv': dn_conv, 'dn_a_log': dn_a_log, 'dn_dt_bias': dn_dt_bias, 'dn_norm_g': dn_norm_g,
            's5_a_re': s5_a_re, 's5_a_im': s5_a_im, 's5_log_dt': s5_log_dt,
            's5_b_re': s5_b_re, 's5_b_im': s5_b_im, 's5_c_re': s5_c_re, 's5_c_im': s5_c_im,
            's5_d': s5_d, 's5_glu_w': s5_glu_w, 's5_glu_b': s5_glu_b,
            'ft_w': ft_w, 'w_out': w_out, 'final_g': final_g}


def reference(x_prompt, x_sample, c, state_delta, state_s5, c_ctx, w_ada, b_ada, norm_g, w_in,
              pool_w, pool_scale, dn_conv, dn_a_log, dn_dt_bias, dn_norm_g,
              s5_a_re, s5_a_im, s5_log_dt, s5_b_re, s5_b_im, s5_c_re, s5_c_im,
              s5_d, s5_glu_w, s5_glu_b, ft_w, w_out, final_g):
    params = {'w_ada': w_ada, 'b_ada': b_ada, 'norm_g': norm_g, 'w_in': w_in,
              'pool_w': pool_w, 'pool_scale': pool_scale,
              'dn_conv': dn_conv, 'dn_a_log': dn_a_log, 'dn_dt_bias': dn_dt_bias, 'dn_norm_g': dn_norm_g,
              's5_a_re': s5_a_re, 's5_a_im': s5_a_im, 's5_log_dt': s5_log_dt,
              's5_b_re': s5_b_re, 's5_b_im': s5_b_im, 's5_c_re': s5_c_re, 's5_c_im': s5_c_im,
              's5_d': s5_d, 's5_glu_w': s5_glu_w, 's5_glu_b': s5_glu_b,
              'ft_w': ft_w, 'w_out': w_out}
    xp = x_prompt.astype(F32)
    xs = x_sample.astype(F32)
    rows = xs.shape[1] // GRID_W
    ctx_cond = c_ctx.astype(F32)[None]
    lat_cond = c.astype(F32)
    new_dn, new_s5 = [], []
    for l in range(DEPTH):
        lp = {name: arr[l] for name, arr in params.items()}
        xp, st_dn, st_s5 = trunk_layer(xp, ctx_cond, lp, None, None, None)
        new_dn.append(st_dn)
        new_s5.append(st_s5)
        xs, _, _ = trunk_layer(xs, lat_cond, lp, state_delta[:, l].astype(F32),
                               state_s5[:, l].astype(F32), rows)
    y_prompt = rmsnorm(xp, final_g).astype(x_prompt.dtype)
    y_sample = rmsnorm(xs, final_g).astype(x_sample.dtype)
    new_state_delta = jnp.stack(new_dn, axis=1).astype(state_delta.dtype)
    new_state_s5 = jnp.stack(new_s5, axis=1).astype(state_s5.dtype)
    return (y_prompt, y_sample, new_state_delta, new_state_s5)
```

```cpp
#ifdef EMU
#include "hip_emu.h"
#define LAUNCH(k, g, b, l, s, ...) EMU_LAUNCH(k, g, b, l, s, __VA_ARGS__)
#define DYN_LDS(name) char* name = emu::dyn_lds
#else
#include <hip/hip_runtime.h>
#include <cstdio>
#include <cstdint>
#include <cstring>
#define LAUNCH(k, g, b, l, s, ...) hipLaunchKernelGGL(k, dim3(g), dim3(b), l, s, __VA_ARGS__)
#define DYN_LDS(name) extern __shared__ __attribute__((aligned(16))) char name[]
#endif

#ifndef D_MODEL
#define D_MODEL 1024
#endif
#ifndef BATCH
#define BATCH 16
#endif
#ifndef SEQ
#define SEQ 256
#endif
#ifndef DEPTH
#define DEPTH 4
#endif
#ifndef DEC_BATCH
#define DEC_BATCH 2
#endif
#define DEC_SEQ 4096
constexpr int D = D_MODEL;
constexpr int NCTX = BATCH * SEQ, NLAT = DEC_BATCH * DEC_SEQ, NTOK = NCTX + NLAT;
constexpr int NCH_CTX = NCTX / 64, NCH_LAT = NLAT / 64, NCH = NTOK / 64;
constexpr int CPS_CTX = SEQ / 64, CPS_LAT = 64;
constexpr int NSEQ = BATCH + DEC_BATCH, NCOND = 1 + DEC_BATCH;
constexpr int BR = 256, DMIX = 1024;
constexpr int PU = 0, PZ = 256, QKV = 512, DZ = 1280, SU = 1536, SZ = 1792, FU = 2048, FZ = 2304, NPROJ = 2560, NPAD = 2688;
constexpr int D_IN_PROJ = 2576;
constexpr float EPS = 1e-6f;

typedef unsigned short bf16;
typedef float f32x4 __attribute__((ext_vector_type(4)));
typedef short bf16x8 __attribute__((ext_vector_type(8)));
typedef unsigned u32x2 __attribute__((ext_vector_type(2)));
typedef unsigned u32x4 __attribute__((ext_vector_type(4)));

__device__ __forceinline__ unsigned f2u(float f) { return __builtin_bit_cast(unsigned, f); }
__device__ __forceinline__ float u2f(unsigned u) { return __builtin_bit_cast(float, u); }
__device__ __forceinline__ bf16 f2bf(float f) { unsigned u = f2u(f); return (bf16)((u + 0x7fffu + ((u >> 16) & 1u)) >> 16); }
__device__ __forceinline__ float bf2f(bf16 h) { return u2f((unsigned)h << 16); }
__device__ __forceinline__ unsigned pk2(float lo, float hi) { return (unsigned)f2bf(lo) | ((unsigned)f2bf(hi) << 16); }
__device__ __forceinline__ float silu_f(float x) { return x / (1.0f + expf(-x)); }
__device__ __forceinline__ float sigmoid_f(float x) { return 1.0f / (1.0f + expf(-x)); }
__device__ __forceinline__ float softplus_f(float x) { return x > 20.f ? x : log1pf(expf(x)); }
__device__ __forceinline__ float gelu_f(float x) { return 0.5f * x * (1.0f + tanhf(0.7978845608028654f * (x + 0.044715f * x * x * x))); }

template <int MT, int NT>
__device__ __forceinline__ void mma_tiles(f32x4 (&acc)[MT][NT], const bf16* A, int lda, const bf16* B, int ldb, int K, int lane) {
#ifdef EMU
    const int col = lane & 15, rq = (lane >> 4) * 4;
    for (int mt = 0; mt < MT; ++mt) for (int nt = 0; nt < NT; ++nt) for (int r = 0; r < 4; ++r) {
        float s = 0.f; const bf16* a = A + (16 * mt + rq + r) * lda; const bf16* b = B + (16 * nt + col) * ldb;
        for (int k = 0; k < K; ++k) s += bf2f(a[k]) * bf2f(b[k]);
        acc[mt][nt][r] += s;
    }
#else
    const bf16* a0 = A + (lane & 15) * lda + (lane >> 4) * 8;
    const bf16* b0 = B + (lane & 15) * ldb + (lane >> 4) * 8;
    for (int k0 = 0; k0 < K; k0 += 32) {
        bf16x8 a[MT], b[NT];
#pragma unroll
        for (int mt = 0; mt < MT; ++mt) a[mt] = *(const bf16x8*)(a0 + 16 * mt * lda + k0);
#pragma unroll
        for (int nt = 0; nt < NT; ++nt) b[nt] = *(const bf16x8*)(b0 + 16 * nt * ldb + k0);
#pragma unroll
        for (int mt = 0; mt < MT; ++mt)
#pragma unroll
            for (int nt = 0; nt < NT; ++nt) acc[mt][nt] = __builtin_amdgcn_mfma_f32_16x16x32_bf16(a[mt], b[nt], acc[mt][nt], 0, 0, 0);
    }
#endif
}
template <int MT, int NT> __device__ __forceinline__ void zero_acc(f32x4 (&acc)[MT][NT]) {
#pragma unroll
    for (int mt = 0; mt < MT; ++mt)
#pragma unroll
        for (int nt = 0; nt < NT; ++nt) acc[mt][nt] = (f32x4){0.f, 0.f, 0.f, 0.f};
}

struct Params {
    const float *x_prompt, *x_sample, *c, *state_delta, *state_s5, *c_ctx, *w_ada, *b_ada, *norm_g, *w_in, *pool_w, *pool_scale,
        *dn_conv, *dn_a_log, *dn_dt_bias, *dn_norm_g, *s5_a_re, *s5_a_im, *s5_log_dt, *s5_b_re, *s5_b_im, *s5_c_re, *s5_c_im,
        *s5_d, *s5_glu_w, *s5_glu_b, *ft_w, *w_out, *final_g;
    float* out;
    bf16 *winT, *woutT, *ftwT, *gluT, *poolwT, *Cmat, *tabDc, *tabE, *tabT;
    float *ada, *abar, *abar64, *bbar;
    bf16 *hbuf  , *mix, *proj, *fbuf, *ybuf, *obuf, *Zg, *dnAp, *dnQh, *dnBT, *dnOT;
    float *gates, *dnEgl, *s5E, *s5S;
};
constexpr size_t OUT_DN = (size_t)NTOK * D, OUT_S5 = OUT_DN + (size_t)BATCH * DEPTH * 2 * 4 * 64 * 64;
constexpr size_t OUT_TOTAL = OUT_S5 + (size_t)BATCH * DEPTH * 2 * 2 * 16 * 64;

__device__ __forceinline__ int cond_of(int tok) { return tok < NCTX ? 0 : 1 + (tok - NCTX) / DEC_SEQ; }
__device__ __forceinline__ const float* xrow_in(const Params& p, int l, int tok) {
    if (l == 0) return tok < NCTX ? p.x_prompt + (size_t)tok * D : p.x_sample + (size_t)(tok - NCTX) * D;
    return p.out + (size_t)tok * D;
}

__device__ void prep_weights_body(const Params& p, size_t gtid, size_t gsz) {
    for (size_t i = gtid; i < (size_t)DEPTH * NPAD * D; i += gsz) {
        int k = (int)(i % D); int n = (int)((i / D) % NPAD); int l = (int)(i / ((size_t)D * NPAD));
        int oc = n < 1536 ? n : (n < NPROJ ? n + 16 : (n < NPROJ + 16 ? 1536 + (n - NPROJ) : -1));
        p.winT[i] = oc < 0 ? (bf16)0 : f2bf(p.w_in[((size_t)l * D + k) * D_IN_PROJ + oc]);
    }
    for (size_t i = gtid; i < (size_t)DEPTH * D * DMIX; i += gsz) {
        int k = (int)(i % DMIX); int n = (int)((i / DMIX) % D); int l = (int)(i / ((size_t)DMIX * D));
        p.woutT[i] = f2bf(p.w_out[((size_t)l * DMIX + k) * D + n]);
    }
    for (size_t i = gtid; i < (size_t)DEPTH * 256 * 256; i += gsz) {
        int k = (int)(i % 256), n = (int)((i / 256) % 256), l = (int)(i / 65536);
        p.ftwT[i] = f2bf(p.ft_w[((size_t)l * 256 + k) * 256 + n]);
        p.gluT[i] = f2bf(p.s5_glu_w[((size_t)l * 256 + k) * 256 + n]);
    }
    for (size_t i = gtid; i < (size_t)DEPTH * 4 * 64 * 64; i += gsz) {
        int c = (int)(i % 64), d = (int)((i / 64) % 64); size_t lg = i / 4096;
        p.poolwT[i] = f2bf(p.pool_w[(lg * 64 + c) * 64 + d]);
    }
    for (size_t i = gtid; i < (size_t)DEPTH * 16 * 16 * 256; i += gsz) {
        int k = (int)(i % 256), pp = (int)((i / 256) % 16), g = (int)((i / 4096) % 16), l = (int)(i / 65536);
        int d = k >> 7, part = (k >> 6) & 1, n = k & 63;
        size_t src = ((((size_t)l * 2 + d) * 16 + g) * 16 + pp) * 64 + n;
        p.Cmat[i] = f2bf(part ? -p.s5_c_im[src] : p.s5_c_re[src]);
    }
    const float TWO_PI = 6.283185307179586f;
    for (size_t i = gtid; i < 128 * 64; i += gsz) {
        int c = (int)(i % 64), n = (int)(i / 64), part = n >> 6, kc = n & 63; int m = (c * kc) & 63;
        float a = TWO_PI * (float)m / 64.f; p.tabDc[i] = f2bf(part ? -sinf(a) : cosf(a));
    }
    for (size_t i = gtid; i < 128 * 128; i += gsz) {
        int kk = (int)(i % 128), n = (int)(i / 128); int pp = n >> 6, k1 = n & 63, pt = kk >> 6, t1 = kk & 63; int m = (t1 * k1) & 63;
        float a = TWO_PI * (float)m / 64.f; float C = cosf(a), S = sinf(a);
        float v = (pp == 0) ? (pt == 0 ? C : S) : (pt == 0 ? -S : C);
        p.tabE[i] = f2bf(v);
    }
    for (size_t i = gtid; i < (size_t)SEQ * 2 * SEQ; i += gsz) {
        int kk = (int)(i % (2 * SEQ)), kt = (int)(i / (2 * SEQ)); int part = kk / SEQ, t = kk % SEQ; int m = (kt * t) % SEQ;
        float a = TWO_PI * (float)m / (float)SEQ; p.tabT[i] = f2bf(part ? sinf(a) : cosf(a));
    }
    for (size_t i = gtid; i < (size_t)DEPTH * 2 * 16 * 64; i += gsz) {
        size_t ldg = i / 64;
        float dt = expf(p.s5_log_dt[ldg]); float are = p.s5_a_re[i], aim = p.s5_a_im[i];
        float mag = expf(are * dt); float abr = mag * cosf(aim * dt), abi = mag * sinf(aim * dt);
        float den = are * are + aim * aim; float nr = abr - 1.0f;
        float cre = (nr * are + abi * aim) / den, cim = (abi * are - nr * aim) / den;
        p.abar[2 * i] = abr; p.abar[2 * i + 1] = abi;
        float pr = abr, pi = abi;
        for (int s = 0; s < 6; ++s) { float t0 = pr * pr - pi * pi, t1 = 2.f * pr * pi; pr = t0; pi = t1; }
        p.abar64[2 * i] = pr; p.abar64[2 * i + 1] = pi;
        for (int pp = 0; pp < 16; ++pp) {
            float bre = p.s5_b_re[i * 16 + pp], bim = p.s5_b_im[i * 16 + pp];
            p.bbar[i * 32 + pp] = cre * bre - cim * bim;
            p.bbar[i * 32 + 16 + pp] = cre * bim + cim * bre;
        }
    }
    for (size_t i = gtid; i < (size_t)DEPTH * 3 * D; i += gsz) {
        int j = (int)(i % (3 * D)), l = (int)(i / (3 * D));
        float acc[NCOND];
        for (int c = 0; c < NCOND; ++c) acc[c] = p.b_ada[(size_t)l * 3 * D + j];
        for (int k = 0; k < D; ++k) {
            float w = p.w_ada[((size_t)l * D + k) * 3 * D + j];
            acc[0] += silu_f(p.c_ctx[k]) * w;
            for (int c = 1; c < NCOND; ++c) acc[c] += silu_f(p.c[(size_t)(c - 1) * D + k]) * w;
        }
        for (int c = 0; c < NCOND; ++c) p.ada[((size_t)l * NCOND + c) * 3 * D + j] = acc[c];
    }
}
__global__ void __launch_bounds__(256) k_prep(Params p) { prep_weights_body(p, (size_t)blockIdx.x * 256 + threadIdx.x, (size_t)gridDim.x * 256); }

__device__ void norm_mod_body(const Params& p, int l, char* smem) {
    float* red = (float*)smem;
    const int tid = threadIdx.x, lane = tid & 63, wave = tid >> 6;
    for (int tok0 = blockIdx.x * 4; tok0 < NTOK; tok0 += gridDim.x * 4) {
        const int tok = tok0 + wave;
        const float* xr = xrow_in(p, l, tok);
        float v[D / 64]; float ss = 0.f;
#pragma unroll
        for (int j = 0; j < D / 64; ++j) { v[j] = xr[j * 64 + lane]; ss += v[j] * v[j]; }
#pragma unroll
        for (int o = 1; o < 64; o <<= 1) ss += __shfl_xor(ss, o);
        const float rs = 1.0f / sqrtf(ss / (float)D + EPS);
        const float* ad = p.ada + ((size_t)l * NCOND + cond_of(tok)) * 3 * D;
        const float* ng = p.norm_g + (size_t)l * D;
#pragma unroll
        for (int j = 0; j < D / 64; ++j) { int i = j * 64 + lane; float h = v[j] * rs * ng[i] * (1.0f + ad[D + i]) + ad[i]; p.hbuf[(size_t)tok * D + i] = f2bf(h); }
    }
    (void)red;
}
__global__ void __launch_bounds__(256) k_norm_mod(Params p, int l) { DYN_LDS(smem); norm_mod_body(p, l, smem); }

constexpr int GLD = 40;
constexpr int GEMM_LDS = 2 * 128 * GLD * 2;
template <class Epi>
__device__ void gemm_body(const bf16* A, int lda, const bf16* B, int ldb, int M, int N, int K, const Epi& epi, char* smem) {
    bf16* As = (bf16*)smem; bf16* Bs = As + 128 * GLD;
    const int tid = threadIdx.x, lane = tid & 63, wave = tid >> 6, wr = wave >> 1, wc = wave & 1;
    const int nM = M / 128, nN = N / 128, ntiles = nM * nN;
    for (int tile = blockIdx.x; tile < ntiles; tile += gridDim.x) {
        const int tm = tile / nN, tn = tile % nN;
        const bf16* Ag = A + (size_t)tm * 128 * lda; const bf16* Bg = B + (size_t)tn * 128 * ldb;
        f32x4 acc[4][4]; zero_acc(acc);
        u32x4 ra[2], rb[2];
        const int r0 = tid >> 2, ck = tid & 3;
#pragma unroll
        for (int i = 0; i < 2; ++i) { ra[i] = *(const u32x4*)(Ag + (size_t)(r0 + 64 * i) * lda + ck * 8); rb[i] = *(const u32x4*)(Bg + (size_t)(r0 + 64 * i) * ldb + ck * 8); }
        for (int k0 = 0; k0 < K; k0 += 32) {
            __syncthreads();
#pragma unroll
            for (int i = 0; i < 2; ++i) { *(u32x4*)(As + (r0 + 64 * i) * GLD + ck * 8) = ra[i]; *(u32x4*)(Bs + (r0 + 64 * i) * GLD + ck * 8) = rb[i]; }
            __syncthreads();
            if (k0 + 32 < K) {
#pragma unroll
                for (int i = 0; i < 2; ++i) { ra[i] = *(const u32x4*)(Ag + (size_t)(r0 + 64 * i) * lda + k0 + 32 + ck * 8); rb[i] = *(const u32x4*)(Bg + (size_t)(r0 + 64 * i) * ldb + k0 + 32 + ck * 8); }
            }
            mma_tiles<4, 4>(acc, As + wr * 64 * GLD, GLD, Bs + wc * 64 * GLD, GLD, 32, lane);
        }
#pragma unroll
        for (int mt = 0; mt < 4; ++mt)
#pragma unroll
            for (int nt = 0; nt < 4; ++nt) {
                const int row = tm * 128 + wr * 64 + mt * 16 + (lane >> 4) * 4, col = tn * 128 + wc * 64 + nt * 16 + (lane & 15);
#pragma unroll
                for (int r = 0; r < 4; ++r) epi(row + r, col, acc[mt][nt][r]);
            }
    }
}
struct EpiProj {
    bf16* proj; float* gates;
    __device__ __forceinline__ void operator()(int row, int col, float v) const {
        if (col < NPROJ) proj[(size_t)row * NPROJ + col] = f2bf(v);
        else if (col < NPROJ + 16) gates[(size_t)row * 16 + (col - NPROJ)] = v;
    }
};
struct EpiOut {
    const Params* p; int l;
    __device__ __forceinline__ void operator()(int row, int col, float v) const {
        const float g = p->ada[((size_t)l * NCOND + cond_of(row)) * 3 * D + 2 * D + col];
        const float xi = xrow_in(*p, l, row)[col];
        p->out[(size_t)row * D + col] = xi + g * v;
    }
};
struct EpiGlu {
    const Params* p; int l;
    __device__ __forceinline__ void operator()(int row, int col, float v) const {
        const float y = bf2f(p->ybuf[(size_t)row * 256 + col]);
        const float z = bf2f(p->proj[(size_t)row * NPROJ + SZ + col]);
        p->mix[(size_t)row * DMIX + 512 + col] = f2bf(y * sigmoid_f(v + p->s5_glu_b[l * 256 + col]) * silu_f(z));
    }
};
struct EpiFt {
    const Params* p;
    __device__ __forceinline__ void operator()(int row, int col, float v) const {
        const float z = bf2f(p->proj[(size_t)row * NPROJ + FZ + col]);
        p->mix[(size_t)row * DMIX + 768 + col] = f2bf(v * silu_f(z));
    }
};
__global__ void __launch_bounds__(256) k_gemm_in(Params p, int l) { DYN_LDS(smem); EpiProj e{p.proj, p.gates}; gemm_body(p.hbuf, D, p.winT + (size_t)l * NPAD * D, D, NTOK, NPAD, D, e, smem); }
__global__ void __launch_bounds__(256) k_gemm_out(Params p, int l) { DYN_LDS(smem); EpiOut e{&p, l}; gemm_body(p.mix, DMIX, p.woutT + (size_t)l * D * DMIX, DMIX, NTOK, D, DMIX, e, smem); }
__global__ void __launch_bounds__(256) k_gemm_glu(Params p, int l) { DYN_LDS(smem); EpiGlu e{&p, l}; gemm_body(p.ybuf, 256, p.gluT + (size_t)l * 65536, 256, NTOK, 256, 256, e, smem); }
__global__ void __launch_bounds__(256) k_gemm_ft(Params p, int l) { DYN_LDS(smem); EpiFt e{&p}; gemm_body(p.fbuf, 256, p.ftwT + (size_t)l * 65536, 256, NTOK, 256, 256, e, smem); }

constexpr int POOL_LDS = 64 * 264 * 2 + 64 * 66 * 4;
__device__ void pool_body(const Params& p, int l, char* smem) {
    bf16* Ps = (bf16*)smem;
    float* Vs = (float*)(smem + 64 * 264 * 2);
    const int tid = threadIdx.x, lane = tid & 63, wave = tid >> 6;
    const int c2 = tid & 31, jg = tid >> 5;
    for (int ch = blockIdx.x; ch < NCH; ch += gridDim.x) {
        const bool lat = ch >= NCH_CTX;
        __syncthreads();
        for (int g = 0; g < 4; ++g) {
            const int w = 2 << g, hw = w >> 1;
            const int cofs = PU + g * 64 + 2 * c2;
            if (!lat) {
                const int seq = ch / CPS_CTX, ci = ch % CPS_CTX; const size_t tok_seq = (size_t)seq * SEQ;
                for (int jj = 0; jj < 8; ++jj) {
                    const int j = jg * 8 + jj, t = ci * 64 + j;
                    int lo = t - hw; if (lo < 0) lo = 0; int hi = t - hw + w; if (hi > SEQ) hi = SEQ;
                    float s0 = 0.f, s1 = 0.f;
                    for (int tt = lo; tt < hi; ++tt) { unsigned u = *(const unsigned*)(p.proj + (tok_seq + tt) * NPROJ + cofs); s0 += bf2f((bf16)(u & 0xffff)); s1 += bf2f((bf16)(u >> 16)); }
                    unsigned uc = *(const unsigned*)(p.proj + (tok_seq + t) * NPROJ + cofs);
                    const float inv = 1.0f / (float)(hi - lo);
                    *(unsigned*)(Ps + j * 264 + g * 64 + 2 * c2) = pk2(s0 * inv - bf2f((bf16)(uc & 0xffff)), s1 * inv - bf2f((bf16)(uc >> 16)));
                }
            } else {
                const int b = (ch - NCH_CTX) / 64, r = (ch - NCH_CTX) % 64; const size_t tok_b = (size_t)NCTX + (size_t)b * DEC_SEQ;
                int lor = r - hw; if (lor < 0) lor = 0; int hir = r - hw + w; if (hir > 64) hir = 64;
                const float invr = 1.0f / (float)(hir - lor);
                for (int jj = 0; jj < 8; ++jj) {
                    const int col = jg * 8 + jj; float s0 = 0.f, s1 = 0.f;
                    for (int rr = lor; rr < hir; ++rr) { unsigned u = *(const unsigned*)(p.proj + (tok_b + rr * 64 + col) * NPROJ + cofs); s0 += bf2f((bf16)(u & 0xffff)); s1 += bf2f((bf16)(u >> 16)); }
                    Vs[col * 66 + 2 * c2] = s0 * invr; Vs[col * 66 + 2 * c2 + 1] = s1 * invr;
                }
                __syncthreads();
                for (int jj = 0; jj < 8; ++jj) {
                    const int col = jg * 8 + jj;
                    int lo = col - hw; if (lo < 0) lo = 0; int hi = col - hw + w; if (hi > 64) hi = 64;
                    float s0 = 0.f, s1 = 0.f;
                    for (int cc = lo; cc < hi; ++cc) { s0 += Vs[cc * 66 + 2 * c2]; s1 += Vs[cc * 66 + 2 * c2 + 1]; }
                    unsigned uc = *(const unsigned*)(p.proj + (tok_b + r * 64 + col) * NPROJ + cofs);
                    const float inv = 1.0f / (float)(hi - lo);
                    *(unsigned*)(Ps + col * 264 + g * 64 + 2 * c2) = pk2(s0 * inv - bf2f((bf16)(uc & 0xffff)), s1 * inv - bf2f((bf16)(uc >> 16)));
                }
                __syncthreads();
            }
        }
        __syncthreads();
        {
            const int g = wave; f32x4 acc[4][4]; zero_acc(acc);
            mma_tiles<4, 4>(acc, Ps + g * 64, 264, p.poolwT + ((size_t)l * 4 + g) * 4096, 64, 64, lane);
#pragma unroll
            for (int mt = 0; mt < 4; ++mt)
#pragma unroll
                for (int nt = 0; nt < 4; ++nt) {
                    const int d = g * 64 + nt * 16 + (lane & 15); const float sc = p.pool_scale[l * 256 + d];
#pragma unroll
                    for (int r = 0; r < 4; ++r) {
                        const size_t tok = (size_t)ch * 64 + mt * 16 + (lane >> 4) * 4 + r;
                        const float z = bf2f(p.proj[tok * NPROJ + PZ + d]);
                        p.mix[tok * DMIX + d] = f2bf(acc[mt][nt][r] * sc * silu_f(z));
                    }
                }
        }
    }
}
__global__ void __launch_bounds__(256) k_pool(Params p, int l) { DYN_LDS(smem); pool_body(p, l, smem); }

constexpr int FTC_ULD = 72, FTC_GLD = SEQ + 8;
constexpr int FTC_LDS = SEQ * FTC_ULD * 2 + 64 * FTC_GLD * 2;
__device__ void ft_ctx_body(const Params& p, char* smem) {
    bf16* Us = (bf16*)smem;
    bf16* GT = Us + SEQ * FTC_ULD;
    const int tid = threadIdx.x, lane = tid & 63, wave = tid >> 6;
    constexpr int MTW = SEQ / 64;
    for (int item = blockIdx.x; item < BATCH * 4; item += gridDim.x) {
        const int b = item >> 2, h = item & 3;
        __syncthreads();
        for (int i = tid; i < SEQ * 8; i += 256) { const int t = i >> 3, ck = i & 7; *(u32x4*)(Us + t * FTC_ULD + ck * 8) = *(const u32x4*)(p.proj + ((size_t)b * SEQ + t) * NPROJ + FU + h * 64 + ck * 8); }
        __syncthreads();
        f32x4 facc[MTW][4]; zero_acc(facc);
        for (int part = 0; part < 2; ++part) {
            f32x4 g[MTW][4]; zero_acc(g);
            mma_tiles<MTW, 4>(g, Us + wave * (SEQ / 4) * FTC_ULD, FTC_ULD, p.tabDc + part * 64 * 64, 64, 64, lane);
#pragma unroll
            for (int mt = 0; mt < MTW; ++mt)
#pragma unroll
                for (int nt = 0; nt < 4; ++nt) {
                    const int kc = nt * 16 + (lane & 15), t0 = wave * (SEQ / 4) + mt * 16 + (lane >> 4) * 4;
                    u32x2 w; w.x = pk2(g[mt][nt][0], g[mt][nt][1]); w.y = pk2(g[mt][nt][2], g[mt][nt][3]);
                    *(u32x2*)(GT + kc * FTC_GLD + t0) = w;
                }
            __syncthreads();
            mma_tiles<MTW, 4>(facc, p.tabT + (size_t)(wave * (SEQ / 4)) * 2 * SEQ + part * SEQ, 2 * SEQ, GT, FTC_GLD, SEQ, lane);
            __syncthreads();
        }
        const float sc = 1.0f / sqrtf((float)SEQ * 64.f);
#pragma unroll
        for (int mt = 0; mt < MTW; ++mt)
#pragma unroll
            for (int nt = 0; nt < 4; ++nt)
#pragma unroll
                for (int r = 0; r < 4; ++r) {
                    const int kt = wave * (SEQ / 4) + mt * 16 + (lane >> 4) * 4 + r, kc = nt * 16 + (lane & 15);
                    p.fbuf[((size_t)b * SEQ + kt) * 256 + h * 64 + kc] = f2bf(facc[mt][nt][r] * sc);
                }
    }
}
__global__ void __launch_bounds__(256) k_ft_ctx(Params p) { DYN_LDS(smem); ft_ctx_body(p, smem); }

constexpr int FTA_LDS = 64 * 264 * 2 + 64 * 136 * 2;
__device__ void ft_latA_body(const Params& p, char* smem) {
    bf16* Xs = (bf16*)smem;
    bf16* Z1T = Xs + 64 * 264;
    const int tid = threadIdx.x, lane = tid & 63, wave = tid >> 6;
    for (int item = blockIdx.x; item < DEC_BATCH * 64; item += gridDim.x) {
        const int b = item >> 6, t2 = item & 63;
        __syncthreads();
        for (int i = tid; i < 64 * 32; i += 256) { const int t1 = i >> 5, ck = i & 31; *(u32x4*)(Xs + t1 * 264 + ck * 8) = *(const u32x4*)(p.proj + ((size_t)NCTX + (size_t)b * DEC_SEQ + t1 * 64 + t2) * NPROJ + FU + ck * 8); }
        __syncthreads();
        for (int h = 0; h < 4; ++h) {
            {
                f32x4 a[4][2]; zero_acc(a);
                mma_tiles<4, 2>(a, Xs + h * 64, 264, p.tabDc + wave * 32 * 64, 64, 64, lane);
#pragma unroll
                for (int mt = 0; mt < 4; ++mt)
#pragma unroll
                    for (int nt = 0; nt < 2; ++nt) {
                        const int n = wave * 32 + nt * 16 + (lane & 15), part = n >> 6, kc = n & 63, t10 = mt * 16 + (lane >> 4) * 4;
                        u32x2 w; w.x = pk2(a[mt][nt][0], a[mt][nt][1]); w.y = pk2(a[mt][nt][2], a[mt][nt][3]);
                        *(u32x2*)(Z1T + kc * 136 + part * 64 + t10) = w;
                    }
            }
            __syncthreads();
            {
                f32x4 z[1][8]; zero_acc(z);
                mma_tiles<1, 8>(z, Z1T + wave * 16 * 136, 136, p.tabE, 128, 128, lane);
#pragma unroll
                for (int nt = 0; nt < 4; ++nt) {
                    const int k1 = nt * 16 + (lane & 15); const int m = (t2 * k1) & 4095;
                    const float ang = 6.283185307179586f * (float)m / 4096.f; const float tc = cosf(ang), ts = sinf(ang);
#pragma unroll
                    for (int r = 0; r < 4; ++r) {
                        const int kc = wave * 16 + (lane >> 4) * 4 + r; const float a = z[0][nt][r], bb = z[0][nt + 4][r];
                        bf16* dst = p.Zg + ((((size_t)b * 64 + k1) * 256 + h * 64 + kc) * 128) + t2;
                        dst[0] = f2bf(a * tc + bb * ts); dst[64] = f2bf(bb * tc - a * ts);
                    }
                }
            }
            __syncthreads();
        }
    }
}
__global__ void __launch_bounds__(256) k_ft_latA(Params p) { DYN_LDS(smem); ft_latA_body(p, smem); }

__device__ void ft_latB_body(const Params& p) {
    const int tid = threadIdx.x, lane = tid & 63, wave = tid >> 6;
    for (int item = blockIdx.x; item < DEC_BATCH * 64; item += gridDim.x) {
        const int b = item >> 6, k1 = item & 63;
        f32x4 acc[4][4]; zero_acc(acc);
        mma_tiles<4, 4>(acc, p.tabE, 128, p.Zg + (((size_t)b * 64 + k1) * 256 + wave * 64) * 128, 128, 128, lane);
#pragma unroll
        for (int mt = 0; mt < 4; ++mt)
#pragma unroll
            for (int nt = 0; nt < 4; ++nt)
#pragma unroll
                for (int r = 0; r < 4; ++r) {
                    const int k2 = mt * 16 + (lane >> 4) * 4 + r, n = wave * 64 + nt * 16 + (lane & 15);
                    p.fbuf[((size_t)NCTX + (size_t)b * DEC_SEQ + k1 + 64 * k2) * 256 + n] = f2bf(acc[mt][nt][r] * (1.0f / 512.f));
                }
    }
}
__global__ void __launch_bounds__(256) k_ft_latB(Params p) { ft_latB_body(p); }

constexpr int S5P1_LDS = 4 * 64 * 16 * 4;
__device__ void s5_pass1_body(const Params& p, int l, char* smem) {
    const int tid = threadIdx.x, lane = tid & 63, wave = tid >> 6;
    float* uS = (float*)smem + wave * 1024;
    for (int it0 = blockIdx.x * 4; it0 < NCH * 32; it0 += gridDim.x * 4) {
        const int item = it0 + wave; const int d = item & 1, g = (item >> 1) & 15, ch = item >> 5;
        __syncthreads();
        for (int i = lane; i < 1024; i += 64) { const int t = i >> 4, pp = i & 15; uS[i] = bf2f(p.proj[((size_t)ch * 64 + t) * NPROJ + SU + g * 16 + pp]); }
        __syncthreads();
        const size_t pi = (((size_t)l * 2 + d) * 16 + g) * 64 + lane;
        const float ar = p.abar[2 * pi], ai = p.abar[2 * pi + 1];
        float bre[16], bim[16];
#pragma unroll
        for (int pp = 0; pp < 16; ++pp) { bre[pp] = p.bbar[pi * 32 + pp]; bim[pp] = p.bbar[pi * 32 + 16 + pp]; }
        float sr = 0.f, si = 0.f;
        for (int tau = 0; tau < 64; ++tau) {
            const int t = d ? 63 - tau : tau; float br = 0.f, bi = 0.f;
#pragma unroll
            for (int pp = 0; pp < 16; ++pp) { const float u = uS[t * 16 + pp]; br += bre[pp] * u; bi += bim[pp] * u; }
            const float nr = ar * sr - ai * si + br, ni = ar * si + ai * sr + bi; sr = nr; si = ni;
        }
        float* E = p.s5E + (((size_t)ch * 16 + g) * 2 + d) * 128;
        E[lane] = sr; E[64 + lane] = si;
    }
}
__global__ void __launch_bounds__(256) k_s5_pass1(Params p, int l) { DYN_LDS(smem); s5_pass1_body(p, l, smem); }
__device__ void s5_carry_body(const Params& p, int l) {
    for (int i = blockIdx.x * 256 + threadIdx.x; i < NSEQ * 16 * 2 * 64; i += gridDim.x * 256) {
        const int n = i & 63, d = (i >> 6) & 1, g = (i >> 7) & 15, seq = i >> 11;
        const bool lat = seq >= BATCH; const int cps = lat ? CPS_LAT : CPS_CTX; const int ch0 = lat ? NCH_CTX + (seq - BATCH) * CPS_LAT : seq * CPS_CTX;
        const size_t pi = (((size_t)l * 2 + d) * 16 + g) * 64 + n;
        const float ar = p.abar64[2 * pi], ai = p.abar64[2 * pi + 1];
        float sr = 0.f, si = 0.f;
        if (lat) { const size_t o = ((((size_t)(seq - BATCH) * DEPTH + l) * 2 + d) * 2) * 1024 + g * 64 + n; sr = p.state_s5[o]; si = p.state_s5[o + 1024]; }
        for (int c = 0; c < cps; ++c) {
            const int ch = ch0 + (d ? cps - 1 - c : c);
            const size_t e = (((size_t)ch * 16 + g) * 2 + d) * 128 + n;
            p.s5S[e] = sr; p.s5S[e + 64] = si;
            const float er = p.s5E[e], ei = p.s5E[e + 64];
            const float nr = ar * sr - ai * si + er, ni = ar * si + ai * sr + ei; sr = nr; si = ni;
        }
        if (!lat) { const size_t o = OUT_S5 + ((((size_t)seq * DEPTH + l) * 2 + d) * 2) * 1024 + g * 64 + n; p.out[o] = sr; p.out[o + 1024] = si; }
    }
}
__global__ void __launch_bounds__(256) k_s5_carry(Params p, int l) { s5_carry_body(p, l); }
constexpr int S5P3_LDS = 2 * 64 * 264 * 2 + 2 * 64 * 16 * 4;
__device__ void s5_pass3_body(const Params& p, int l, char* smem) {
    const int tid = threadIdx.x, lane = tid & 63, wave = tid >> 6, il = wave >> 1, d = wave & 1;
    bf16* Ss = (bf16*)smem + il * 64 * 264;
    float* uS = (float*)(smem + 2 * 64 * 264 * 2) + il * 1024;
    for (int it0 = blockIdx.x * 2; it0 < NCH * 16; it0 += gridDim.x * 2) {
        const int item = it0 + il; const int g = item & 15, ch = item >> 4;
        __syncthreads();
        for (int i = (tid & 127); i < 1024; i += 128) { const int t = i >> 4, pp = i & 15; uS[i] = bf2f(p.proj[((size_t)ch * 64 + t) * NPROJ + SU + g * 16 + pp]); }
        __syncthreads();
        const size_t pi = (((size_t)l * 2 + d) * 16 + g) * 64 + lane;
        const float ar = p.abar[2 * pi], ai = p.abar[2 * pi + 1];
        float bre[16], bim[16];
#pragma unroll
        for (int pp = 0; pp < 16; ++pp) { bre[pp] = p.bbar[pi * 32 + pp]; bim[pp] = p.bbar[pi * 32 + 16 + pp]; }
        const size_t e = (((size_t)ch * 16 + g) * 2 + d) * 128 + lane;
        float sr = p.s5S[e], si = p.s5S[e + 64];
        for (int tau = 0; tau < 64; ++tau) {
            const int t = d ? 63 - tau : tau; float br = 0.f, bi = 0.f;
#pragma unroll
            for (int pp = 0; pp < 16; ++pp) { const float u = uS[t * 16 + pp]; br += bre[pp] * u; bi += bim[pp] * u; }
            const float nr = ar * sr - ai * si + br, ni = ar * si + ai * sr + bi; sr = nr; si = ni;
            Ss[t * 264 + d * 128 + lane] = f2bf(sr); Ss[t * 264 + d * 128 + 64 + lane] = f2bf(si);
        }
        __syncthreads();
        f32x4 acc[2][1]; zero_acc(acc);
        mma_tiles<2, 1>(acc, Ss + d * 32 * 264, 264, p.Cmat + ((size_t)l * 16 + g) * 4096, 256, 256, lane);
#pragma unroll
        for (int mt = 0; mt < 2; ++mt)
#pragma unroll
            for (int r = 0; r < 4; ++r) {
                const int t = d * 32 + mt * 16 + (lane >> 4) * 4 + r, pp = lane & 15;
                const float y = acc[mt][0][r] + p.s5_d[l * 256 + g * 16 + pp] * uS[t * 16 + pp];
                p.ybuf[((size_t)ch * 64 + t) * 256 + g * 16 + pp] = f2bf(gelu_f(y));
            }
    }
}
__global__ void __launch_bounds__(256) k_s5_pass3(Params p, int l) { DYN_LDS(smem); s5_pass3_body(p, l, smem); }

constexpr int DN_STG = 0;
constexpr int DN_S1 = 0, DN_S2 = 18432;
constexpr int DN_AM = 36864;
constexpr int DN_QB = DN_AM + 17408, DN_KB = DN_QB + 9216, DN_VB = DN_KB + 9216;
constexpr int DN_SM = DN_VB + 9216;
constexpr int DN1_LDS = DN_SM + 5 * 64 * 4;
__device__ void dn_d1_body(const Params& p, int l, char* smem) {
    float* stq = (float*)(smem + DN_STG); float* stk = stq + 64 * 65;
    bf16* S1 = (bf16*)(smem + DN_S1); bf16* S2 = (bf16*)(smem + DN_S2);
    float* Am = (float*)(smem + DN_AM);
    bf16* Qb = (bf16*)(smem + DN_QB); bf16* Kb = (bf16*)(smem + DN_KB); bf16* Vb = (bf16*)(smem + DN_VB);
    float* rq = (float*)(smem + DN_SM); float* rk = rq + 64; float* gs = rk + 64; float* bs = gs + 64; float* gcs = bs + 64;
    const int tid = threadIdx.x, lane = tid & 63, wave = tid >> 6;
    for (int item = blockIdx.x; item < NCH * 8; item += gridDim.x) {
        const int d = item & 1, h = (item >> 1) & 3, ch = item >> 3;
        const bool lat = ch >= NCH_CTX;
        const int cps = lat ? CPS_LAT : CPS_CTX; const int ci = lat ? (ch - NCH_CTX) % CPS_LAT : ch % CPS_CTX;
        const int lseq = cps * 64; const size_t tok_seq = (size_t)(ch - ci) * 64;
        __syncthreads();
        {
            const int c = lane, tq = wave;
#pragma unroll
            for (int arr = 0; arr < 3; ++arr) {
                const int chn = arr * 256 + h * 64 + c; float wv[5];
#pragma unroll
                for (int j = 0; j < 5; ++j) wv[j] = p.dn_conv[((size_t)l * 5 + j) * 768 + chn];
                float in[20];
#pragma unroll
                for (int i = 0; i < 20; ++i) { const int pos = ci * 64 + tq * 16 + i - 2; in[i] = (pos >= 0 && pos < lseq) ? bf2f(p.proj[(tok_seq + pos) * NPROJ + QKV + chn]) : 0.f; }
#pragma unroll
                for (int i = 0; i < 16; ++i) {
                    float s = 0.f;
#pragma unroll
                    for (int j = 0; j < 5; ++j) s += wv[j] * in[i + j];
                    s = silu_f(s);
                    const int jt = tq * 16 + i, tau = d ? 63 - jt : jt;
                    if (arr == 0) stq[tau * 65 + c] = s; else if (arr == 1) stk[tau * 65 + c] = s; else Vb[tau * 72 + c] = f2bf(s);
                }
            }
        }
        __syncthreads();
        if (tid < 128) {
            const float* st = tid < 64 ? stq : stk; const int t = tid & 63; float ss = 0.f;
            for (int c = 0; c < 64; ++c) { const float v = st[t * 65 + c]; ss += v * v; }
            (tid < 64 ? rq : rk)[t] = 1.0f / sqrtf(ss + EPS);
        } else if (tid < 192) {
            const int tau = tid - 128; const size_t tok = (size_t)ch * 64 + (d ? 63 - tau : tau);
            const float braw = p.gates[tok * 16 + d * 4 + h], araw = p.gates[tok * 16 + 8 + d * 4 + h];
            bs[tau] = sigmoid_f(braw);
            gs[tau] = -expf(p.dn_a_log[(l * 2 + d) * 4 + h]) * softplus_f(araw + p.dn_dt_bias[(l * 2 + d) * 4 + h]);
        }
        __syncthreads();
        {
            const int c = lane;
            for (int t = wave * 16; t < wave * 16 + 16; ++t) { Qb[t * 72 + c] = f2bf(stq[t * 65 + c] * rq[t]); Kb[t * 72 + c] = f2bf(stk[t * 65 + c] * rk[t]); }
            if (tid == 0) { float a = 0.f; for (int t = 0; t < 64; ++t) { a += gs[t]; gcs[t] = a; } }
        }
        __syncthreads();
        const float gl = gcs[63];
        {
            f32x4 kk[1][4], qk[1][4]; zero_acc(kk); zero_acc(qk);
            mma_tiles<1, 4>(kk, Kb + wave * 16 * 72, 72, Kb, 72, 64, lane);
            mma_tiles<1, 4>(qk, Qb + wave * 16 * 72, 72, Kb, 72, 64, lane);
            __syncthreads();
#pragma unroll
            for (int nt = 0; nt < 4; ++nt)
#pragma unroll
                for (int r = 0; r < 4; ++r) {
                    const int tau = wave * 16 + (lane >> 4) * 4 + r, sg = nt * 16 + (lane & 15);
                    const float dec = sg <= tau ? expf(gcs[tau] - gcs[sg]) : 0.f;
                    Am[tau * 68 + sg] = sg < tau ? kk[0][nt][r] * dec * bs[tau] : 0.f;
                    S1[(64 + tau) * 72 + sg] = f2bf(qk[0][nt][r] * 0.125f * dec);
                }
            const int tau = lane;
            const float kd = expf(gl - gcs[tau]);
            for (int dk = wave * 16; dk < wave * 16 + 16; ++dk) S1[dk * 72 + tau] = f2bf(bf2f(Kb[tau * 72 + dk]) * kd);
        }
        __syncthreads();
        if (tid < 128) {
            const int col = tid; float x[64];
#pragma unroll
            for (int t = 0; t < 64; ++t) x[t] = col < 64 ? bf2f(Kb[t * 72 + col]) * bs[t] * expf(gcs[t]) : bf2f(Vb[t * 72 + col - 64]) * bs[t];
#pragma unroll
            for (int i = 1; i < 64; ++i) {
                float s = x[i];
#pragma unroll
                for (int j = 0; j < i; ++j) s -= Am[i * 68 + j] * x[j];
                x[i] = s;
            }
            const float sgn = col < 64 ? -1.f : 1.f;
#pragma unroll
            for (int t = 0; t < 64; t += 2) *(unsigned*)(S2 + col * 72 + t) = pk2(sgn * x[t], sgn * x[t + 1]);
        }
        __syncthreads();
        {
            f32x4 acc[2][8]; zero_acc(acc);
            mma_tiles<2, 8>(acc, S1 + wave * 32 * 72, 72, S2, 72, 64, lane);
            const size_t ib = (size_t)item * 4096;
#pragma unroll
            for (int mt = 0; mt < 2; ++mt)
#pragma unroll
                for (int nt = 0; nt < 8; ++nt) {
                    const int row0 = wave * 32 + mt * 16 + (lane >> 4) * 4, colx = nt * 16 + (lane & 15);
                    if (row0 < 64) {
                        if (colx < 64) { for (int r = 0; r < 4; ++r) p.dnAp[ib + (row0 + r) * 64 + colx] = f2bf(acc[mt][nt][r]); }
                        else { u32x2 w; w.x = pk2(acc[mt][nt][0], acc[mt][nt][1]); w.y = pk2(acc[mt][nt][2], acc[mt][nt][3]); *(u32x2*)(p.dnBT + ib + (colx - 64) * 64 + row0) = w; }
                    } else {
                        const int t0 = row0 - 64;
                        if (colx < 64) { for (int r = 0; r < 4; ++r) { const int tau = t0 + r; const float qe = bf2f(Qb[tau * 72 + colx]) * 0.125f * expf(gcs[tau]); p.dnQh[ib + tau * 64 + colx] = f2bf(qe + acc[mt][nt][r]); } }
                        else { u32x2 w; w.x = pk2(acc[mt][nt][0], acc[mt][nt][1]); w.y = pk2(acc[mt][nt][2], acc[mt][nt][3]); *(u32x2*)(p.dnOT + ib + (colx - 64) * 64 + t0) = w; }
                    }
                }
            if (tid == 0) p.dnEgl[item] = expf(gl);
        }
    }
}
__global__ void __launch_bounds__(256) k_dn_d1(Params p, int l) { DYN_LDS(smem); dn_d1_body(p, l, smem); }
constexpr int DN2_LDS = 64 * 72 * 2;
__device__ void dn_scan_body(const Params& p, int l, char* smem) {
    bf16* ST = (bf16*)smem;
    const int tid = threadIdx.x, lane = tid & 63, wave = tid >> 6;
    for (int chain = blockIdx.x; chain < NSEQ * 8; chain += gridDim.x) {
        const int d = chain & 1, h = (chain >> 1) & 3, seq = chain >> 3;
        const bool lat = seq >= BATCH; const int cps = lat ? CPS_LAT : CPS_CTX; const int ch0 = lat ? NCH_CTX + (seq - BATCH) * CPS_LAT : seq * CPS_CTX;
        const int dv = wave * 16 + (lane & 15);
        f32x4 S[4][1];
#pragma unroll
        for (int mt = 0; mt < 4; ++mt)
#pragma unroll
            for (int r = 0; r < 4; ++r) {
                const int dk = mt * 16 + (lane >> 4) * 4 + r;
                S[mt][0][r] = lat ? p.state_delta[(((((size_t)(seq - BATCH) * DEPTH + l) * 2 + d) * 4 + h) * 64 + dk) * 64 + dv] : 0.f;
            }
        for (int c = 0; c < cps; ++c) {
            const int ch = ch0 + (d ? cps - 1 - c : c); const int item = (ch * 4 + h) * 2 + d; const size_t ib = (size_t)item * 4096;
            __syncthreads();
#pragma unroll
            for (int mt = 0; mt < 4; ++mt) { u32x2 w; w.x = pk2(S[mt][0][0], S[mt][0][1]); w.y = pk2(S[mt][0][2], S[mt][0][3]); *(u32x2*)(ST + dv * 72 + mt * 16 + (lane >> 4) * 4) = w; }
            __syncthreads();
            const float egl = p.dnEgl[item];
            f32x4 Sn[4][1], O[4][1];
#pragma unroll
            for (int mt = 0; mt < 4; ++mt) {
                const int r0 = mt * 16 + (lane >> 4) * 4;
                const u32x2 wb = *(const u32x2*)(p.dnBT + ib + dv * 64 + r0), wo = *(const u32x2*)(p.dnOT + ib + dv * 64 + r0);
                Sn[mt][0][0] = egl * S[mt][0][0] + bf2f((bf16)(wb.x & 0xffff)); Sn[mt][0][1] = egl * S[mt][0][1] + bf2f((bf16)(wb.x >> 16));
                Sn[mt][0][2] = egl * S[mt][0][2] + bf2f((bf16)(wb.y & 0xffff)); Sn[mt][0][3] = egl * S[mt][0][3] + bf2f((bf16)(wb.y >> 16));
                O[mt][0][0] = bf2f((bf16)(wo.x & 0xffff)); O[mt][0][1] = bf2f((bf16)(wo.x >> 16)); O[mt][0][2] = bf2f((bf16)(wo.y & 0xffff)); O[mt][0][3] = bf2f((bf16)(wo.y >> 16));
            }
            mma_tiles<4, 1>(Sn, p.dnAp + ib, 64, ST + wave * 16 * 72, 72, 64, lane);
            mma_tiles<4, 1>(O, p.dnQh + ib, 64, ST + wave * 16 * 72, 72, 64, lane);
#pragma unroll
            for (int mt = 0; mt < 4; ++mt)
#pragma unroll
                for (int r = 0; r < 4; ++r) {
                    const int tau = mt * 16 + (lane >> 4) * 4 + r; const size_t tok = (size_t)ch * 64 + (d ? 63 - tau : tau);
                    p.obuf[((size_t)d * NTOK + tok) * 256 + h * 64 + dv] = f2bf(O[mt][0][r]);
                    S[mt][0][r] = Sn[mt][0][r];
                }
        }
        if (!lat) {
#pragma unroll
            for (int mt = 0; mt < 4; ++mt)
#pragma unroll
                for (int r = 0; r < 4; ++r) {
                    const int dk = mt * 16 + (lane >> 4) * 4 + r;
                    p.out[OUT_DN + (((((size_t)seq * DEPTH + l) * 2 + d) * 4 + h) * 64 + dk) * 64 + dv] = S[mt][0][r];
                }
        }
    }
}
__global__ void __launch_bounds__(256) k_dn_scan(Params p, int l) { DYN_LDS(smem); dn_scan_body(p, l, smem); }
__device__ void dn_d3_body(const Params& p, int l) {
    for (int i = blockIdx.x * 256 + threadIdx.x; i < NTOK * 4; i += gridDim.x * 256) {
        const int h = i & 3; const size_t tok = i >> 2;
        const bf16* o0 = p.obuf + tok * 256 + h * 64; const bf16* o1 = p.obuf + ((size_t)NTOK + tok) * 256 + h * 64;
        float v[64]; float ss = 0.f;
#pragma unroll
        for (int c = 0; c < 64; ++c) { v[c] = bf2f(o0[c]) + bf2f(o1[c]); ss += v[c] * v[c]; }
        const float rs = 1.0f / sqrtf(ss / 64.f + EPS);
#pragma unroll
        for (int c = 0; c < 64; ++c) {
            const float z = bf2f(p.proj[tok * NPROJ + DZ + h * 64 + c]);
            p.mix[tok * DMIX + 256 + h * 64 + c] = f2bf(v[c] * rs * p.dn_norm_g[l * 64 + c] * silu_f(z));
        }
    }
}
__global__ void __launch_bounds__(256) k_dn_d3(Params p, int l) { dn_d3_body(p, l); }

__device__ void final_norm_body(const Params& p) {
    const int tid = threadIdx.x, lane = tid & 63, wave = tid >> 6;
    for (int tok0 = blockIdx.x * 4; tok0 < NTOK; tok0 += gridDim.x * 4) {
        float* xr = p.out + (size_t)(tok0 + wave) * D;
        float v[D / 64]; float ss = 0.f;
#pragma unroll
        for (int j = 0; j < D / 64; ++j) { v[j] = xr[j * 64 + lane]; ss += v[j] * v[j]; }
#pragma unroll
        for (int o = 1; o < 64; o <<= 1) ss += __shfl_xor(ss, o);
        const float rs = 1.0f / sqrtf(ss / (float)D + EPS);
#pragma unroll
        for (int j = 0; j < D / 64; ++j) xr[j * 64 + lane] = v[j] * rs * p.final_g[j * 64 + lane];
    }
}
__global__ void __launch_bounds__(256) k_final(Params p) { final_norm_body(p); }

static size_t ws_carve(Params& p, char* ws) {
    size_t off = 0;
    auto take = [&](size_t bytes) { size_t o = off; off += (bytes + 255) & ~(size_t)255; return ws ? ws + o : (char*)nullptr; };
    p.winT = (bf16*)take((size_t)DEPTH * NPAD * D * 2);
    p.woutT = (bf16*)take((size_t)DEPTH * D * DMIX * 2);
    p.ftwT = (bf16*)take((size_t)DEPTH * 65536 * 2);
    p.gluT = (bf16*)take((size_t)DEPTH * 65536 * 2);
    p.poolwT = (bf16*)take((size_t)DEPTH * 4 * 4096 * 2);
    p.Cmat = (bf16*)take((size_t)DEPTH * 16 * 4096 * 2);
    p.tabDc = (bf16*)take(128 * 64 * 2);
    p.tabE = (bf16*)take(128 * 128 * 2);
    p.tabT = (bf16*)take((size_t)SEQ * 2 * SEQ * 2);
    p.ada = (float*)take((size_t)DEPTH * NCOND * 3 * D * 4);
    p.abar = (float*)take((size_t)DEPTH * 2 * 16 * 64 * 2 * 4);
    p.abar64 = (float*)take((size_t)DEPTH * 2 * 16 * 64 * 2 * 4);
    p.bbar = (float*)take((size_t)DEPTH * 2 * 16 * 64 * 32 * 4);
    p.hbuf = (bf16*)take((size_t)NTOK * DMIX * 2);
    p.mix = p.hbuf;
    p.proj = (bf16*)take((size_t)NTOK * NPROJ * 2);
    p.fbuf = (bf16*)take((size_t)NTOK * 256 * 2);
    p.ybuf = (bf16*)take((size_t)NTOK * 256 * 2);
    p.obuf = (bf16*)take((size_t)2 * NTOK * 256 * 2);
    p.Zg = (bf16*)take((size_t)DEC_BATCH * 64 * 256 * 128 * 2);
    p.dnAp = (bf16*)take((size_t)NCH * 8 * 4096 * 2);
    p.dnQh = (bf16*)take((size_t)NCH * 8 * 4096 * 2);
    p.dnBT = (bf16*)take((size_t)NCH * 8 * 4096 * 2);
    p.dnOT = (bf16*)take((size_t)NCH * 8 * 4096 * 2);
    p.gates = (float*)take((size_t)NTOK * 16 * 4);
    p.dnEgl = (float*)take((size_t)NCH * 8 * 4);
    p.s5E = (float*)take((size_t)NCH * 16 * 2 * 128 * 4);
    p.s5S = (float*)take((size_t)NCH * 16 * 2 * 128 * 4);
    return off;
}

#ifdef EMU
void emu_hook(const char* tag, int l, const Params& p);
#define HOOK(tag, l) emu_hook(tag, l, p)
#else
#define HOOK(tag, l)
#endif
extern "C" void kernel_launch(void* const* d_in, const int* in_sizes, int n_in, void* d_out, int out_size, void* d_ws, size_t ws_size, hipStream_t stream) {
    Params p;
    memset(&p, 0, sizeof(p));
    const float** ip = (const float**)&p;
    for (int i = 0; i < 29; ++i) ip[i] = (const float*)d_in[i];
    p.out = (float*)d_out;
    const size_t need = ws_carve(p, (char*)d_ws);
    if (need > ws_size || n_in != 29) { fprintf(stderr, "kernel_launch: workspace %zu < %zu or n_in %d\n", ws_size, need, n_in); return; }
#ifndef EMU
    static bool attr_done = false;
    if (!attr_done) {
        hipFuncSetAttribute((const void*)k_dn_d1, hipFuncAttributeMaxDynamicSharedMemorySize, DN1_LDS);
        hipFuncSetAttribute((const void*)k_s5_pass3, hipFuncAttributeMaxDynamicSharedMemorySize, S5P3_LDS);
        hipFuncSetAttribute((const void*)k_ft_ctx, hipFuncAttributeMaxDynamicSharedMemorySize, FTC_LDS);
        hipFuncSetAttribute((const void*)k_ft_latA, hipFuncAttributeMaxDynamicSharedMemorySize, FTA_LDS);
        hipFuncSetAttribute((const void*)k_pool, hipFuncAttributeMaxDynamicSharedMemorySize, POOL_LDS);
        attr_done = true;
    }
#endif
    LAUNCH(k_prep, 1024, 256, 0, stream, p);
    for (int l = 0; l < DEPTH; ++l) {
        LAUNCH(k_norm_mod, NTOK / 4, 256, 64, stream, p, l);
        HOOK("norm", l);
        LAUNCH(k_gemm_in, (NTOK / 128) * (NPAD / 128), 256, GEMM_LDS, stream, p, l);
        HOOK("proj", l);
        LAUNCH(k_pool, NCH, 256, POOL_LDS, stream, p, l);
        LAUNCH(k_ft_ctx, BATCH * 4, 256, FTC_LDS, stream, p);
        LAUNCH(k_ft_latA, DEC_BATCH * 64, 256, FTA_LDS, stream, p);
        LAUNCH(k_s5_pass1, NCH * 8, 256, S5P1_LDS, stream, p, l);
        LAUNCH(k_dn_d1, NCH * 8, 256, DN1_LDS, stream, p, l);
        LAUNCH(k_s5_carry, (NSEQ * 2048 + 255) / 256, 256, 0, stream, p, l);
        LAUNCH(k_dn_scan, NSEQ * 8, 256, DN2_LDS, stream, p, l);
        LAUNCH(k_ft_latB, DEC_BATCH * 64, 256, 0, stream, p);
        LAUNCH(k_s5_pass3, NCH * 8, 256, S5P3_LDS, stream, p, l);
        LAUNCH(k_dn_d3, (NTOK * 4 + 255) / 256, 256, 0, stream, p, l);
        LAUNCH(k_gemm_glu, (NTOK / 128) * 2, 256, GEMM_LDS, stream, p, l);
        LAUNCH(k_gemm_ft, (NTOK / 128) * 2, 256, GEMM_LDS, stream, p, l);
        HOOK("mix", l);
        LAUNCH(k_gemm_out, (NTOK / 128) * (D / 128), 256, GEMM_LDS, stream, p, l);
        HOOK("xout", l);
    }
    LAUNCH(k_final, NTOK / 4, 256, 0, stream, p);
}
```

```cpp
#ifdef EMU
#include "hip_emu.h"
#define LAUNCH(k, g, b, l, s, ...) EMU_LAUNCH(k, g, b, l, s, __VA_ARGS__)
#define DYN_LDS(name) char* name = emu::dyn_lds
#define WAVE_SYNC() emu_wave_sync()
#define SCHED_BARRIER()
#define UNIFORM(x) (x)
#define LAUNDER_V(x)
#define LAUNDER_S(x)
#else
#include <hip/hip_runtime.h>
#include <hip/hip_cooperative_groups.h>
#include <cstdio>
#include <cstdint>
#include <cstring>
#define LAUNCH(k, g, b, l, s, ...) hipLaunchKernelGGL(k, dim3(g), dim3(b), l, s, __VA_ARGS__)
#define DYN_LDS(name) extern __shared__ __attribute__((aligned(16))) char name[]
#define WAVE_SYNC() do { __builtin_amdgcn_s_waitcnt(0xc07f); __builtin_amdgcn_wave_barrier(); } while (0)
#define SCHED_BARRIER() __builtin_amdgcn_sched_barrier(0)
#define UNIFORM(x) __builtin_amdgcn_readfirstlane(x)
#define LAUNDER_V(x) asm volatile("" : "+v"(x))
#define LAUNDER_S(x) asm volatile("" : "+s"(x))
#endif

#ifndef D_MODEL
#define D_MODEL 1024
#endif
#ifndef BATCH
#define BATCH 16
#endif
#ifndef SEQ
#define SEQ 256
#endif
#ifndef DEPTH
#define DEPTH 4
#endif
#ifndef DEC_BATCH
#define DEC_BATCH 2
#endif
#define DEC_SEQ 4096
constexpr int D = D_MODEL;
constexpr int NCTX = BATCH * SEQ, NLAT = DEC_BATCH * DEC_SEQ, NTOK = NCTX + NLAT;
constexpr int NCH_CTX = NCTX / 64, NCH_LAT = NLAT / 64, NCH = NTOK / 64;
constexpr int CPS_CTX = SEQ / 64, CPS_LAT = 64;
constexpr int NSEQ = BATCH + DEC_BATCH, NCOND = 1 + DEC_BATCH;
constexpr int BR = 256, DMIX = 1024;
constexpr int PU = 0, PZ = 256, QKV = 512, DZ = 1280, SU = 1536, SZ = 1792, FU = 2048, FZ = 2304, NPROJ = 2560, NPAD = 2688;
constexpr int D_IN_PROJ = 2576;
constexpr float EPS = 1e-6f;

typedef unsigned short bf16;
typedef float f32x4 __attribute__((ext_vector_type(4)));
typedef short bf16x8 __attribute__((ext_vector_type(8)));
typedef unsigned u32x2 __attribute__((ext_vector_type(2)));
typedef unsigned u32x4 __attribute__((ext_vector_type(4)));

__device__ __forceinline__ unsigned f2u(float f) { return __builtin_bit_cast(unsigned, f); }
__device__ __forceinline__ float u2f(unsigned u) { return __builtin_bit_cast(float, u); }
__device__ __forceinline__ bf16 f2bf(float f) { unsigned u = f2u(f); return (bf16)((u + 0x7fffu + ((u >> 16) & 1u)) >> 16); }
__device__ __forceinline__ float bf2f(bf16 h) { return u2f((unsigned)h << 16); }
__device__ __forceinline__ unsigned pk2(float lo, float hi) { return (unsigned)f2bf(lo) | ((unsigned)f2bf(hi) << 16); }
__device__ __forceinline__ float silu_f(float x) { return x / (1.0f + expf(-x)); }
__device__ __forceinline__ float sigmoid_f(float x) { return 1.0f / (1.0f + expf(-x)); }
__device__ __forceinline__ float softplus_f(float x) { return x > 20.f ? x : log1pf(expf(x)); }
__device__ __forceinline__ float gelu_f(float x) { return 0.5f * x * (1.0f + tanhf(0.7978845608028654f * (x + 0.044715f * x * x * x))); }

template <int MT, int NT>
__device__ __forceinline__ void mma_tiles(f32x4 (&acc)[MT][NT], const bf16* A, int lda, const bf16* B, int ldb, int K, int lane) {
#ifdef EMU
    const int col = lane & 15, rq = (lane >> 4) * 4;
    for (int mt = 0; mt < MT; ++mt) for (int nt = 0; nt < NT; ++nt) for (int r = 0; r < 4; ++r) {
        float s = 0.f; const bf16* a = A + (16 * mt + rq + r) * lda; const bf16* b = B + (16 * nt + col) * ldb;
        for (int k = 0; k < K; ++k) s += bf2f(a[k]) * bf2f(b[k]);
        acc[mt][nt][r] += s;
    }
#else
    const bf16* a0 = A + (lane & 15) * lda + (lane >> 4) * 8;
    const bf16* b0 = B + (lane & 15) * ldb + (lane >> 4) * 8;
    for (int k0 = 0; k0 < K; k0 += 32) {
        bf16x8 a[MT], b[NT];
#pragma unroll
        for (int mt = 0; mt < MT; ++mt) a[mt] = *(const bf16x8*)(a0 + 16 * mt * lda + k0);
#pragma unroll
        for (int nt = 0; nt < NT; ++nt) b[nt] = *(const bf16x8*)(b0 + 16 * nt * ldb + k0);
#pragma unroll
        for (int mt = 0; mt < MT; ++mt)
#pragma unroll
            for (int nt = 0; nt < NT; ++nt) acc[mt][nt] = __builtin_amdgcn_mfma_f32_16x16x32_bf16(a[mt], b[nt], acc[mt][nt], 0, 0, 0);
    }
#endif
}
template <int MT, int NT> __device__ __forceinline__ void zero_acc(f32x4 (&acc)[MT][NT]) {
#pragma unroll
    for (int mt = 0; mt < MT; ++mt)
#pragma unroll
        for (int nt = 0; nt < NT; ++nt) acc[mt][nt] = (f32x4){0.f, 0.f, 0.f, 0.f};
}

struct Params {
    const float *x_prompt, *x_sample, *c, *state_delta, *state_s5, *c_ctx, *w_ada, *b_ada, *norm_g, *w_in, *pool_w, *pool_scale,
        *dn_conv, *dn_a_log, *dn_dt_bias, *dn_norm_g, *s5_a_re, *s5_a_im, *s5_log_dt, *s5_b_re, *s5_b_im, *s5_c_re, *s5_c_im,
        *s5_d, *s5_glu_w, *s5_glu_b, *ft_w, *w_out, *final_g;
    float* out;
    bf16 *winT, *woutT, *ftwT, *gluT, *poolwT, *Cmat, *tabDc, *tabE, *tabT;
    float *ada, *abar, *abar64, *bbar;
    bf16 *hbuf  , *mix, *proj, *fbuf, *ybuf, *obuf, *Zg, *dnAp, *dnQh, *dnBT, *dnOT;
    float *gates, *dnEgl, *s5E, *s5S;
};
constexpr size_t OUT_DN = (size_t)NTOK * D, OUT_S5 = OUT_DN + (size_t)BATCH * DEPTH * 2 * 4 * 64 * 64;
constexpr size_t OUT_TOTAL = OUT_S5 + (size_t)BATCH * DEPTH * 2 * 2 * 16 * 64;

struct Ctx { int tid, lane, wave, vb, nvb; char* smem; };
constexpr int HALF_LDS = 81664;
__device__ __forceinline__ int cond_of(int tok) { return tok < NCTX ? 0 : 1 + (tok - NCTX) / DEC_SEQ; }
__device__ __forceinline__ const float* xrow_in(const Params& p, int l, int tok) {
    if (l == 0) return tok < NCTX ? p.x_prompt + (size_t)tok * D : p.x_sample + (size_t)(tok - NCTX) * D;
    return p.out + (size_t)tok * D;
}

__device__ __forceinline__ void prep_weights_body(const Params& p, size_t gtid, size_t gsz) {
    for (size_t i = gtid; i < (size_t)DEPTH * NPAD * D; i += gsz) {
        int k = (int)(i % D); int n = (int)((i / D) % NPAD); int l = (int)(i / ((size_t)D * NPAD));
        int oc = n < 1536 ? n : (n < NPROJ ? n + 16 : (n < NPROJ + 16 ? 1536 + (n - NPROJ) : -1));
        p.winT[i] = oc < 0 ? (bf16)0 : f2bf(p.w_in[((size_t)l * D + k) * D_IN_PROJ + oc]);
    }
    for (size_t i = gtid; i < (size_t)DEPTH * D * DMIX; i += gsz) {
        int k = (int)(i % DMIX); int n = (int)((i / DMIX) % D); int l = (int)(i / ((size_t)DMIX * D));
        p.woutT[i] = f2bf(p.w_out[((size_t)l * DMIX + k) * D + n]);
    }
    for (size_t i = gtid; i < (size_t)DEPTH * 256 * 256; i += gsz) {
        int k = (int)(i % 256), n = (int)((i / 256) % 256), l = (int)(i / 65536);
        p.ftwT[i] = f2bf(p.ft_w[((size_t)l * 256 + k) * 256 + n]);
        p.gluT[i] = f2bf(p.s5_glu_w[((size_t)l * 256 + k) * 256 + n]);
    }
    for (size_t i = gtid; i < (size_t)DEPTH * 4 * 64 * 64; i += gsz) {
        int c = (int)(i % 64), d = (int)((i / 64) % 64); size_t lg = i / 4096;
        p.poolwT[i] = f2bf(p.pool_w[(lg * 64 + c) * 64 + d]);
    }
    for (size_t i = gtid; i < (size_t)DEPTH * 16 * 16 * 256; i += gsz) {
        int k = (int)(i % 256), pp = (int)((i / 256) % 16), g = (int)((i / 4096) % 16), l = (int)(i / 65536);
        int d = k >> 7, part = (k >> 6) & 1, n = k & 63;
        size_t src = ((((size_t)l * 2 + d) * 16 + g) * 16 + pp) * 64 + n;
        p.Cmat[i] = f2bf(part ? -p.s5_c_im[src] : p.s5_c_re[src]);
    }
    const float TWO_PI = 6.283185307179586f;
    for (size_t i = gtid; i < 128 * 64; i += gsz) {
        int c = (int)(i % 64), n = (int)(i / 64), part = n >> 6, kc = n & 63; int m = (c * kc) & 63;
        float a = TWO_PI * (float)m / 64.f; p.tabDc[i] = f2bf(part ? -sinf(a) : cosf(a));
    }
    for (size_t i = gtid; i < 128 * 128; i += gsz) {
        int kk = (int)(i % 128), n = (int)(i / 128); int pp = n >> 6, k1 = n & 63, pt = kk >> 6, t1 = kk & 63; int m = (t1 * k1) & 63;
        float a = TWO_PI * (float)m / 64.f; float C = cosf(a), S = sinf(a);
        float v = (pp == 0) ? (pt == 0 ? C : S) : (pt == 0 ? -S : C);
        p.tabE[i] = f2bf(v);
    }
    for (size_t i = gtid; i < (size_t)SEQ * 2 * SEQ; i += gsz) {
        int kk = (int)(i % (2 * SEQ)), kt = (int)(i / (2 * SEQ)); int part = kk / SEQ, t = kk % SEQ; int m = (kt * t) % SEQ;
        float a = TWO_PI * (float)m / (float)SEQ; p.tabT[i] = f2bf(part ? sinf(a) : cosf(a));
    }
    for (size_t i = gtid; i < (size_t)DEPTH * 2 * 16 * 64; i += gsz) {
        size_t ldg = i / 64;
        float dt = expf(p.s5_log_dt[ldg]); float are = p.s5_a_re[i], aim = p.s5_a_im[i];
        float mag = expf(are * dt); float abr = mag * cosf(aim * dt), abi = mag * sinf(aim * dt);
        float den = are * are + aim * aim; float nr = abr - 1.0f;
        float cre = (nr * are + abi * aim) / den, cim = (abi * are - nr * aim) / den;
        p.abar[2 * i] = abr; p.abar[2 * i + 1] = abi;
        float pr = abr, pi = abi;
        for (int s = 0; s < 6; ++s) { float t0 = pr * pr - pi * pi, t1 = 2.f * pr * pi; pr = t0; pi = t1; }
        p.abar64[2 * i] = pr; p.abar64[2 * i + 1] = pi;
        for (int pp = 0; pp < 16; ++pp) {
            float bre = p.s5_b_re[i * 16 + pp], bim = p.s5_b_im[i * 16 + pp];
            p.bbar[i * 32 + pp] = cre * bre - cim * bim;
            p.bbar[i * 32 + 16 + pp] = cre * bim + cim * bre;
        }
    }
    for (size_t i = gtid; i < (size_t)DEPTH * 3 * D; i += gsz) {
        int j = (int)(i % (3 * D)), l = (int)(i / (3 * D));
        float acc[NCOND];
        for (int c = 0; c < NCOND; ++c) acc[c] = p.b_ada[(size_t)l * 3 * D + j];
        for (int k = 0; k < D; ++k) {
            float w = p.w_ada[((size_t)l * D + k) * 3 * D + j];
            acc[0] += silu_f(p.c_ctx[k]) * w;
            for (int c = 1; c < NCOND; ++c) acc[c] += silu_f(p.c[(size_t)(c - 1) * D + k]) * w;
        }
        for (int c = 0; c < NCOND; ++c) p.ada[((size_t)l * NCOND + c) * 3 * D + j] = acc[c];
    }
}

__device__ __forceinline__ void norm_mod_body(const Params& p, int l, const Ctx& c) {
    const int lane = c.lane, wave = c.wave;
    for (int tok0 = c.vb * 4; tok0 < NTOK; tok0 += c.nvb * 4) {
        const int tok = tok0 + wave;
        const float* xr = xrow_in(p, l, tok);
        float v[D / 64]; float ss = 0.f;
#pragma unroll
        for (int j = 0; j < D / 64; ++j) { v[j] = xr[j * 64 + lane]; ss += v[j] * v[j]; }
#pragma unroll
        for (int o = 1; o < 64; o <<= 1) ss += __shfl_xor(ss, o);
        const float rs = 1.0f / sqrtf(ss / (float)D + EPS);
        const float* ad = p.ada + ((size_t)l * NCOND + cond_of(tok)) * 3 * D;
        const float* ng = p.norm_g + (size_t)l * D;
#pragma unroll
        for (int j = 0; j < D / 64; ++j) { int i = j * 64 + lane; float h = v[j] * rs * ng[i] * (1.0f + ad[D + i]) + ad[i]; p.hbuf[(size_t)tok * D + i] = f2bf(h); }
    }
}

constexpr int GLD = 40;
constexpr int GEMM_LDS = 2 * 128 * GLD * 2;
template <class Epi>
__device__ __forceinline__ void gemm_body(const bf16* A, int lda, const bf16* B, int ldb, int M, int N, int K, const Epi& epi, const Ctx& c) {
    bf16* As = (bf16*)c.smem; bf16* Bs = As + 128 * GLD;
    const int tid = c.tid, lane = c.lane, wave = c.wave, wr = wave >> 1, wc = wave & 1;
    const int nM = M / 128, nN = N / 128, ntiles = nM * nN;
    for (int _k = 0; _k < ((ntiles) + c.nvb - 1) / c.nvb; ++_k) {
        int tile = c.vb + _k * c.nvb; const bool ghost = tile >= ntiles; if (ghost) tile = ntiles - 1;
        const int tm = tile / nN, tn = tile % nN;
        const bf16* Ag = A + (size_t)tm * 128 * lda; const bf16* Bg = B + (size_t)tn * 128 * ldb;
        f32x4 acc[4][4]; zero_acc(acc);
        u32x4 ra[2], rb[2];
        const int r0 = tid >> 2, ck = tid & 3;
#pragma unroll
        for (int i = 0; i < 2; ++i) { ra[i] = *(const u32x4*)(Ag + (size_t)(r0 + 64 * i) * lda + ck * 8); rb[i] = *(const u32x4*)(Bg + (size_t)(r0 + 64 * i) * ldb + ck * 8); }
        for (int k0 = 0; k0 < K; k0 += 32) {
            __syncthreads();
#pragma unroll
            for (int i = 0; i < 2; ++i) { *(u32x4*)(As + (r0 + 64 * i) * GLD + ck * 8) = ra[i]; *(u32x4*)(Bs + (r0 + 64 * i) * GLD + ck * 8) = rb[i]; }
            __syncthreads();
            if (k0 + 32 < K) {
#pragma unroll
                for (int i = 0; i < 2; ++i) { ra[i] = *(const u32x4*)(Ag + (size_t)(r0 + 64 * i) * lda + k0 + 32 + ck * 8); rb[i] = *(const u32x4*)(Bg + (size_t)(r0 + 64 * i) * ldb + k0 + 32 + ck * 8); }
            }
            mma_tiles<4, 4>(acc, As + wr * 64 * GLD, GLD, Bs + wc * 64 * GLD, GLD, 32, lane);
        }
        if (!ghost) {
#pragma unroll
        for (int mt = 0; mt < 4; ++mt)
#pragma unroll
            for (int nt = 0; nt < 4; ++nt) {
                const int row = tm * 128 + wr * 64 + mt * 16 + (lane >> 4) * 4, col = tn * 128 + wc * 64 + nt * 16 + (lane & 15);
#pragma unroll
                for (int r = 0; r < 4; ++r) epi(row + r, col, acc[mt][nt][r]);
            }
        }
    }
}
struct EpiProj {
    bf16* proj; float* gates;
    __device__ __forceinline__ void operator()(int row, int col, float v) const {
        if (col < NPROJ) proj[(size_t)row * NPROJ + col] = f2bf(v);
        else if (col < NPROJ + 16) gates[(size_t)row * 16 + (col - NPROJ)] = v;
    }
};
struct EpiOut {
    const Params* p; int l;
    __device__ __forceinline__ void operator()(int row, int col, float v) const {
        const float g = p->ada[((size_t)l * NCOND + cond_of(row)) * 3 * D + 2 * D + col];
        const float xi = xrow_in(*p, l, row)[col];
        p->out[(size_t)row * D + col] = xi + g * v;
    }
};
struct EpiGlu {
    const Params* p; int l;
    __device__ __forceinline__ void operator()(int row, int col, float v) const {
        const float y = bf2f(p->ybuf[(size_t)row * 256 + col]);
        const float z = bf2f(p->proj[(size_t)row * NPROJ + SZ + col]);
        p->mix[(size_t)row * DMIX + 512 + col] = f2bf(y * sigmoid_f(v + p->s5_glu_b[l * 256 + col]) * silu_f(z));
    }
};
struct EpiFt {
    const Params* p;
    __device__ __forceinline__ void operator()(int row, int col, float v) const {
        const float z = bf2f(p->proj[(size_t)row * NPROJ + FZ + col]);
        p->mix[(size_t)row * DMIX + 768 + col] = f2bf(v * silu_f(z));
    }
};

constexpr int POOL_LDS = 64 * 264 * 2 + 64 * 66 * 4;
__device__ __forceinline__ void pool_body(const Params& p, int l, const Ctx& c) {
    bf16* Ps = (bf16*)c.smem;
    float* Vs = (float*)(c.smem + 64 * 264 * 2);
    const int tid = c.tid, lane = c.lane, wave = c.wave;
    const int c2 = tid & 31, jg = tid >> 5;
    for (int _k = 0; _k < ((NCH) + c.nvb - 1) / c.nvb; ++_k) {
        int ch = c.vb + _k * c.nvb; if (ch >= (NCH)) ch = (NCH) - 1;
        const bool lat = ch >= NCH_CTX;
        __syncthreads();
        for (int g = 0; g < 4; ++g) {
            const int w = 2 << g, hw = w >> 1;
            const int cofs = PU + g * 64 + 2 * c2;
            if (!lat) {
                const int seq = ch / CPS_CTX, ci = ch % CPS_CTX; const size_t tok_seq = (size_t)seq * SEQ;
                for (int jj = 0; jj < 8; ++jj) {
                    const int j = jg * 8 + jj, t = ci * 64 + j;
                    int lo = t - hw; if (lo < 0) lo = 0; int hi = t - hw + w; if (hi > SEQ) hi = SEQ;
                    float s0 = 0.f, s1 = 0.f;
                    for (int tt = lo; tt < hi; ++tt) { unsigned u = *(const unsigned*)(p.proj + (tok_seq + tt) * NPROJ + cofs); s0 += bf2f((bf16)(u & 0xffff)); s1 += bf2f((bf16)(u >> 16)); }
                    unsigned uc = *(const unsigned*)(p.proj + (tok_seq + t) * NPROJ + cofs);
                    const float inv = 1.0f / (float)(hi - lo);
                    *(unsigned*)(Ps + j * 264 + g * 64 + 2 * c2) = pk2(s0 * inv - bf2f((bf16)(uc & 0xffff)), s1 * inv - bf2f((bf16)(uc >> 16)));
                }
                __syncthreads(); __syncthreads();
            } else {
                const int b = (ch - NCH_CTX) / 64, r = (ch - NCH_CTX) % 64; const size_t tok_b = (size_t)NCTX + (size_t)b * DEC_SEQ;
                int lor = r - hw; if (lor < 0) lor = 0; int hir = r - hw + w; if (hir > 64) hir = 64;
                const float invr = 1.0f / (float)(hir - lor);
                for (int jj = 0; jj < 8; ++jj) {
                    const int col = jg * 8 + jj; float s0 = 0.f, s1 = 0.f;
                    for (int rr = lor; rr < hir; ++rr) { unsigned u = *(const unsigned*)(p.proj + (tok_b + rr * 64 + col) * NPROJ + cofs); s0 += bf2f((bf16)(u & 0xffff)); s1 += bf2f((bf16)(u >> 16)); }
                    Vs[col * 66 + 2 * c2] = s0 * invr; Vs[col * 66 + 2 * c2 + 1] = s1 * invr;
                }
                __syncthreads();
                for (int jj = 0; jj < 8; ++jj) {
                    const int col = jg * 8 + jj;
                    int lo = col - hw; if (lo < 0) lo = 0; int hi = col - hw + w; if (hi > 64) hi = 64;
                    float s0 = 0.f, s1 = 0.f;
                    for (int cc = lo; cc < hi; ++cc) { s0 += Vs[cc * 66 + 2 * c2]; s1 += Vs[cc * 66 + 2 * c2 + 1]; }
                    unsigned uc = *(const unsigned*)(p.proj + (tok_b + r * 64 + col) * NPROJ + cofs);
                    const float inv = 1.0f / (float)(hi - lo);
                    *(unsigned*)(Ps + col * 264 + g * 64 + 2 * c2) = pk2(s0 * inv - bf2f((bf16)(uc & 0xffff)), s1 * inv - bf2f((bf16)(uc >> 16)));
                }
                __syncthreads();
            }
        }
        __syncthreads();
        {
            const int g = wave; f32x4 acc[4][4]; zero_acc(acc);
            mma_tiles<4, 4>(acc, Ps + g * 64, 264, p.poolwT + ((size_t)l * 4 + g) * 4096, 64, 64, lane);
#pragma unroll
            for (int mt = 0; mt < 4; ++mt)
#pragma unroll
                for (int nt = 0; nt < 4; ++nt) {
                    const int d = g * 64 + nt * 16 + (lane & 15); const float sc = p.pool_scale[l * 256 + d];
#pragma unroll
                    for (int r = 0; r < 4; ++r) {
                        const size_t tok = (size_t)ch * 64 + mt * 16 + (lane >> 4) * 4 + r;
                        const float z = bf2f(p.proj[tok * NPROJ + PZ + d]);
                        p.mix[tok * DMIX + d] = f2bf(acc[mt][nt][r] * sc * silu_f(z));
                    }
                }
        }
    }
}

constexpr int FTC_ULD = 72, FTC_GLD = SEQ + 8;
constexpr int FTC_LDS = SEQ * FTC_ULD * 2 + 64 * FTC_GLD * 2;
__device__ __forceinline__ void ft_ctx_body(const Params& p, const Ctx& c) {
    bf16* Us = (bf16*)c.smem;
    bf16* GT = Us + SEQ * FTC_ULD;
    const int tid = c.tid, lane = c.lane, wave = c.wave;
    constexpr int MTW = SEQ / 64;
    for (int _k = 0; _k < ((BATCH * 4) + c.nvb - 1) / c.nvb; ++_k) {
        int item = c.vb + _k * c.nvb; if (item >= (BATCH * 4)) item = (BATCH * 4) - 1;
        const int b = item >> 2, h = item & 3;
        __syncthreads();
        for (int i = tid; i < SEQ * 8; i += 256) { const int t = i >> 3, ck = i & 7; *(u32x4*)(Us + t * FTC_ULD + ck * 8) = *(const u32x4*)(p.proj + ((size_t)b * SEQ + t) * NPROJ + FU + h * 64 + ck * 8); }
        __syncthreads();
        f32x4 facc[MTW][4]; zero_acc(facc);
        for (int part = 0; part < 2; ++part) {
#pragma unroll 1
            for (int nh = 0; nh < 2; ++nh) {
                f32x4 g[MTW][2]; zero_acc(g);
                mma_tiles<MTW, 2>(g, Us + wave * (SEQ / 4) * FTC_ULD, FTC_ULD, p.tabDc + (part * 64 + nh * 32) * 64, 64, 64, lane);
#pragma unroll
                for (int mt = 0; mt < MTW; ++mt)
#pragma unroll
                    for (int nt = 0; nt < 2; ++nt) {
                        const int kc = nh * 32 + nt * 16 + (lane & 15), t0 = wave * (SEQ / 4) + mt * 16 + (lane >> 4) * 4;
                        u32x2 w; w.x = pk2(g[mt][nt][0], g[mt][nt][1]); w.y = pk2(g[mt][nt][2], g[mt][nt][3]);
                        *(u32x2*)(GT + kc * FTC_GLD + t0) = w;
                    }
            }
            __syncthreads();
            mma_tiles<MTW, 4>(facc, p.tabT + (size_t)(wave * (SEQ / 4)) * 2 * SEQ + part * SEQ, 2 * SEQ, GT, FTC_GLD, SEQ, lane);
            __syncthreads();
        }
        const float sc = 1.0f / sqrtf((float)SEQ * 64.f);
#pragma unroll
        for (int mt = 0; mt < MTW; ++mt)
#pragma unroll
            for (int nt = 0; nt < 4; ++nt)
#pragma unroll
                for (int r = 0; r < 4; ++r) {
                    const int kt = wave * (SEQ / 4) + mt * 16 + (lane >> 4) * 4 + r, kc = nt * 16 + (lane & 15);
                    p.fbuf[((size_t)b * SEQ + kt) * 256 + h * 64 + kc] = f2bf(facc[mt][nt][r] * sc);
                }
    }
}

constexpr int FTA_LDS = 64 * 264 * 2 + 64 * 136 * 2;
__device__ __forceinline__ void ft_latA_body(const Params& p, const Ctx& c) {
    bf16* Xs = (bf16*)c.smem;
    bf16* Z1T = Xs + 64 * 264;
    const int tid = c.tid, lane = c.lane, wave = c.wave;
    for (int _k = 0; _k < ((DEC_BATCH * 64) + c.nvb - 1) / c.nvb; ++_k) {
        int item = c.vb + _k * c.nvb; if (item >= (DEC_BATCH * 64)) item = (DEC_BATCH * 64) - 1;
        const int b = item >> 6, t2 = item & 63;
        __syncthreads();
        for (int i = tid; i < 64 * 32; i += 256) { const int t1 = i >> 5, ck = i & 31; *(u32x4*)(Xs + t1 * 264 + ck * 8) = *(const u32x4*)(p.proj + ((size_t)NCTX + (size_t)b * DEC_SEQ + t1 * 64 + t2) * NPROJ + FU + ck * 8); }
        __syncthreads();
        for (int h = 0; h < 4; ++h) {
            {
                f32x4 a[4][2]; zero_acc(a);
                mma_tiles<4, 2>(a, Xs + h * 64, 264, p.tabDc + wave * 32 * 64, 64, 64, lane);
#pragma unroll
                for (int mt = 0; mt < 4; ++mt)
#pragma unroll
                    for (int nt = 0; nt < 2; ++nt) {
                        const int n = wave * 32 + nt * 16 + (lane & 15), part = n >> 6, kc = n & 63, t10 = mt * 16 + (lane >> 4) * 4;
                        u32x2 w; w.x = pk2(a[mt][nt][0], a[mt][nt][1]); w.y = pk2(a[mt][nt][2], a[mt][nt][3]);
                        *(u32x2*)(Z1T + kc * 136 + part * 64 + t10) = w;
                    }
            }
            __syncthreads();
            {
                f32x4 z[1][8]; zero_acc(z);
                mma_tiles<1, 8>(z, Z1T + wave * 16 * 136, 136, p.tabE, 128, 128, lane);
#pragma unroll
                for (int nt = 0; nt < 4; ++nt) {
                    const int k1 = nt * 16 + (lane & 15); const int m = (t2 * k1) & 4095;
                    const float ang = 6.283185307179586f * (float)m / 4096.f; const float tc = cosf(ang), ts = sinf(ang);
#pragma unroll
                    for (int r = 0; r < 4; ++r) {
                        const int kc = wave * 16 + (lane >> 4) * 4 + r; const float a = z[0][nt][r], bb = z[0][nt + 4][r];
                        bf16* dst = p.Zg + ((((size_t)b * 64 + k1) * 256 + h * 64 + kc) * 128) + t2;
                        dst[0] = f2bf(a * tc + bb * ts); dst[64] = f2bf(bb * tc - a * ts);
                    }
                }
            }
            __syncthreads();
        }
    }
}

__device__ __forceinline__ void ft_latB_body(const Params& p, const Ctx& c) {
    const int lane = c.lane, wave = c.wave;
    for (int item = c.vb; item < DEC_BATCH * 64; item += c.nvb) {
        const int b = item >> 6, k1 = item & 63;
        f32x4 acc[4][4]; zero_acc(acc);
        mma_tiles<4, 4>(acc, p.tabE, 128, p.Zg + (((size_t)b * 64 + k1) * 256 + wave * 64) * 128, 128, 128, lane);
#pragma unroll
        for (int mt = 0; mt < 4; ++mt)
#pragma unroll
            for (int nt = 0; nt < 4; ++nt)
#pragma unroll
                for (int r = 0; r < 4; ++r) {
                    const int k2 = mt * 16 + (lane >> 4) * 4 + r, n = wave * 64 + nt * 16 + (lane & 15);
                    p.fbuf[((size_t)NCTX + (size_t)b * DEC_SEQ + k1 + 64 * k2) * 256 + n] = f2bf(acc[mt][nt][r] * (1.0f / 512.f));
                }
    }
}

constexpr int S5P1_LDS = 4 * 64 * 16 * 4;
__device__ __forceinline__ void s5_pass1_body(const Params& p, int l, const Ctx& c) {
    const int lane = c.lane, wave = c.wave;
    float* uS = (float*)c.smem + wave * 1024;
    for (int it0 = c.vb * 4; it0 < NCH * 32; it0 += c.nvb * 4) {
        const int item = it0 + wave; const int d = item & 1, g = (item >> 1) & 15, ch = item >> 5;
        WAVE_SYNC();
        for (int i = lane; i < 1024; i += 64) { const int t = i >> 4, pp = i & 15; uS[i] = bf2f(p.proj[((size_t)ch * 64 + t) * NPROJ + SU + g * 16 + pp]); }
        WAVE_SYNC();
        const size_t pi = (((size_t)l * 2 + d) * 16 + g) * 64 + lane;
        const float ar = p.abar[2 * pi], ai = p.abar[2 * pi + 1];
        float bre[16], bim[16];
#pragma unroll
        for (int pp = 0; pp < 16; ++pp) { bre[pp] = p.bbar[pi * 32 + pp]; bim[pp] = p.bbar[pi * 32 + 16 + pp]; }
        float sr = 0.f, si = 0.f;
        for (int tau = 0; tau < 64; ++tau) {
            const int t = d ? 63 - tau : tau; float br = 0.f, bi = 0.f;
#pragma unroll
            for (int pp = 0; pp < 16; ++pp) { const float u = uS[t * 16 + pp]; br += bre[pp] * u; bi += bim[pp] * u; }
            const float nr = ar * sr - ai * si + br, ni = ar * si + ai * sr + bi; sr = nr; si = ni;
        }
        float* E = p.s5E + (((size_t)ch * 16 + g) * 2 + d) * 128;
        E[lane] = sr; E[64 + lane] = si;
    }
}
__device__ __forceinline__ void s5_carry_body(const Params& p, int l, const Ctx& c) {
    for (int i = c.vb * 256 + c.tid; i < NSEQ * 16 * 2 * 64; i += c.nvb * 256) {
        const int n = i & 63, d = (i >> 6) & 1, g = (i >> 7) & 15, seq = i >> 11;
        const bool lat = seq >= BATCH; const int cps = lat ? CPS_LAT : CPS_CTX; const int ch0 = lat ? NCH_CTX + (seq - BATCH) * CPS_LAT : seq * CPS_CTX;
        const size_t pi = (((size_t)l * 2 + d) * 16 + g) * 64 + n;
        const float ar = p.abar64[2 * pi], ai = p.abar64[2 * pi + 1];
        float sr = 0.f, si = 0.f;
        if (lat) { const size_t o = ((((size_t)(seq - BATCH) * DEPTH + l) * 2 + d) * 2) * 1024 + g * 64 + n; sr = p.state_s5[o]; si = p.state_s5[o + 1024]; }
        for (int q = 0; q < cps; ++q) {
            const int ch = ch0 + (d ? cps - 1 - q : q);
            const size_t e = (((size_t)ch * 16 + g) * 2 + d) * 128 + n;
            p.s5S[e] = sr; p.s5S[e + 64] = si;
            const float er = p.s5E[e], ei = p.s5E[e + 64];
            const float nr = ar * sr - ai * si + er, ni = ar * si + ai * sr + ei; sr = nr; si = ni;
        }
        if (!lat) { const size_t o = OUT_S5 + ((((size_t)seq * DEPTH + l) * 2 + d) * 2) * 1024 + g * 64 + n; p.out[o] = sr; p.out[o + 1024] = si; }
    }
}
constexpr int S5P3_LDS = 2 * 64 * 264 * 2 + 2 * 64 * 16 * 4;
__device__ __forceinline__ void s5_pass3_body(const Params& p, int l, const Ctx& c) {
    const int tid = c.tid, lane = c.lane, wave = c.wave, il = wave >> 1, d = wave & 1;
    bf16* Ss = (bf16*)c.smem + il * 64 * 264;
    float* uS = (float*)(c.smem + 2 * 64 * 264 * 2) + il * 1024;
    for (int _k = 0; _k < ((NCH * 8) + c.nvb - 1) / c.nvb; ++_k) {
        int grp = c.vb + _k * c.nvb; if (grp >= (NCH * 8)) grp = (NCH * 8) - 1;
        const int item = grp * 2 + il; const int g = item & 15, ch = item >> 4;
        __syncthreads();
        for (int i = (tid & 127); i < 1024; i += 128) { const int t = i >> 4, pp = i & 15; uS[i] = bf2f(p.proj[((size_t)ch * 64 + t) * NPROJ + SU + g * 16 + pp]); }
        __syncthreads();
        const size_t pi = (((size_t)l * 2 + d) * 16 + g) * 64 + lane;
        const float ar = p.abar[2 * pi], ai = p.abar[2 * pi + 1];
        float bre[16], bim[16];
#pragma unroll
        for (int pp = 0; pp < 16; ++pp) { bre[pp] = p.bbar[pi * 32 + pp]; bim[pp] = p.bbar[pi * 32 + 16 + pp]; }
        const size_t e = (((size_t)ch * 16 + g) * 2 + d) * 128 + lane;
        float sr = p.s5S[e], si = p.s5S[e + 64];
        for (int tau = 0; tau < 64; ++tau) {
            const int t = d ? 63 - tau : tau; float br = 0.f, bi = 0.f;
#pragma unroll
            for (int pp = 0; pp < 16; ++pp) { const float u = uS[t * 16 + pp]; br += bre[pp] * u; bi += bim[pp] * u; }
            const float nr = ar * sr - ai * si + br, ni = ar * si + ai * sr + bi; sr = nr; si = ni;
            Ss[t * 264 + d * 128 + lane] = f2bf(sr); Ss[t * 264 + d * 128 + 64 + lane] = f2bf(si);
        }
        __syncthreads();
        f32x4 acc[2][1]; zero_acc(acc);
        mma_tiles<2, 1>(acc, Ss + d * 32 * 264, 264, p.Cmat + ((size_t)l * 16 + g) * 4096, 256, 256, lane);
#pragma unroll
        for (int mt = 0; mt < 2; ++mt)
#pragma unroll
            for (int r = 0; r < 4; ++r) {
                const int t = d * 32 + mt * 16 + (lane >> 4) * 4 + r, pp = lane & 15;
                const float y = acc[mt][0][r] + p.s5_d[l * 256 + g * 16 + pp] * uS[t * 16 + pp];
                p.ybuf[((size_t)ch * 64 + t) * 256 + g * 16 + pp] = f2bf(gelu_f(y));
            }
    }
}

constexpr int DN_STG = 0;
constexpr int DN_S1 = 0, DN_S2 = 18432;
constexpr int DN_AB = 36864;
constexpr int DN_QB = DN_AB + 9216, DN_KB = DN_QB + 9216, DN_VB = DN_KB + 9216;
constexpr int DN_SM = DN_VB + 8192;
constexpr int DN1_LDS = DN_SM + 5 * 64 * 4;
static_assert(DN1_LDS <= HALF_LDS, "DN1 LDS");
__device__ __forceinline__ void dn_d1_body(const Params& p, int l, const Ctx& c) {
    char* smem = c.smem;
    float* stq = (float*)(smem + DN_STG); float* stk = stq + 64 * 65;
    bf16* S1 = (bf16*)(smem + DN_S1); bf16* S2 = (bf16*)(smem + DN_S2);
    bf16* Ab = (bf16*)(smem + DN_AB); float* Rb = (float*)(smem + DN_VB);
    bf16* Qb = (bf16*)(smem + DN_QB); bf16* Kb = (bf16*)(smem + DN_KB); bf16* Vb = (bf16*)(smem + DN_VB);
    float* rq = (float*)(smem + DN_SM); float* rk = rq + 64; float* gs = rk + 64; float* bs = gs + 64; float* gcs = bs + 64;
    const int wave = c.wave;
    for (int _k = 0; _k < ((NCH * 8) + c.nvb - 1) / c.nvb; ++_k) {
        int item = c.vb + _k * c.nvb; if (item >= (NCH * 8)) item = (NCH * 8) - 1;
        int tid = c.tid; LAUNDER_V(tid); const int lane = tid & 63;
        const int d = item & 1, h = (item >> 1) & 3, ch = item >> 3;
        const bool lat = ch >= NCH_CTX;
        const int cps = lat ? CPS_LAT : CPS_CTX; const int ci = lat ? (ch - NCH_CTX) % CPS_LAT : ch % CPS_CTX;
        const int lseq = cps * 64; const size_t tok_seq = (size_t)(ch - ci) * 64;
        __syncthreads();
        {
            const int cc = lane, tq = wave;
#pragma unroll
            for (int arr = 0; arr < 3; ++arr) {
                const int chn = arr * 256 + h * 64 + cc; float wv[5];
#pragma unroll
                for (int j = 0; j < 5; ++j) wv[j] = p.dn_conv[((size_t)l * 5 + j) * 768 + chn];
                float in[20];
#pragma unroll
                for (int i = 0; i < 20; ++i) { const int pos = ci * 64 + tq * 16 + i - 2; in[i] = (pos >= 0 && pos < lseq) ? bf2f(p.proj[(tok_seq + pos) * NPROJ + QKV + chn]) : 0.f; }
#pragma unroll
                for (int i = 0; i < 16; ++i) {
                    float s = 0.f;
#pragma unroll
                    for (int j = 0; j < 5; ++j) s += wv[j] * in[i + j];
                    s = silu_f(s);
                    const int jt = tq * 16 + i, tau = d ? 63 - jt : jt;
                    if (arr == 0) stq[tau * 65 + cc] = s; else if (arr == 1) stk[tau * 65 + cc] = s; else Vb[tau * 64 + cc] = f2bf(s);
                }
            }
        }
        __syncthreads();
        if (tid < 128) {
            const float* st = tid < 64 ? stq : stk; const int t = tid & 63; float ss = 0.f;
            for (int q = 0; q < 64; ++q) { const float v = st[t * 65 + q]; ss += v * v; }
            (tid < 64 ? rq : rk)[t] = 1.0f / sqrtf(ss + EPS);
        } else if (tid < 192) {
            const int tau = tid - 128; const size_t tok = (size_t)ch * 64 + (d ? 63 - tau : tau);
            const float braw = p.gates[tok * 16 + d * 4 + h], araw = p.gates[tok * 16 + 8 + d * 4 + h];
            bs[tau] = sigmoid_f(braw);
            gs[tau] = -expf(p.dn_a_log[(l * 2 + d) * 4 + h]) * softplus_f(araw + p.dn_dt_bias[(l * 2 + d) * 4 + h]);
        }
        __syncthreads();
        {
            const int cc = lane;
            for (int t = wave * 16; t < wave * 16 + 16; ++t) { Qb[t * 72 + cc] = f2bf(stq[t * 65 + cc] * rq[t]); Kb[t * 72 + cc] = f2bf(stk[t * 65 + cc] * rk[t]); }
            if (tid == 0) { float a = 0.f; for (int t = 0; t < 64; ++t) { a += gs[t]; gcs[t] = a; } }
        }
        __syncthreads();
        const float gl = gcs[63];
        {
            f32x4 kk[1][4], qk[1][4]; zero_acc(kk); zero_acc(qk);
            mma_tiles<1, 4>(kk, Kb + wave * 16 * 72, 72, Kb, 72, 64, lane);
            mma_tiles<1, 4>(qk, Qb + wave * 16 * 72, 72, Kb, 72, 64, lane);
            __syncthreads();
#pragma unroll
            for (int nt = 0; nt < 4; ++nt)
#pragma unroll
                for (int r = 0; r < 4; ++r) {
                    const int tau = wave * 16 + (lane >> 4) * 4 + r, sg = nt * 16 + (lane & 15);
                    const float dec = sg <= tau ? expf(gcs[tau] - gcs[sg]) : 0.f;
                    Ab[tau * 72 + sg] = f2bf(sg < tau ? -kk[0][nt][r] * dec * bs[tau] : 0.f);
                    S1[(64 + tau) * 72 + sg] = f2bf(qk[0][nt][r] * 0.125f * dec);
                }
            for (int i = tid; i < 18432 / 16; i += 256) *(u32x4*)((char*)S2 + i * 16) = (u32x4){0u, 0u, 0u, 0u};
            const int tau = lane;
            const float kd = expf(gl - gcs[tau]);
            for (int dk = wave * 16; dk < wave * 16 + 16; ++dk) S1[dk * 72 + tau] = f2bf(bf2f(Kb[tau * 72 + dk]) * kd);
        }
        __syncthreads();
        {
            f32x4 rhs[4][2];
#pragma unroll
            for (int I = 0; I < 4; ++I)
#pragma unroll
                for (int nt = 0; nt < 2; ++nt)
#pragma unroll
                    for (int r = 0; r < 4; ++r) {
                        const int tau = I * 16 + (lane >> 4) * 4 + r, col = wave * 32 + nt * 16 + (lane & 15);
                        rhs[I][nt][r] = wave < 2 ? bf2f(Kb[tau * 72 + col]) * (bs[tau] * expf(gcs[tau])) : bf2f(Vb[tau * 64 + col - 64]) * bs[tau];
                    }
            __syncthreads();
#pragma unroll
            for (int I = 0; I < 4; ++I) {
                f32x4 acc[1][2]; acc[0][0] = rhs[I][0]; acc[0][1] = rhs[I][1];
                mma_tiles<1, 2>(acc, Ab + I * 16 * 72, 72, S2 + wave * 32 * 72, 72, 64, lane);
#pragma unroll
                for (int nt = 0; nt < 2; ++nt)
#pragma unroll
                    for (int r = 0; r < 4; ++r) Rb[((lane >> 4) * 4 + r) * 128 + wave * 32 + nt * 16 + (lane & 15)] = acc[0][nt][r];
                __syncthreads();
                if (tid < 128) {
                    const int col = tid; float x[16];
#pragma unroll
                    for (int r = 0; r < 16; ++r) x[r] = Rb[r * 128 + col];
#pragma unroll
                    for (int r = 1; r < 16; ++r) {
                        const bf16* ar = Ab + (I * 16 + r) * 72 + I * 16;
#pragma unroll
                        for (int k = 0; k < r; ++k) x[r] += bf2f(ar[k]) * x[k];
                    }
                    u32x4 w0, w1;
                    w0.x = pk2(x[0], x[1]); w0.y = pk2(x[2], x[3]); w0.z = pk2(x[4], x[5]); w0.w = pk2(x[6], x[7]);
                    w1.x = pk2(x[8], x[9]); w1.y = pk2(x[10], x[11]); w1.z = pk2(x[12], x[13]); w1.w = pk2(x[14], x[15]);
                    *(u32x4*)(S2 + col * 72 + I * 16) = w0; *(u32x4*)(S2 + col * 72 + I * 16 + 8) = w1;
                }
                __syncthreads();
            }
        }
        __syncthreads();
        {
            const size_t ib = (size_t)item * 4096;
#pragma unroll 1
            for (int half = 0; half < 2; ++half) {
                f32x4 acc[2][4]; zero_acc(acc);
                mma_tiles<2, 4>(acc, S1 + wave * 32 * 72, 72, S2 + half * 64 * 72, 72, 64, lane);
#pragma unroll
                for (int mt = 0; mt < 2; ++mt)
#pragma unroll
                    for (int nt = 0; nt < 4; ++nt) {
                        const int row0 = wave * 32 + mt * 16 + (lane >> 4) * 4, cx = nt * 16 + (lane & 15);
                        if (half == 0) {
                            if (row0 < 64) { for (int r = 0; r < 4; ++r) p.dnAp[ib + (row0 + r) * 64 + cx] = f2bf(-acc[mt][nt][r]); }
                            else { const int t0 = row0 - 64; for (int r = 0; r < 4; ++r) { const int tau = t0 + r; const float qe = bf2f(Qb[tau * 72 + cx]) * 0.125f * expf(gcs[tau]); p.dnQh[ib + tau * 64 + cx] = f2bf(qe - acc[mt][nt][r]); } }
                        } else {
                            u32x2 w; w.x = pk2(acc[mt][nt][0], acc[mt][nt][1]); w.y = pk2(acc[mt][nt][2], acc[mt][nt][3]);
                            if (row0 < 64) *(u32x2*)(p.dnBT + ib + cx * 64 + row0) = w;
                            else *(u32x2*)(p.dnOT + ib + cx * 64 + (row0 - 64)) = w;
                        }
                    }
            }
            if (tid == 0) p.dnEgl[item] = expf(gl);
        }
    }
}
constexpr int DN2_LDS = 64 * 72 * 2;
__device__ __forceinline__ void dn_scan_body(const Params& p, int l, const Ctx& c) {
    bf16* ST = (bf16*)c.smem;
    const int lane = c.lane, wave = c.wave;
    for (int chain = c.vb; chain < NSEQ * 8; chain += c.nvb) {
        const int d = chain & 1, h = (chain >> 1) & 3, seq = chain >> 3;
        const bool lat = seq >= BATCH; const int cps = lat ? CPS_LAT : CPS_CTX; const int ch0 = lat ? NCH_CTX + (seq - BATCH) * CPS_LAT : seq * CPS_CTX;
        const int dv = wave * 16 + (lane & 15);
        f32x4 S[4][1];
#pragma unroll
        for (int mt = 0; mt < 4; ++mt)
#pragma unroll
            for (int r = 0; r < 4; ++r) {
                const int dk = mt * 16 + (lane >> 4) * 4 + r;
                S[mt][0][r] = lat ? p.state_delta[(((((size_t)(seq - BATCH) * DEPTH + l) * 2 + d) * 4 + h) * 64 + dk) * 64 + dv] : 0.f;
            }
        for (int q = 0; q < cps; ++q) {
            const int ch = ch0 + (d ? cps - 1 - q : q); const int item = (ch * 4 + h) * 2 + d; const size_t ib = (size_t)item * 4096;
            WAVE_SYNC();
#pragma unroll
            for (int mt = 0; mt < 4; ++mt) { u32x2 w; w.x = pk2(S[mt][0][0], S[mt][0][1]); w.y = pk2(S[mt][0][2], S[mt][0][3]); *(u32x2*)(ST + dv * 72 + mt * 16 + (lane >> 4) * 4) = w; }
            WAVE_SYNC();
            const float egl = p.dnEgl[item];
            f32x4 Sn[4][1], O[4][1];
#pragma unroll
            for (int mt = 0; mt < 4; ++mt) {
                const int r0 = mt * 16 + (lane >> 4) * 4;
                const u32x2 wb = *(const u32x2*)(p.dnBT + ib + dv * 64 + r0), wo = *(const u32x2*)(p.dnOT + ib + dv * 64 + r0);
                Sn[mt][0][0] = egl * S[mt][0][0] + bf2f((bf16)(wb.x & 0xffff)); Sn[mt][0][1] = egl * S[mt][0][1] + bf2f((bf16)(wb.x >> 16));
                Sn[mt][0][2] = egl * S[mt][0][2] + bf2f((bf16)(wb.y & 0xffff)); Sn[mt][0][3] = egl * S[mt][0][3] + bf2f((bf16)(wb.y >> 16));
                O[mt][0][0] = bf2f((bf16)(wo.x & 0xffff)); O[mt][0][1] = bf2f((bf16)(wo.x >> 16)); O[mt][0][2] = bf2f((bf16)(wo.y & 0xffff)); O[mt][0][3] = bf2f((bf16)(wo.y >> 16));
            }
            mma_tiles<4, 1>(Sn, p.dnAp + ib, 64, ST + wave * 16 * 72, 72, 64, lane);
            mma_tiles<4, 1>(O, p.dnQh + ib, 64, ST + wave * 16 * 72, 72, 64, lane);
#pragma unroll
            for (int mt = 0; mt < 4; ++mt)
#pragma unroll
                for (int r = 0; r < 4; ++r) {
                    const int tau = mt * 16 + (lane >> 4) * 4 + r; const size_t tok = (size_t)ch * 64 + (d ? 63 - tau : tau);
                    p.obuf[((size_t)d * NTOK + tok) * 256 + h * 64 + dv] = f2bf(O[mt][0][r]);
                    S[mt][0][r] = Sn[mt][0][r];
                }
        }
        if (!lat) {
#pragma unroll
            for (int mt = 0; mt < 4; ++mt)
#pragma unroll
                for (int r = 0; r < 4; ++r) {
                    const int dk = mt * 16 + (lane >> 4) * 4 + r;
                    p.out[OUT_DN + (((((size_t)seq * DEPTH + l) * 2 + d) * 4 + h) * 64 + dk) * 64 + dv] = S[mt][0][r];
                }
        }
    }
}
__device__ __forceinline__ void dn_d3_body(const Params& p, int l, const Ctx& c) {
    for (int i = c.vb * 256 + c.tid; i < NTOK * 4; i += c.nvb * 256) {
        const int h = i & 3; const size_t tok = i >> 2;
        const bf16* o0 = p.obuf + tok * 256 + h * 64; const bf16* o1 = p.obuf + ((size_t)NTOK + tok) * 256 + h * 64;
        float v[64]; float ss = 0.f;
#pragma unroll
        for (int q = 0; q < 64; ++q) { v[q] = bf2f(o0[q]) + bf2f(o1[q]); ss += v[q] * v[q]; }
        const float rs = 1.0f / sqrtf(ss / 64.f + EPS);
#pragma unroll
        for (int q = 0; q < 64; ++q) {
            const float z = bf2f(p.proj[tok * NPROJ + DZ + h * 64 + q]);
            p.mix[tok * DMIX + 256 + h * 64 + q] = f2bf(v[q] * rs * p.dn_norm_g[l * 64 + q] * silu_f(z));
        }
    }
}

__device__ __forceinline__ void final_norm_body(const Params& p, const Ctx& c) {
    const int lane = c.lane, wave = c.wave;
    for (int tok0 = c.vb * 4; tok0 < NTOK; tok0 += c.nvb * 4) {
        float* xr = p.out + (size_t)(tok0 + wave) * D;
        float v[D / 64]; float ss = 0.f;
#pragma unroll
        for (int j = 0; j < D / 64; ++j) { v[j] = xr[j * 64 + lane]; ss += v[j] * v[j]; }
#pragma unroll
        for (int o = 1; o < 64; o <<= 1) ss += __shfl_xor(ss, o);
        const float rs = 1.0f / sqrtf(ss / (float)D + EPS);
#pragma unroll
        for (int j = 0; j < D / 64; ++j) xr[j * 64 + lane] = v[j] * rs * p.final_g[j * 64 + lane];
    }
}

enum { PH_PREP = 0, PH_NORM, PH_GEMM_IN, PH_LOCAL, PH_SCAN, PH_POST, PH_POST2, PH_GEMM_OUT, PH_FINAL };
__device__ __forceinline__ Ctx make_ctx(char* smem) {
    Ctx c; const int hb = UNIFORM((int)(threadIdx.x >> 8));
    c.tid = threadIdx.x & 255; c.lane = c.tid & 63; c.wave = UNIFORM(c.tid >> 6); c.vb = blockIdx.x * 2 + hb; c.nvb = gridDim.x * 2; c.smem = smem + hb * HALF_LDS;
    return c;
}
__device__ __forceinline__ Ctx shifted(const Ctx& c, int by) { Ctx s = c; s.vb = (c.vb + c.nvb - (by % c.nvb)) % c.nvb; return s; }
__device__ __forceinline__ void run_phase(const Params& p, int ph, int l, const Ctx& c0) {
    Ctx c = c0;
    LAUNDER_V(c.tid); c.lane = c.tid & 63; c.wave = UNIFORM(c.tid >> 6); LAUNDER_S(c.vb); LAUNDER_S(l);
    switch (ph) {
    case PH_PREP: prep_weights_body(p, (size_t)c.vb * 256 + c.tid, (size_t)c.nvb * 256); break;
    case PH_NORM: norm_mod_body(p, l, c); break;
    case PH_GEMM_IN: { EpiProj e{p.proj, p.gates}; gemm_body(p.hbuf, D, p.winT + (size_t)l * NPAD * D, D, NTOK, NPAD, D, e, c); } break;
    case PH_LOCAL:
        dn_d1_body(p, l, c); __syncthreads();
        pool_body(p, l, c); __syncthreads();
        ft_ctx_body(p, c); __syncthreads();
        ft_latA_body(p, c); __syncthreads();
        s5_pass1_body(p, l, c);
        break;
    case PH_SCAN:
        dn_scan_body(p, l, c);
        ft_latB_body(p, shifted(c, NSEQ * 8));
        s5_carry_body(p, l, shifted(c, NSEQ * 8 + DEC_BATCH * 64));
        break;
    case PH_POST: s5_pass3_body(p, l, c); dn_d3_body(p, l, c); break;
    case PH_POST2: {
        EpiGlu eg{&p, l}; gemm_body(p.ybuf, 256, p.gluT + (size_t)l * 65536, 256, NTOK, 256, 256, eg, c); __syncthreads();
        EpiFt ef{&p}; gemm_body(p.fbuf, 256, p.ftwT + (size_t)l * 65536, 256, NTOK, 256, 256, ef, c);
    } break;
    case PH_GEMM_OUT: { EpiOut e{&p, l}; gemm_body(p.mix, DMIX, p.woutT + (size_t)l * D * DMIX, DMIX, NTOK, D, DMIX, e, c); } break;
    case PH_FINAL: final_norm_body(p, c); break;
    }
}
constexpr int MEGA_LDS = 2 * HALF_LDS;
#ifdef EMU
__global__ void __launch_bounds__(512) k_phase(Params p, int ph, int l) { DYN_LDS(smem); const Ctx c = make_ctx(smem); run_phase(p, ph, l, c); }
#else
namespace cg = cooperative_groups;
__global__ void __launch_bounds__(512) k_mega(Params p) {
    DYN_LDS(smem);
    cg::grid_group grid = cg::this_grid();
    const Ctx c = make_ctx(smem);
    run_phase(p, PH_PREP, 0, c); grid.sync();
#pragma unroll 1
    for (int l = 0; l < DEPTH; ++l) {
        run_phase(p, PH_NORM, l, c); grid.sync();
        run_phase(p, PH_GEMM_IN, l, c); grid.sync();
        run_phase(p, PH_LOCAL, l, c); grid.sync();
        run_phase(p, PH_SCAN, l, c); grid.sync();
        run_phase(p, PH_POST, l, c); grid.sync();
        run_phase(p, PH_POST2, l, c); grid.sync();
        run_phase(p, PH_GEMM_OUT, l, c); grid.sync();
    }
    run_phase(p, PH_FINAL, 0, c);
}
#endif

static size_t ws_carve(Params& p, char* ws) {
    size_t off = 0;
    auto take = [&](size_t bytes) { size_t o = off; off += (bytes + 255) & ~(size_t)255; return ws ? ws + o : (char*)nullptr; };
    p.winT = (bf16*)take((size_t)DEPTH * NPAD * D * 2);
    p.woutT = (bf16*)take((size_t)DEPTH * D * DMIX * 2);
    p.ftwT = (bf16*)take((size_t)DEPTH * 65536 * 2);
    p.gluT = (bf16*)take((size_t)DEPTH * 65536 * 2);
    p.poolwT = (bf16*)take((size_t)DEPTH * 4 * 4096 * 2);
    p.Cmat = (bf16*)take((size_t)DEPTH * 16 * 4096 * 2);
    p.tabDc = (bf16*)take(128 * 64 * 2);
    p.tabE = (bf16*)take(128 * 128 * 2);
    p.tabT = (bf16*)take((size_t)SEQ * 2 * SEQ * 2);
    p.ada = (float*)take((size_t)DEPTH * NCOND * 3 * D * 4);
    p.abar = (float*)take((size_t)DEPTH * 2 * 16 * 64 * 2 * 4);
    p.abar64 = (float*)take((size_t)DEPTH * 2 * 16 * 64 * 2 * 4);
    p.bbar = (float*)take((size_t)DEPTH * 2 * 16 * 64 * 32 * 4);
    p.hbuf = (bf16*)take((size_t)NTOK * DMIX * 2);
    p.mix = p.hbuf;
    p.proj = (bf16*)take((size_t)NTOK * NPROJ * 2);
    p.fbuf = (bf16*)take((size_t)NTOK * 256 * 2);
    p.ybuf = (bf16*)take((size_t)NTOK * 256 * 2);
    p.obuf = (bf16*)take((size_t)2 * NTOK * 256 * 2);
    p.Zg = (bf16*)take((size_t)DEC_BATCH * 64 * 256 * 128 * 2);
    p.dnAp = (bf16*)take((size_t)NCH * 8 * 4096 * 2);
    p.dnQh = (bf16*)take((size_t)NCH * 8 * 4096 * 2);
    p.dnBT = (bf16*)take((size_t)NCH * 8 * 4096 * 2);
    p.dnOT = (bf16*)take((size_t)NCH * 8 * 4096 * 2);
    p.gates = (float*)take((size_t)NTOK * 16 * 4);
    p.dnEgl = (float*)take((size_t)NCH * 8 * 4);
    p.s5E = (float*)take((size_t)NCH * 16 * 2 * 128 * 4);
    p.s5S = (float*)take((size_t)NCH * 16 * 2 * 128 * 4);
    return off;
}

#ifdef EMU
void emu_hook(const char* tag, int l, const Params& p);
#define HOOK(tag, l) emu_hook(tag, l, p)
#endif
extern "C" void kernel_launch(void* const* d_in, const int* in_sizes, int n_in, void* d_out, int out_size, void* d_ws, size_t ws_size, hipStream_t stream) {
    Params p;
    memset(&p, 0, sizeof(p));
    const float** ip = (const float**)&p;
    for (int i = 0; i < 29; ++i) ip[i] = (const float*)d_in[i];
    p.out = (float*)d_out;
    const size_t need = ws_carve(p, (char*)d_ws);
    if (need > ws_size || n_in != 29) { fprintf(stderr, "kernel_launch: workspace %zu < %zu or n_in %d\n", ws_size, need, n_in); return; }
#ifdef EMU
    const int G = 6;
    LAUNCH(k_phase, G, 512, MEGA_LDS, stream, p, (int)PH_PREP, 0);
    for (int l = 0; l < DEPTH; ++l)
        for (int ph = PH_NORM; ph <= PH_GEMM_OUT; ++ph) {
            LAUNCH(k_phase, G, 512, MEGA_LDS, stream, p, ph, l);
            if (ph == PH_NORM) HOOK("norm", l);
            if (ph == PH_GEMM_IN) HOOK("proj", l);
            if (ph == PH_POST2) HOOK("mix", l);
            if (ph == PH_GEMM_OUT) HOOK("xout", l);
        }
    LAUNCH(k_phase, G, 512, MEGA_LDS, stream, p, (int)PH_FINAL, 0);
#else
    static int grid = 0;
    if (!grid) {
        int dev = 0, cus = 0, per_cu = 0;
        (void)hipGetDevice(&dev);
        (void)hipDeviceGetAttribute(&cus, hipDeviceAttributeMultiprocessorCount, dev);
        (void)hipFuncSetAttribute((const void*)k_mega, hipFuncAttributeMaxDynamicSharedMemorySize, MEGA_LDS);
        (void)hipOccupancyMaxActiveBlocksPerMultiprocessor(&per_cu, (const void*)k_mega, 512, MEGA_LDS);
        if (per_cu < 1) { fprintf(stderr, "kernel_launch: occupancy query says %d blocks/CU\n", per_cu); per_cu = 1; }
        grid = cus * 1;
        fprintf(stderr, "kernel_launch: cus %d per_cu %d grid %d\n", cus, per_cu, grid);
    }
    void* args[] = {&p};
    hipError_t e = hipLaunchCooperativeKernel((const void*)k_mega, dim3(grid), dim3(512), args, MEGA_LDS, stream);
    if (e != hipSuccess) fprintf(stderr, "cooperative launch failed: %s (grid %d)\n", hipGetErrorString(e), grid);
#endif
}
```

```cpp
#ifdef EMU
#include "hip_emu.h"
#define LAUNCH(k, g, b, l, s, ...) EMU_LAUNCH(k, g, b, l, s, __VA_ARGS__)
#define DYN_LDS(name) char* name = emu::dyn_lds
#define WAVE_SYNC() emu_wave_sync()
#define SCHED_BARRIER()
#define UNIFORM(x) (x)
#define LAUNDER_V(x)
#define LAUNDER_S(x)
#else
#include <hip/hip_runtime.h>
#include <hip/hip_cooperative_groups.h>
#include <cstdio>
#include <cstdint>
#include <cstring>
#define LAUNCH(k, g, b, l, s, ...) hipLaunchKernelGGL(k, dim3(g), dim3(b), l, s, __VA_ARGS__)
#define DYN_LDS(name) extern __shared__ __attribute__((aligned(16))) char name[]
#define WAVE_SYNC() do { __builtin_amdgcn_s_waitcnt(0xc07f); __builtin_amdgcn_wave_barrier(); } while (0)
#define SCHED_BARRIER() __builtin_amdgcn_sched_barrier(0)
#define UNIFORM(x) __builtin_amdgcn_readfirstlane(x)
#define LAUNDER_V(x) asm volatile("" : "+v"(x))
#define LAUNDER_S(x) asm volatile("" : "+s"(x))
#endif

#ifndef D_MODEL
#define D_MODEL 1024
#endif
#ifndef BATCH
#define BATCH 16
#endif
#ifndef SEQ
#define SEQ 256
#endif
#ifndef DEPTH
#define DEPTH 4
#endif
#ifndef DEC_BATCH
#define DEC_BATCH 2
#endif
#define DEC_SEQ 4096
constexpr int D = D_MODEL;
constexpr int NCTX = BATCH * SEQ, NLAT = DEC_BATCH * DEC_SEQ, NTOK = NCTX + NLAT;
constexpr int NCH_CTX = NCTX / 64, NCH_LAT = NLAT / 64, NCH = NTOK / 64;
constexpr int CPS_CTX = SEQ / 64, CPS_LAT = 64;
constexpr int NSEQ = BATCH + DEC_BATCH, NCOND = 1 + DEC_BATCH;
constexpr int BR = 256, DMIX = 1024;
constexpr int PU = 0, PZ = 256, QKV = 512, DZ = 1280, SU = 1536, SZ = 1792, FU = 2048, FZ = 2304, NPROJ = 2560, NPAD = 2688;
constexpr int D_IN_PROJ = 2576;
constexpr float EPS = 1e-6f;

typedef unsigned short bf16;
typedef float f32x4 __attribute__((ext_vector_type(4)));
typedef short bf16x8 __attribute__((ext_vector_type(8)));
typedef unsigned u32x2 __attribute__((ext_vector_type(2)));
typedef unsigned u32x4 __attribute__((ext_vector_type(4)));

__device__ __forceinline__ unsigned f2u(float f) { return __builtin_bit_cast(unsigned, f); }
__device__ __forceinline__ float u2f(unsigned u) { return __builtin_bit_cast(float, u); }
__device__ __forceinline__ bf16 f2bf(float f) { unsigned u = f2u(f); return (bf16)((u + 0x7fffu + ((u >> 16) & 1u)) >> 16); }
__device__ __forceinline__ float bf2f(bf16 h) { return u2f((unsigned)h << 16); }
__device__ __forceinline__ unsigned pk2(float lo, float hi) { return (unsigned)f2bf(lo) | ((unsigned)f2bf(hi) << 16); }
__device__ __forceinline__ float silu_f(float x) { return x / (1.0f + expf(-x)); }
__device__ __forceinline__ float sigmoid_f(float x) { return 1.0f / (1.0f + expf(-x)); }
__device__ __forceinline__ float softplus_f(float x) { return x > 20.f ? x : log1pf(expf(x)); }
__device__ __forceinline__ float gelu_f(float x) { return 0.5f * x * (1.0f + tanhf(0.7978845608028654f * (x + 0.044715f * x * x * x))); }

template <int MT, int NT>
__device__ __forceinline__ void mma_tiles(f32x4 (&acc)[MT][NT], const bf16* A, int lda, const bf16* B, int ldb, int K, int lane) {
#ifdef EMU
    const int col = lane & 15, rq = (lane >> 4) * 4;
    for (int mt = 0; mt < MT; ++mt) for (int nt = 0; nt < NT; ++nt) for (int r = 0; r < 4; ++r) {
        float s = 0.f; const bf16* a = A + (16 * mt + rq + r) * lda; const bf16* b = B + (16 * nt + col) * ldb;
        for (int k = 0; k < K; ++k) s += bf2f(a[k]) * bf2f(b[k]);
        acc[mt][nt][r] += s;
    }
#else
    const bf16* a0 = A + (lane & 15) * lda + (lane >> 4) * 8;
    const bf16* b0 = B + (lane & 15) * ldb + (lane >> 4) * 8;
    for (int k0 = 0; k0 < K; k0 += 32) {
        bf16x8 a[MT], b[NT];
#pragma unroll
        for (int mt = 0; mt < MT; ++mt) a[mt] = *(const bf16x8*)(a0 + 16 * mt * lda + k0);
#pragma unroll
        for (int nt = 0; nt < NT; ++nt) b[nt] = *(const bf16x8*)(b0 + 16 * nt * ldb + k0);
#pragma unroll
        for (int mt = 0; mt < MT; ++mt)
#pragma unroll
            for (int nt = 0; nt < NT; ++nt) acc[mt][nt] = __builtin_amdgcn_mfma_f32_16x16x32_bf16(a[mt], b[nt], acc[mt][nt], 0, 0, 0);
    }
#endif
}
template <int MT, int NT> __device__ __forceinline__ void zero_acc(f32x4 (&acc)[MT][NT]) {
#pragma unroll
    for (int mt = 0; mt < MT; ++mt)
#pragma unroll
        for (int nt = 0; nt < NT; ++nt) acc[mt][nt] = (f32x4){0.f, 0.f, 0.f, 0.f};
}

struct Params {
    const float *x_prompt, *x_sample, *c, *state_delta, *state_s5, *c_ctx, *w_ada, *b_ada, *norm_g, *w_in, *pool_w, *pool_scale,
        *dn_conv, *dn_a_log, *dn_dt_bias, *dn_norm_g, *s5_a_re, *s5_a_im, *s5_log_dt, *s5_b_re, *s5_b_im, *s5_c_re, *s5_c_im,
        *s5_d, *s5_glu_w, *s5_glu_b, *ft_w, *w_out, *final_g;
    float* out;
    bf16 *winT, *woutT, *ftwT, *gluT, *poolwT, *Cmat, *tabDc, *tabE, *tabT;
    float *ada, *abar, *abar64, *bbar;
    bf16 *hbuf  , *mix, *proj, *fbuf, *ybuf, *obuf, *Zg, *dnAp, *dnQh, *dnBT, *dnOT;
    float *gates, *dnEgl, *s5E, *s5S;
    unsigned* bar;
};
constexpr size_t OUT_DN = (size_t)NTOK * D, OUT_S5 = OUT_DN + (size_t)BATCH * DEPTH * 2 * 4 * 64 * 64;
constexpr size_t OUT_TOTAL = OUT_S5 + (size_t)BATCH * DEPTH * 2 * 2 * 16 * 64;

struct Ctx { int tid, lane, wave, vb, nvb; char* smem; };
constexpr int HALF_LDS = 81664;
__device__ __forceinline__ int loop_iters(int N, const Ctx& c) { const int v0 = c.vb & ~1; return N > v0 ? (N - v0 + c.nvb - 1) / c.nvb : 0; }
__device__ __forceinline__ int cond_of(int tok) { return tok < NCTX ? 0 : 1 + (tok - NCTX) / DEC_SEQ; }
__device__ __forceinline__ const float* xrow_in(const Params& p, int l, int tok) {
    if (l == 0) return tok < NCTX ? p.x_prompt + (size_t)tok * D : p.x_sample + (size_t)(tok - NCTX) * D;
    return p.out + (size_t)tok * D;
}

__device__ __forceinline__ void prep_weights_body(const Params& p, size_t gtid, size_t gsz) {
    for (size_t i = gtid; i < (size_t)DEPTH * 4 * 64 * 64; i += gsz) {
        int c = (int)(i % 64), d = (int)((i / 64) % 64); size_t lg = i / 4096;
        p.poolwT[i] = f2bf(p.pool_w[(lg * 64 + c) * 64 + d]);
    }
    for (size_t i = gtid; i < (size_t)DEPTH * 16 * 16 * 256; i += gsz) {
        int k = (int)(i % 256), pp = (int)((i / 256) % 16), g = (int)((i / 4096) % 16), l = (int)(i / 65536);
        int d = k >> 7, part = (k >> 6) & 1, n = k & 63;
        size_t src = ((((size_t)l * 2 + d) * 16 + g) * 16 + pp) * 64 + n;
        p.Cmat[i] = f2bf(part ? -p.s5_c_im[src] : p.s5_c_re[src]);
    }
    const float TWO_PI = 6.283185307179586f;
    for (size_t i = gtid; i < 128 * 64; i += gsz) {
        int c = (int)(i % 64), n = (int)(i / 64), part = n >> 6, kc = n & 63; int m = (c * kc) & 63;
        float a = TWO_PI * (float)m / 64.f; p.tabDc[i] = f2bf(part ? -sinf(a) : cosf(a));
    }
    for (size_t i = gtid; i < 128 * 128; i += gsz) {
        int kk = (int)(i % 128), n = (int)(i / 128); int pp = n >> 6, k1 = n & 63, pt = kk >> 6, t1 = kk & 63; int m = (t1 * k1) & 63;
        float a = TWO_PI * (float)m / 64.f; float C = cosf(a), S = sinf(a);
        float v = (pp == 0) ? (pt == 0 ? C : S) : (pt == 0 ? -S : C);
        p.tabE[i] = f2bf(v);
    }
    for (size_t i = gtid; i < (size_t)SEQ * 2 * SEQ; i += gsz) {
        int kk = (int)(i % (2 * SEQ)), kt = (int)(i / (2 * SEQ)); int part = kk / SEQ, t = kk % SEQ; int m = (kt * t) % SEQ;
        float a = TWO_PI * (float)m / (float)SEQ; p.tabT[i] = f2bf(part ? sinf(a) : cosf(a));
    }
    for (size_t i = gtid; i < (size_t)DEPTH * 2 * 16 * 64; i += gsz) {
        size_t ldg = i / 64;
        float dt = expf(p.s5_log_dt[ldg]); float are = p.s5_a_re[i], aim = p.s5_a_im[i];
        float mag = expf(are * dt); float abr = mag * cosf(aim * dt), abi = mag * sinf(aim * dt);
        float den = are * are + aim * aim; float nr = abr - 1.0f;
        float cre = (nr * are + abi * aim) / den, cim = (abi * are - nr * aim) / den;
        p.abar[2 * i] = abr; p.abar[2 * i + 1] = abi;
        float pr = abr, pi = abi;
        for (int s = 0; s < 6; ++s) { float t0 = pr * pr - pi * pi, t1 = 2.f * pr * pi; pr = t0; pi = t1; }
        p.abar64[2 * i] = pr; p.abar64[2 * i + 1] = pi;
        for (int pp = 0; pp < 16; ++pp) {
            float bre = p.s5_b_re[i * 16 + pp], bim = p.s5_b_im[i * 16 + pp];
            p.bbar[i * 32 + pp] = cre * bre - cim * bim;
            p.bbar[i * 32 + 16 + pp] = cre * bim + cim * bre;
        }
    }
}


constexpr int PT_KT = D / 64;
constexpr int PT_WIN = DEPTH * (NPAD / 64) * PT_KT;
constexpr int PT_WOUT = DEPTH * (D / 64) * (DMIX / 64);
constexpr int PT_SQ = DEPTH * 2 * 16;
constexpr int PT_ADA = DEPTH * (3 * D / 64);
constexpr int PT_TOTAL = PT_WIN + PT_WOUT + PT_SQ + PT_ADA;
constexpr int PREP_LDS = 64 * 65 * 4 + NCOND * D * 4;
__device__ __forceinline__ void prep_tiled_body(const Params& p, const Ctx& c) {
    float* T = (float*)c.smem;
    float* sc = T + 64 * 65;
    const int tid = c.tid;
    for (int i = tid; i < NCOND * D; i += 256) { const int cc = i / D, k = i % D; sc[i] = silu_f(cc == 0 ? p.c_ctx[k] : p.c[(size_t)(cc - 1) * D + k]); }
    for (int _k = 0, _n = loop_iters(PT_TOTAL, c); _k < _n; ++_k) {
        int item = c.vb + _k * c.nvb; const bool ghost = item >= PT_TOTAL; if (ghost) item = PT_TOTAL - 1;
        int type, l, kt = 0, nt = 0;
        const float* src_ = nullptr; int lds_ = 0, k0 = 0, ncol0 = 0, nvalid = 64; bf16* dst = nullptr; int ldk = 0;
        if (item < PT_WIN) { type = 0; l = item / ((NPAD / 64) * PT_KT); const int r = item % ((NPAD / 64) * PT_KT); nt = r / PT_KT; kt = r % PT_KT;
            const int n0 = nt * 64; const int oc = n0 < 1536 ? n0 : (n0 < NPROJ ? n0 + 16 : 1536); nvalid = n0 < NPROJ ? 64 : (n0 == NPROJ ? 16 : 0);
            src_ = p.w_in + (size_t)l * D * D_IN_PROJ; lds_ = D_IN_PROJ; k0 = kt * 64; ncol0 = oc; dst = p.winT + ((size_t)l * NPAD + n0) * D; ldk = D; }
        else if (item < PT_WIN + PT_WOUT) { type = 0; const int it = item - PT_WIN; l = it / ((D / 64) * (DMIX / 64)); const int r = it % ((D / 64) * (DMIX / 64)); nt = r / (DMIX / 64); kt = r % (DMIX / 64);
            src_ = p.w_out + (size_t)l * DMIX * D; lds_ = D; k0 = kt * 64; ncol0 = nt * 64; dst = p.woutT + ((size_t)l * D + nt * 64) * DMIX; ldk = DMIX; }
        else if (item < PT_WIN + PT_WOUT + PT_SQ) { type = 0; const int it = item - PT_WIN - PT_WOUT; l = it / 32; const int which = (it >> 4) & 1, r = it & 15; nt = r >> 2; kt = r & 3;
            src_ = (which ? p.s5_glu_w : p.ft_w) + (size_t)l * 65536; lds_ = 256; k0 = kt * 64; ncol0 = nt * 64; dst = (which ? p.gluT : p.ftwT) + (size_t)l * 65536 + (size_t)nt * 64 * 256; ldk = 256; }
        else { type = 1; const int it = item - PT_WIN - PT_WOUT - PT_SQ; l = it / (3 * D / 64); nt = it % (3 * D / 64); }
        __syncthreads();
        if (type == 0) {
            const int cq = (tid & 15) * 4;
#pragma unroll
            for (int i = 0; i < 4; ++i) {
                const int kk = (tid >> 4) + 16 * i;
                f32x4 v = (f32x4){0.f, 0.f, 0.f, 0.f};
                if (cq < nvalid) v = *(const f32x4*)(src_ + (size_t)(k0 + kk) * lds_ + ncol0 + cq);
                T[kk * 65 + cq] = v.x; T[kk * 65 + cq + 1] = v.y; T[kk * 65 + cq + 2] = v.z; T[kk * 65 + cq + 3] = v.w;
            }
        } else {
            const int col = tid & 63, kg = tid >> 6; const int j = nt * 64 + col;
            float a0 = 0.f, a1 = 0.f, a2 = 0.f;
            const float* w = p.w_ada + ((size_t)l * D + kg * (D / 4)) * 3 * D + j;
            for (int k = 0; k < D / 4; ++k) { const float wv = w[(size_t)k * 3 * D]; const int kk = kg * (D / 4) + k; a0 += sc[kk] * wv; a1 += sc[D + kk] * wv; if (NCOND > 2) a2 += sc[2 * D + kk] * wv; }
            T[(kg * 3 + 0) * 65 + col] = a0; T[(kg * 3 + 1) * 65 + col] = a1; T[(kg * 3 + 2) * 65 + col] = a2;
        }
        __syncthreads();
        if (!ghost) {
            if (type == 0) {
                const int n = tid >> 2, kc = (tid & 3) * 16;
                u32x4 w0, w1;
                w0.x = pk2(T[(kc + 0) * 65 + n], T[(kc + 1) * 65 + n]); w0.y = pk2(T[(kc + 2) * 65 + n], T[(kc + 3) * 65 + n]);
                w0.z = pk2(T[(kc + 4) * 65 + n], T[(kc + 5) * 65 + n]); w0.w = pk2(T[(kc + 6) * 65 + n], T[(kc + 7) * 65 + n]);
                w1.x = pk2(T[(kc + 8) * 65 + n], T[(kc + 9) * 65 + n]); w1.y = pk2(T[(kc + 10) * 65 + n], T[(kc + 11) * 65 + n]);
                w1.z = pk2(T[(kc + 12) * 65 + n], T[(kc + 13) * 65 + n]); w1.w = pk2(T[(kc + 14) * 65 + n], T[(kc + 15) * 65 + n]);
                bf16* d = dst + (size_t)n * ldk + k0 + kc;
                *(u32x4*)d = w0; *(u32x4*)(d + 8) = w1;
            } else if (tid < 64 * NCOND) {
                const int col = tid & 63, cc = tid >> 6; const int j = nt * 64 + col;
                const float v = T[(0 * 3 + cc) * 65 + col] + T[(1 * 3 + cc) * 65 + col] + T[(2 * 3 + cc) * 65 + col] + T[(3 * 3 + cc) * 65 + col];
                p.ada[((size_t)l * NCOND + cc) * 3 * D + j] = v + p.b_ada[(size_t)l * 3 * D + j];
            }
        }
    }
}

__device__ __forceinline__ void norm_mod_body(const Params& p, int l, const Ctx& c) {
    const int lane = c.lane, wave = c.wave;
    for (int tok0 = c.vb * 4; tok0 < NTOK; tok0 += c.nvb * 4) {
        const int tok = tok0 + wave;
        const float* xr = xrow_in(p, l, tok);
        float v[D / 64]; float ss = 0.f;
#pragma unroll
        for (int j = 0; j < D / 64; ++j) { v[j] = xr[j * 64 + lane]; ss += v[j] * v[j]; }
#pragma unroll
        for (int o = 1; o < 64; o <<= 1) ss += __shfl_xor(ss, o);
        const float rs = 1.0f / sqrtf(ss / (float)D + EPS);
        const float* ad = p.ada + ((size_t)l * NCOND + cond_of(tok)) * 3 * D;
        const float* ng = p.norm_g + (size_t)l * D;
#pragma unroll
        for (int j = 0; j < D / 64; ++j) { int i = j * 64 + lane; float h = v[j] * rs * ng[i] * (1.0f + ad[D + i]) + ad[i]; p.hbuf[(size_t)tok * D + i] = f2bf(h); }
    }
}

constexpr int GLD = 40;
constexpr int GEMM_LDS = 2 * 128 * GLD * 2;
template <class Epi>
__device__ __forceinline__ void gemm_body(const bf16* A, int lda, const bf16* B, int ldb, int M, int N, int K, const Epi& epi, const Ctx& c) {
    bf16* As = (bf16*)c.smem; bf16* Bs = As + 128 * GLD;
    const int tid = c.tid, lane = c.lane, wave = c.wave, wr = wave >> 1, wc = wave & 1;
    const int nM = M / 128, nN = N / 128, ntiles = nM * nN;
    for (int _k = 0, _n = loop_iters(ntiles, c); _k < _n; ++_k) {
        int tile = c.vb + _k * c.nvb; const bool ghost = tile >= ntiles; if (ghost) tile = ntiles - 1;
        const int tm = tile / nN, tn = tile % nN;
        const bf16* Ag = A + (size_t)tm * 128 * lda; const bf16* Bg = B + (size_t)tn * 128 * ldb;
        f32x4 acc[4][4]; zero_acc(acc);
        u32x4 ra[2], rb[2];
        const int r0 = tid >> 2, ck = tid & 3;
#pragma unroll
        for (int i = 0; i < 2; ++i) { ra[i] = *(const u32x4*)(Ag + (size_t)(r0 + 64 * i) * lda + ck * 8); rb[i] = *(const u32x4*)(Bg + (size_t)(r0 + 64 * i) * ldb + ck * 8); }
        for (int k0 = 0; k0 < K; k0 += 32) {
            __syncthreads();
#pragma unroll
            for (int i = 0; i < 2; ++i) { *(u32x4*)(As + (r0 + 64 * i) * GLD + ck * 8) = ra[i]; *(u32x4*)(Bs + (r0 + 64 * i) * GLD + ck * 8) = rb[i]; }
            __syncthreads();
            if (k0 + 32 < K) {
#pragma unroll
                for (int i = 0; i < 2; ++i) { ra[i] = *(const u32x4*)(Ag + (size_t)(r0 + 64 * i) * lda + k0 + 32 + ck * 8); rb[i] = *(const u32x4*)(Bg + (size_t)(r0 + 64 * i) * ldb + k0 + 32 + ck * 8); }
            }
            mma_tiles<4, 4>(acc, As + wr * 64 * GLD, GLD, Bs + wc * 64 * GLD, GLD, 32, lane);
        }
        if (!ghost) {
#pragma unroll
        for (int mt = 0; mt < 4; ++mt)
#pragma unroll
            for (int nt = 0; nt < 4; ++nt) {
                const int row = tm * 128 + wr * 64 + mt * 16 + (lane >> 4) * 4, col = tn * 128 + wc * 64 + nt * 16 + (lane & 15);
#pragma unroll
                for (int r = 0; r < 4; ++r) epi(row + r, col, acc[mt][nt][r]);
            }
        }
    }
}
struct EpiProj {
    bf16* proj; float* gates;
    __device__ __forceinline__ void operator()(int row, int col, float v) const {
        if (col < NPROJ) proj[(size_t)row * NPROJ + col] = f2bf(v);
        else if (col < NPROJ + 16) gates[(size_t)row * 16 + (col - NPROJ)] = v;
    }
};
struct EpiOut {
    const Params* p; int l;
    __device__ __forceinline__ void operator()(int row, int col, float v) const {
        const float g = p->ada[((size_t)l * NCOND + cond_of(row)) * 3 * D + 2 * D + col];
        const float xi = xrow_in(*p, l, row)[col];
        p->out[(size_t)row * D + col] = xi + g * v;
    }
};
struct EpiGlu {
    const Params* p; int l;
    __device__ __forceinline__ void operator()(int row, int col, float v) const {
        const float y = bf2f(p->ybuf[(size_t)row * 256 + col]);
        const float z = bf2f(p->proj[(size_t)row * NPROJ + SZ + col]);
        p->mix[(size_t)row * DMIX + 512 + col] = f2bf(y * sigmoid_f(v + p->s5_glu_b[l * 256 + col]) * silu_f(z));
    }
};
struct EpiFt {
    const Params* p;
    __device__ __forceinline__ void operator()(int row, int col, float v) const {
        const float z = bf2f(p->proj[(size_t)row * NPROJ + FZ + col]);
        p->mix[(size_t)row * DMIX + 768 + col] = f2bf(v * silu_f(z));
    }
};

constexpr int POOL_LDS = 64 * 72 * 2 + 64 * 66 * 4;
template <int W>
__device__ __forceinline__ void pool_item(const Params& p, int l, int ch, int g, bf16* Ps, float* Vs, int tid, int lane, int wave) {
    constexpr int HW = W / 2;
    const bool lat = ch >= NCH_CTX;
    const int c2 = tid & 31, jg = tid >> 5;
    const int cofs = PU + g * 64 + 2 * c2;
    __syncthreads();
    if (!lat) {
        const int seq = ch / CPS_CTX, ci = ch % CPS_CTX; const size_t tok_seq = (size_t)seq * SEQ;
#pragma unroll
        for (int jj = 0; jj < 8; ++jj) {
            const int j = jg * 8 + jj, t = ci * 64 + j;
            int lo = t - HW; if (lo < 0) lo = 0; int hi = t - HW + W; if (hi > SEQ) hi = SEQ;
            float s0 = 0.f, s1 = 0.f;
#pragma unroll
            for (int k = 0; k < W; ++k) {
                int tt = t - HW + k; const bool ok = tt >= 0 && tt < SEQ; tt = tt < 0 ? 0 : (tt >= SEQ ? SEQ - 1 : tt);
                const unsigned u = *(const unsigned*)(p.proj + (tok_seq + tt) * NPROJ + cofs);
                s0 += ok ? bf2f((bf16)(u & 0xffff)) : 0.f; s1 += ok ? bf2f((bf16)(u >> 16)) : 0.f;
            }
            const unsigned uc = *(const unsigned*)(p.proj + (tok_seq + t) * NPROJ + cofs);
            const float inv = 1.0f / (float)(hi - lo);
            *(unsigned*)(Ps + j * 72 + 2 * c2) = pk2(s0 * inv - bf2f((bf16)(uc & 0xffff)), s1 * inv - bf2f((bf16)(uc >> 16)));
        }
        __syncthreads(); __syncthreads();
    } else {
        const int b = (ch - NCH_CTX) / 64, r = (ch - NCH_CTX) % 64; const size_t tok_b = (size_t)NCTX + (size_t)b * DEC_SEQ;
        int lor = r - HW; if (lor < 0) lor = 0; int hir = r - HW + W; if (hir > 64) hir = 64;
        const float invr = 1.0f / (float)(hir - lor);
#pragma unroll
        for (int jj = 0; jj < 8; ++jj) {
            const int col = jg * 8 + jj; float s0 = 0.f, s1 = 0.f;
#pragma unroll
            for (int k = 0; k < W; ++k) {
                int rr = r - HW + k; const bool ok = rr >= 0 && rr < 64; rr = rr < 0 ? 0 : (rr > 63 ? 63 : rr);
                const unsigned u = *(const unsigned*)(p.proj + (tok_b + rr * 64 + col) * NPROJ + cofs);
                s0 += ok ? bf2f((bf16)(u & 0xffff)) : 0.f; s1 += ok ? bf2f((bf16)(u >> 16)) : 0.f;
            }
            Vs[col * 66 + 2 * c2] = s0 * invr; Vs[col * 66 + 2 * c2 + 1] = s1 * invr;
        }
        __syncthreads();
#pragma unroll
        for (int jj = 0; jj < 8; ++jj) {
            const int col = jg * 8 + jj;
            int lo = col - HW; if (lo < 0) lo = 0; int hi = col - HW + W; if (hi > 64) hi = 64;
            float s0 = 0.f, s1 = 0.f;
            for (int cc = lo; cc < hi; ++cc) { s0 += Vs[cc * 66 + 2 * c2]; s1 += Vs[cc * 66 + 2 * c2 + 1]; }
            const unsigned uc = *(const unsigned*)(p.proj + (tok_b + r * 64 + col) * NPROJ + cofs);
            const float inv = 1.0f / (float)(hi - lo);
            *(unsigned*)(Ps + col * 72 + 2 * c2) = pk2(s0 * inv - bf2f((bf16)(uc & 0xffff)), s1 * inv - bf2f((bf16)(uc >> 16)));
        }
        __syncthreads();
    }
    {
        f32x4 acc[1][4]; zero_acc(acc);
        mma_tiles<1, 4>(acc, Ps + wave * 16 * 72, 72, p.poolwT + ((size_t)l * 4 + g) * 4096, 64, 64, lane);
#pragma unroll
        for (int nt = 0; nt < 4; ++nt) {
            const int d = g * 64 + nt * 16 + (lane & 15); const float sc = p.pool_scale[l * 256 + d];
#pragma unroll
            for (int r = 0; r < 4; ++r) {
                const size_t tok = (size_t)ch * 64 + wave * 16 + (lane >> 4) * 4 + r;
                const float z = bf2f(p.proj[tok * NPROJ + PZ + d]);
                p.mix[tok * DMIX + d] = f2bf(acc[0][nt][r] * sc * silu_f(z));
            }
        }
    }
}
__device__ __forceinline__ void pool_body(const Params& p, int l, const Ctx& c) {
    bf16* Ps = (bf16*)c.smem;
    float* Vs = (float*)(c.smem + 64 * 72 * 2);
    const int wave = c.wave;
    for (int _k = 0, _n = loop_iters(NCH * 4, c); _k < _n; ++_k) {
        int item = c.vb + _k * c.nvb; if (item >= NCH * 4) item = NCH * 4 - 1;
        int tid = c.tid; LAUNDER_V(tid); const int lane = tid & 63;
        const int ch = item >> 2, g = item & 3;
        switch (g) {
        case 0: pool_item<2>(p, l, ch, g, Ps, Vs, tid, lane, wave); break;
        case 1: pool_item<4>(p, l, ch, g, Ps, Vs, tid, lane, wave); break;
        case 2: pool_item<8>(p, l, ch, g, Ps, Vs, tid, lane, wave); break;
        default: pool_item<16>(p, l, ch, g, Ps, Vs, tid, lane, wave); break;
        }
    }
}

constexpr int FTC_ULD = 72, FTC_GLD = SEQ + 8;
constexpr int FTC_LDS = SEQ * FTC_ULD * 2 + 64 * FTC_GLD * 2;
__device__ __forceinline__ void ft_ctx_body(const Params& p, const Ctx& c) {
    bf16* Us = (bf16*)c.smem;
    bf16* GT = Us + SEQ * FTC_ULD;
    const int tid = c.tid, lane = c.lane, wave = c.wave;
    constexpr int MTW = SEQ / 64;
    for (int _k = 0, _n = loop_iters(BATCH * 4, c); _k < _n; ++_k) {
        int item = c.vb + _k * c.nvb; if (item >= (BATCH * 4)) item = (BATCH * 4) - 1;
        const int b = item >> 2, h = item & 3;
        __syncthreads();
        for (int i = tid; i < SEQ * 8; i += 256) { const int t = i >> 3, ck = i & 7; *(u32x4*)(Us + t * FTC_ULD + ck * 8) = *(const u32x4*)(p.proj + ((size_t)b * SEQ + t) * NPROJ + FU + h * 64 + ck * 8); }
        __syncthreads();
        f32x4 facc[MTW][4]; zero_acc(facc);
        for (int part = 0; part < 2; ++part) {
#pragma unroll 1
            for (int nh = 0; nh < 2; ++nh) {
                f32x4 g[MTW][2]; zero_acc(g);
                mma_tiles<MTW, 2>(g, Us + wave * (SEQ / 4) * FTC_ULD, FTC_ULD, p.tabDc + (part * 64 + nh * 32) * 64, 64, 64, lane);
#pragma unroll
                for (int mt = 0; mt < MTW; ++mt)
#pragma unroll
                    for (int nt = 0; nt < 2; ++nt) {
                        const int kc = nh * 32 + nt * 16 + (lane & 15), t0 = wave * (SEQ / 4) + mt * 16 + (lane >> 4) * 4;
                        u32x2 w; w.x = pk2(g[mt][nt][0], g[mt][nt][1]); w.y = pk2(g[mt][nt][2], g[mt][nt][3]);
                        *(u32x2*)(GT + kc * FTC_GLD + t0) = w;
                    }
            }
            __syncthreads();
            mma_tiles<MTW, 4>(facc, p.tabT + (size_t)(wave * (SEQ / 4)) * 2 * SEQ + part * SEQ, 2 * SEQ, GT, FTC_GLD, SEQ, lane);
            __syncthreads();
        }
        const float sc = 1.0f / sqrtf((float)SEQ * 64.f);
#pragma unroll
        for (int mt = 0; mt < MTW; ++mt)
#pragma unroll
            for (int nt = 0; nt < 4; ++nt)
#pragma unroll
                for (int r = 0; r < 4; ++r) {
                    const int kt = wave * (SEQ / 4) + mt * 16 + (lane >> 4) * 4 + r, kc = nt * 16 + (lane & 15);
                    p.fbuf[((size_t)b * SEQ + kt) * 256 + h * 64 + kc] = f2bf(facc[mt][nt][r] * sc);
                }
    }
}

constexpr int FTA_LDS = 64 * 264 * 2 + 64 * 136 * 2;
__device__ __forceinline__ void ft_latA_body(const Params& p, const Ctx& c) {
    bf16* Xs = (bf16*)c.smem;
    bf16* Z1T = Xs + 64 * 264;
    const int tid = c.tid, lane = c.lane, wave = c.wave;
    for (int _k = 0, _n = loop_iters(DEC_BATCH * 64, c); _k < _n; ++_k) {
        int item = c.vb + _k * c.nvb; if (item >= (DEC_BATCH * 64)) item = (DEC_BATCH * 64) - 1;
        const int b = item >> 6, t2 = item & 63;
        __syncthreads();
        for (int i = tid; i < 64 * 32; i += 256) { const int t1 = i >> 5, ck = i & 31; *(u32x4*)(Xs + t1 * 264 + ck * 8) = *(const u32x4*)(p.proj + ((size_t)NCTX + (size_t)b * DEC_SEQ + t1 * 64 + t2) * NPROJ + FU + ck * 8); }
        __syncthreads();
        for (int h = 0; h < 4; ++h) {
            {
                f32x4 a[4][2]; zero_acc(a);
                mma_tiles<4, 2>(a, Xs + h * 64, 264, p.tabDc + wave * 32 * 64, 64, 64, lane);
#pragma unroll
                for (int mt = 0; mt < 4; ++mt)
#pragma unroll
                    for (int nt = 0; nt < 2; ++nt) {
                        const int n = wave * 32 + nt * 16 + (lane & 15), part = n >> 6, kc = n & 63, t10 = mt * 16 + (lane >> 4) * 4;
                        u32x2 w; w.x = pk2(a[mt][nt][0], a[mt][nt][1]); w.y = pk2(a[mt][nt][2], a[mt][nt][3]);
                        *(u32x2*)(Z1T + kc * 136 + part * 64 + t10) = w;
                    }
            }
            __syncthreads();
            {
                f32x4 z[1][8]; zero_acc(z);
                mma_tiles<1, 8>(z, Z1T + wave * 16 * 136, 136, p.tabE, 128, 128, lane);
#pragma unroll
                for (int nt = 0; nt < 4; ++nt) {
                    const int k1 = nt * 16 + (lane & 15); const int m = (t2 * k1) & 4095;
                    const float ang = 6.283185307179586f * (float)m / 4096.f; const float tc = cosf(ang), ts = sinf(ang);
#pragma unroll
                    for (int r = 0; r < 4; ++r) {
                        const int kc = wave * 16 + (lane >> 4) * 4 + r; const float a = z[0][nt][r], bb = z[0][nt + 4][r];
                        bf16* dst = p.Zg + ((((size_t)b * 64 + k1) * 256 + h * 64 + kc) * 128) + t2;
                        dst[0] = f2bf(a * tc + bb * ts); dst[64] = f2bf(bb * tc - a * ts);
                    }
                }
            }
            __syncthreads();
        }
    }
}

__device__ __forceinline__ void ft_latB_body(const Params& p, const Ctx& c) {
    const int lane = c.lane, wave = c.wave;
    for (int item = c.vb; item < DEC_BATCH * 64; item += c.nvb) {
        const int b = item >> 6, k1 = item & 63;
        f32x4 acc[4][4]; zero_acc(acc);
        mma_tiles<4, 4>(acc, p.tabE, 128, p.Zg + (((size_t)b * 64 + k1) * 256 + wave * 64) * 128, 128, 128, lane);
#pragma unroll
        for (int mt = 0; mt < 4; ++mt)
#pragma unroll
            for (int nt = 0; nt < 4; ++nt)
#pragma unroll
                for (int r = 0; r < 4; ++r) {
                    const int k2 = mt * 16 + (lane >> 4) * 4 + r, n = wave * 64 + nt * 16 + (lane & 15);
                    p.fbuf[((size_t)NCTX + (size_t)b * DEC_SEQ + k1 + 64 * k2) * 256 + n] = f2bf(acc[mt][nt][r] * (1.0f / 512.f));
                }
    }
}

constexpr int S5P1_LDS = 4 * 64 * 16 * 4;
__device__ __forceinline__ void s5_pass1_body(const Params& p, int l, const Ctx& c) {
    const int lane = c.lane, wave = c.wave;
    float* uS = (float*)c.smem + wave * 1024;
    for (int it0 = c.vb * 4; it0 < NCH * 32; it0 += c.nvb * 4) {
        const int item = it0 + wave; const int d = item & 1, g = (item >> 1) & 15, ch = item >> 5;
        WAVE_SYNC();
        for (int i = lane; i < 1024; i += 64) { const int t = i >> 4, pp = i & 15; uS[i] = bf2f(p.proj[((size_t)ch * 64 + t) * NPROJ + SU + g * 16 + pp]); }
        WAVE_SYNC();
        const size_t pi = (((size_t)l * 2 + d) * 16 + g) * 64 + lane;
        const float ar = p.abar[2 * pi], ai = p.abar[2 * pi + 1];
        float bre[16], bim[16];
#pragma unroll
        for (int pp = 0; pp < 16; ++pp) { bre[pp] = p.bbar[pi * 32 + pp]; bim[pp] = p.bbar[pi * 32 + 16 + pp]; }
        float sr = 0.f, si = 0.f;
        for (int tau = 0; tau < 64; ++tau) {
            const int t = d ? 63 - tau : tau; float br = 0.f, bi = 0.f;
#pragma unroll
            for (int pp = 0; pp < 16; ++pp) { const float u = uS[t * 16 + pp]; br += bre[pp] * u; bi += bim[pp] * u; }
            const float nr = ar * sr - ai * si + br, ni = ar * si + ai * sr + bi; sr = nr; si = ni;
        }
        float* E = p.s5E + (((size_t)ch * 16 + g) * 2 + d) * 128;
        E[lane] = sr; E[64 + lane] = si;
    }
}
__device__ __forceinline__ void s5_carry_body(const Params& p, int l, const Ctx& c) {
    for (int i = c.vb * 256 + c.tid; i < NSEQ * 16 * 2 * 64; i += c.nvb * 256) {
        const int n = i & 63, d = (i >> 6) & 1, g = (i >> 7) & 15, seq = i >> 11;
        const bool lat = seq >= BATCH; const int cps = lat ? CPS_LAT : CPS_CTX; const int ch0 = lat ? NCH_CTX + (seq - BATCH) * CPS_LAT : seq * CPS_CTX;
        const size_t pi = (((size_t)l * 2 + d) * 16 + g) * 64 + n;
        const float ar = p.abar64[2 * pi], ai = p.abar64[2 * pi + 1];
        float sr = 0.f, si = 0.f;
        if (lat) { const size_t o = ((((size_t)(seq - BATCH) * DEPTH + l) * 2 + d) * 2) * 1024 + g * 64 + n; sr = p.state_s5[o]; si = p.state_s5[o + 1024]; }
        for (int q = 0; q < cps; ++q) {
            const int ch = ch0 + (d ? cps - 1 - q : q);
            const size_t e = (((size_t)ch * 16 + g) * 2 + d) * 128 + n;
            p.s5S[e] = sr; p.s5S[e + 64] = si;
            const float er = p.s5E[e], ei = p.s5E[e + 64];
            const float nr = ar * sr - ai * si + er, ni = ar * si + ai * sr + ei; sr = nr; si = ni;
        }
        if (!lat) { const size_t o = OUT_S5 + ((((size_t)seq * DEPTH + l) * 2 + d) * 2) * 1024 + g * 64 + n; p.out[o] = sr; p.out[o + 1024] = si; }
    }
}
constexpr int S5P3_LDS = 2 * 64 * 264 * 2 + 2 * 64 * 16 * 4;
__device__ __forceinline__ void s5_pass3_body(const Params& p, int l, const Ctx& c) {
    const int tid = c.tid, lane = c.lane, wave = c.wave, il = wave >> 1, d = wave & 1;
    bf16* Ss = (bf16*)c.smem + il * 64 * 264;
    float* uS = (float*)(c.smem + 2 * 64 * 264 * 2) + il * 1024;
    for (int _k = 0, _n = loop_iters(NCH * 8, c); _k < _n; ++_k) {
        int grp = c.vb + _k * c.nvb; if (grp >= (NCH * 8)) grp = (NCH * 8) - 1;
        const int item = grp * 2 + il; const int g = item & 15, ch = item >> 4;
        __syncthreads();
        for (int i = (tid & 127); i < 1024; i += 128) { const int t = i >> 4, pp = i & 15; uS[i] = bf2f(p.proj[((size_t)ch * 64 + t) * NPROJ + SU + g * 16 + pp]); }
        __syncthreads();
        const size_t pi = (((size_t)l * 2 + d) * 16 + g) * 64 + lane;
        const float ar = p.abar[2 * pi], ai = p.abar[2 * pi + 1];
        float bre[16], bim[16];
#pragma unroll
        for (int pp = 0; pp < 16; ++pp) { bre[pp] = p.bbar[pi * 32 + pp]; bim[pp] = p.bbar[pi * 32 + 16 + pp]; }
        const size_t e = (((size_t)ch * 16 + g) * 2 + d) * 128 + lane;
        float sr = p.s5S[e], si = p.s5S[e + 64];
        for (int tau = 0; tau < 64; ++tau) {
            const int t = d ? 63 - tau : tau; float br = 0.f, bi = 0.f;
#pragma unroll
            for (int pp = 0; pp < 16; ++pp) { const float u = uS[t * 16 + pp]; br += bre[pp] * u; bi += bim[pp] * u; }
            const float nr = ar * sr - ai * si + br, ni = ar * si + ai * sr + bi; sr = nr; si = ni;
            Ss[t * 264 + d * 128 + lane] = f2bf(sr); Ss[t * 264 + d * 128 + 64 + lane] = f2bf(si);
        }
        __syncthreads();
        f32x4 acc[2][1]; zero_acc(acc);
        mma_tiles<2, 1>(acc, Ss + d * 32 * 264, 264, p.Cmat + ((size_t)l * 16 + g) * 4096, 256, 256, lane);
#pragma unroll
        for (int mt = 0; mt < 2; ++mt)
#pragma unroll
            for (int r = 0; r < 4; ++r) {
                const int t = d * 32 + mt * 16 + (lane >> 4) * 4 + r, pp = lane & 15;
                const float y = acc[mt][0][r] + p.s5_d[l * 256 + g * 16 + pp] * uS[t * 16 + pp];
                p.ybuf[((size_t)ch * 64 + t) * 256 + g * 16 + pp] = f2bf(gelu_f(y));
            }
    }
}

constexpr int DN_STG = 0;
constexpr int DN_S1 = 0, DN_S2 = 18432;
constexpr int DN_AB = 36864;
constexpr int DN_QB = DN_AB + 9216, DN_KB = DN_QB + 9216, DN_VB = DN_KB + 9216;
constexpr int DN_SM = DN_VB + 8192;
constexpr int DN1_LDS = DN_SM + 5 * 64 * 4;
static_assert(DN1_LDS <= HALF_LDS, "DN1 LDS");
__device__ __forceinline__ void dn_d1_body(const Params& p, int l, const Ctx& c) {
    char* smem = c.smem;
    float* stq = (float*)(smem + DN_STG); float* stk = stq + 64 * 65;
    bf16* S1 = (bf16*)(smem + DN_S1); bf16* S2 = (bf16*)(smem + DN_S2);
    bf16* Ab = (bf16*)(smem + DN_AB); float* Rb = (float*)(smem + DN_VB);
    bf16* Qb = (bf16*)(smem + DN_QB); bf16* Kb = (bf16*)(smem + DN_KB); bf16* Vb = (bf16*)(smem + DN_VB);
    float* rq = (float*)(smem + DN_SM); float* rk = rq + 64; float* gs = rk + 64; float* bs = gs + 64; float* gcs = bs + 64;
    const int wave = c.wave;
    for (int _k = 0, _n = loop_iters(NCH * 8, c); _k < _n; ++_k) {
        int item = c.vb + _k * c.nvb; if (item >= (NCH * 8)) item = (NCH * 8) - 1;
        int tid = c.tid; LAUNDER_V(tid); const int lane = tid & 63;
        const int d = item & 1, h = (item >> 1) & 3, ch = item >> 3;
        const bool lat = ch >= NCH_CTX;
        const int cps = lat ? CPS_LAT : CPS_CTX; const int ci = lat ? (ch - NCH_CTX) % CPS_LAT : ch % CPS_CTX;
        const int lseq = cps * 64; const size_t tok_seq = (size_t)(ch - ci) * 64;
        __syncthreads();
        {
            const int cc = lane, tq = wave;
#pragma unroll
            for (int arr = 0; arr < 3; ++arr) {
                const int chn = arr * 256 + h * 64 + cc; float wv[5];
#pragma unroll
                for (int j = 0; j < 5; ++j) wv[j] = p.dn_conv[((size_t)l * 5 + j) * 768 + chn];
                float in[20];
#pragma unroll
                for (int i = 0; i < 20; ++i) { const int pos = ci * 64 + tq * 16 + i - 2; in[i] = (pos >= 0 && pos < lseq) ? bf2f(p.proj[(tok_seq + pos) * NPROJ + QKV + chn]) : 0.f; }
#pragma unroll
                for (int i = 0; i < 16; ++i) {
                    float s = 0.f;
#pragma unroll
                    for (int j = 0; j < 5; ++j) s += wv[j] * in[i + j];
                    s = silu_f(s);
                    const int jt = tq * 16 + i, tau = d ? 63 - jt : jt;
                    if (arr == 0) stq[tau * 65 + cc] = s; else if (arr == 1) stk[tau * 65 + cc] = s; else Vb[tau * 64 + cc] = f2bf(s);
                }
            }
        }
        __syncthreads();
        if (tid < 128) {
            const float* st = tid < 64 ? stq : stk; const int t = tid & 63; float ss = 0.f;
            for (int q = 0; q < 64; ++q) { const float v = st[t * 65 + q]; ss += v * v; }
            (tid < 64 ? rq : rk)[t] = 1.0f / sqrtf(ss + EPS);
        } else if (tid < 192) {
            const int tau = tid - 128; const size_t tok = (size_t)ch * 64 + (d ? 63 - tau : tau);
            const float braw = p.gates[tok * 16 + d * 4 + h], araw = p.gates[tok * 16 + 8 + d * 4 + h];
            bs[tau] = sigmoid_f(braw);
            gs[tau] = -expf(p.dn_a_log[(l * 2 + d) * 4 + h]) * softplus_f(araw + p.dn_dt_bias[(l * 2 + d) * 4 + h]);
        }
        __syncthreads();
        {
            const int cc = lane;
            for (int t = wave * 16; t < wave * 16 + 16; ++t) { Qb[t * 72 + cc] = f2bf(stq[t * 65 + cc] * rq[t]); Kb[t * 72 + cc] = f2bf(stk[t * 65 + cc] * rk[t]); }
            if (tid == 0) { float a = 0.f; for (int t = 0; t < 64; ++t) { a += gs[t]; gcs[t] = a; } }
        }
        __syncthreads();
        const float gl = gcs[63];
        {
            f32x4 kk[1][4], qk[1][4]; zero_acc(kk); zero_acc(qk);
            mma_tiles<1, 4>(kk, Kb + wave * 16 * 72, 72, Kb, 72, 64, lane);
            mma_tiles<1, 4>(qk, Qb + wave * 16 * 72, 72, Kb, 72, 64, lane);
            __syncthreads();
#pragma unroll
            for (int nt = 0; nt < 4; ++nt)
#pragma unroll
                for (int r = 0; r < 4; ++r) {
                    const int tau = wave * 16 + (lane >> 4) * 4 + r, sg = nt * 16 + (lane & 15);
                    const float dec = sg <= tau ? expf(gcs[tau] - gcs[sg]) : 0.f;
                    Ab[tau * 72 + sg] = f2bf(sg < tau ? -kk[0][nt][r] * dec * bs[tau] : 0.f);
                    S1[(64 + tau) * 72 + sg] = f2bf(qk[0][nt][r] * 0.125f * dec);
                }
            for (int i = tid; i < 18432 / 16; i += 256) *(u32x4*)((char*)S2 + i * 16) = (u32x4){0u, 0u, 0u, 0u};
            const int tau = lane;
            const float kd = expf(gl - gcs[tau]);
            for (int dk = wave * 16; dk < wave * 16 + 16; ++dk) S1[dk * 72 + tau] = f2bf(bf2f(Kb[tau * 72 + dk]) * kd);
        }
        __syncthreads();
        {
            f32x4 rhs[4][2];
#pragma unroll
            for (int I = 0; I < 4; ++I)
#pragma unroll
                for (int nt = 0; nt < 2; ++nt)
#pragma unroll
                    for (int r = 0; r < 4; ++r) {
                        const int tau = I * 16 + (lane >> 4) * 4 + r, col = wave * 32 + nt * 16 + (lane & 15);
                        rhs[I][nt][r] = wave < 2 ? bf2f(Kb[tau * 72 + col]) * (bs[tau] * expf(gcs[tau])) : bf2f(Vb[tau * 64 + col - 64]) * bs[tau];
                    }
            __syncthreads();
#pragma unroll
            for (int I = 0; I < 4; ++I) {
                f32x4 acc[1][2]; acc[0][0] = rhs[I][0]; acc[0][1] = rhs[I][1];
                mma_tiles<1, 2>(acc, Ab + I * 16 * 72, 72, S2 + wave * 32 * 72, 72, 64, lane);
#pragma unroll
                for (int nt = 0; nt < 2; ++nt)
#pragma unroll
                    for (int r = 0; r < 4; ++r) Rb[((lane >> 4) * 4 + r) * 128 + wave * 32 + nt * 16 + (lane & 15)] = acc[0][nt][r];
                __syncthreads();
                if (tid < 128) {
                    const int col = tid; float x[16];
#pragma unroll
                    for (int r = 0; r < 16; ++r) x[r] = Rb[r * 128 + col];
#pragma unroll
                    for (int r = 1; r < 16; ++r) {
                        const bf16* ar = Ab + (I * 16 + r) * 72 + I * 16;
#pragma unroll
                        for (int k = 0; k < r; ++k) x[r] += bf2f(ar[k]) * x[k];
                    }
                    u32x4 w0, w1;
                    w0.x = pk2(x[0], x[1]); w0.y = pk2(x[2], x[3]); w0.z = pk2(x[4], x[5]); w0.w = pk2(x[6], x[7]);
                    w1.x = pk2(x[8], x[9]); w1.y = pk2(x[10], x[11]); w1.z = pk2(x[12], x[13]); w1.w = pk2(x[14], x[15]);
                    *(u32x4*)(S2 + col * 72 + I * 16) = w0; *(u32x4*)(S2 + col * 72 + I * 16 + 8) = w1;
                }
                __syncthreads();
            }
        }
        __syncthreads();
        {
            const size_t ib = (size_t)item * 4096;
#pragma unroll 1
            for (int half = 0; half < 2; ++half) {
                f32x4 acc[2][4]; zero_acc(acc);
                mma_tiles<2, 4>(acc, S1 + wave * 32 * 72, 72, S2 + half * 64 * 72, 72, 64, lane);
#pragma unroll
                for (int mt = 0; mt < 2; ++mt)
#pragma unroll
                    for (int nt = 0; nt < 4; ++nt) {
                        const int row0 = wave * 32 + mt * 16 + (lane >> 4) * 4, cx = nt * 16 + (lane & 15);
                        if (half == 0) {
                            if (row0 < 64) { for (int r = 0; r < 4; ++r) p.dnAp[ib + (row0 + r) * 64 + cx] = f2bf(-acc[mt][nt][r]); }
                            else { const int t0 = row0 - 64; for (int r = 0; r < 4; ++r) { const int tau = t0 + r; const float qe = bf2f(Qb[tau * 72 + cx]) * 0.125f * expf(gcs[tau]); p.dnQh[ib + tau * 64 + cx] = f2bf(qe - acc[mt][nt][r]); } }
                        } else {
                            u32x2 w; w.x = pk2(acc[mt][nt][0], acc[mt][nt][1]); w.y = pk2(acc[mt][nt][2], acc[mt][nt][3]);
                            if (row0 < 64) *(u32x2*)(p.dnBT + ib + cx * 64 + row0) = w;
                            else *(u32x2*)(p.dnOT + ib + cx * 64 + (row0 - 64)) = w;
                        }
                    }
            }
            if (tid == 0) p.dnEgl[item] = expf(gl);
        }
    }
}
constexpr int DN2_LDS = 64 * 72 * 2;
struct ScanOps {
#ifdef EMU
    const bf16 *ap, *qh;
#else
    bf16x8 ap[2], qh[2];
#endif
    u32x2 bt[4], ot[4]; float egl;
};
__device__ __forceinline__ void scan_load(ScanOps& o, const Params& p, int item, int wave, int lane) {
    const size_t ib = (size_t)item * 4096;
#ifdef EMU
    o.ap = p.dnAp + ib + wave * 16 * 64; o.qh = p.dnQh + ib + wave * 16 * 64;
#else
#pragma unroll
    for (int ks = 0; ks < 2; ++ks) {
        o.ap[ks] = *(const bf16x8*)(p.dnAp + ib + (wave * 16 + (lane & 15)) * 64 + ks * 32 + (lane >> 4) * 8);
        o.qh[ks] = *(const bf16x8*)(p.dnQh + ib + (wave * 16 + (lane & 15)) * 64 + ks * 32 + (lane >> 4) * 8);
    }
#endif
#pragma unroll
    for (int nt = 0; nt < 4; ++nt) {
        const int dv = nt * 16 + (lane & 15), r0 = wave * 16 + (lane >> 4) * 4;
        o.bt[nt] = *(const u32x2*)(p.dnBT + ib + dv * 64 + r0); o.ot[nt] = *(const u32x2*)(p.dnOT + ib + dv * 64 + r0);
    }
    o.egl = p.dnEgl[item];
}
__device__ __forceinline__ void scan_mma(f32x4 (&acc)[1][4], const ScanOps& o, bool useQ, const bf16* ST, int lane) {
#ifdef EMU
    mma_tiles<1, 4>(acc, useQ ? o.qh : o.ap, 64, ST, 72, 64, lane);
#else
#pragma unroll
    for (int ks = 0; ks < 2; ++ks)
#pragma unroll
        for (int nt = 0; nt < 4; ++nt) {
            const bf16x8 b = *(const bf16x8*)(ST + (nt * 16 + (lane & 15)) * 72 + ks * 32 + (lane >> 4) * 8);
            acc[0][nt] = __builtin_amdgcn_mfma_f32_16x16x32_bf16(useQ ? o.qh[ks] : o.ap[ks], b, acc[0][nt], 0, 0, 0);
        }
#endif
}
__device__ __forceinline__ void dn_scan_body(const Params& p, int l, const Ctx& c) {
    bf16* ST = (bf16*)c.smem;
    const int lane = c.lane, wave = c.wave;
    for (int chain = c.vb; chain < NSEQ * 8; chain += c.nvb) {
        const int d = chain & 1, h = (chain >> 1) & 3, seq = chain >> 3;
        const bool lat = seq >= BATCH; const int cps = lat ? CPS_LAT : CPS_CTX; const int ch0 = lat ? NCH_CTX + (seq - BATCH) * CPS_LAT : seq * CPS_CTX;
        f32x4 S[1][4];
#pragma unroll
        for (int nt = 0; nt < 4; ++nt)
#pragma unroll
            for (int r = 0; r < 4; ++r) {
                const int dk = wave * 16 + (lane >> 4) * 4 + r, dv = nt * 16 + (lane & 15);
                S[0][nt][r] = lat ? p.state_delta[(((((size_t)(seq - BATCH) * DEPTH + l) * 2 + d) * 4 + h) * 64 + dk) * 64 + dv] : 0.f;
            }
#define SCAN_ITEM(qq) ((((ch0 + (d ? cps - 1 - ((qq) < cps ? (qq) : cps - 1) : ((qq) < cps ? (qq) : cps - 1))) * 4 + h) * 2) + d)
#define SCAN_STEP(ops, qq) do { \
            const int ch = ch0 + (d ? cps - 1 - (qq) : (qq)); \
            __syncthreads(); \
            _Pragma("unroll") for (int nt = 0; nt < 4; ++nt) { u32x2 w; w.x = pk2(S[0][nt][0], S[0][nt][1]); w.y = pk2(S[0][nt][2], S[0][nt][3]); *(u32x2*)(ST + (nt * 16 + (lane & 15)) * 72 + wave * 16 + (lane >> 4) * 4) = w; } \
            __syncthreads(); \
            f32x4 Sn[1][4], O[1][4]; \
            _Pragma("unroll") for (int nt = 0; nt < 4; ++nt) { \
                const u32x2 wb = ops.bt[nt], wo = ops.ot[nt]; \
                Sn[0][nt][0] = ops.egl * S[0][nt][0] + bf2f((bf16)(wb.x & 0xffff)); Sn[0][nt][1] = ops.egl * S[0][nt][1] + bf2f((bf16)(wb.x >> 16)); \
                Sn[0][nt][2] = ops.egl * S[0][nt][2] + bf2f((bf16)(wb.y & 0xffff)); Sn[0][nt][3] = ops.egl * S[0][nt][3] + bf2f((bf16)(wb.y >> 16)); \
                O[0][nt][0] = bf2f((bf16)(wo.x & 0xffff)); O[0][nt][1] = bf2f((bf16)(wo.x >> 16)); O[0][nt][2] = bf2f((bf16)(wo.y & 0xffff)); O[0][nt][3] = bf2f((bf16)(wo.y >> 16)); \
            } \
            scan_mma(Sn, ops, false, ST, lane); \
            scan_mma(O, ops, true, ST, lane); \
            _Pragma("unroll") for (int nt = 0; nt < 4; ++nt) \
                _Pragma("unroll") for (int r = 0; r < 4; ++r) { \
                    const int tau = wave * 16 + (lane >> 4) * 4 + r; const size_t tok = (size_t)ch * 64 + (d ? 63 - tau : tau); \
                    p.obuf[((size_t)d * NTOK + tok) * 256 + h * 64 + nt * 16 + (lane & 15)] = f2bf(O[0][nt][r]); \
                    S[0][nt][r] = Sn[0][nt][r]; \
                } \
        } while (0)
        ScanOps o0, o1, o2;
        scan_load(o0, p, SCAN_ITEM(0), wave, lane); scan_load(o1, p, SCAN_ITEM(1), wave, lane);
        int q = 0;
#pragma unroll 1
        for (; q + 3 <= cps; q += 3) {
            scan_load(o2, p, SCAN_ITEM(q + 2), wave, lane); SCAN_STEP(o0, q);
            scan_load(o0, p, SCAN_ITEM(q + 3), wave, lane); SCAN_STEP(o1, q + 1);
            scan_load(o1, p, SCAN_ITEM(q + 4), wave, lane); SCAN_STEP(o2, q + 2);
        }
        if (q < cps) { SCAN_STEP(o0, q); ++q; }
        if (q < cps) { SCAN_STEP(o1, q); ++q; }
#undef SCAN_STEP
#undef SCAN_ITEM
        if (!lat) {
#pragma unroll
            for (int nt = 0; nt < 4; ++nt)
#pragma unroll
                for (int r = 0; r < 4; ++r) {
                    const int dk = wave * 16 + (lane >> 4) * 4 + r, dv = nt * 16 + (lane & 15);
                    p.out[OUT_DN + (((((size_t)seq * DEPTH + l) * 2 + d) * 4 + h) * 64 + dk) * 64 + dv] = S[0][nt][r];
                }
        }
    }
}
__device__ __forceinline__ void dn_d3_body(const Params& p, int l, const Ctx& c) {
    const int lane = c.lane, wave = c.wave;
    for (size_t tok = (size_t)c.vb * 4 + wave; tok < (size_t)NTOK; tok += (size_t)c.nvb * 4) {
        const u32x2 a = *(const u32x2*)(p.obuf + tok * 256 + lane * 4), b = *(const u32x2*)(p.obuf + ((size_t)NTOK + tok) * 256 + lane * 4);
        const u32x2 zz = *(const u32x2*)(p.proj + tok * NPROJ + DZ + lane * 4);
        float v[4] = {bf2f((bf16)(a.x & 0xffff)) + bf2f((bf16)(b.x & 0xffff)), bf2f((bf16)(a.x >> 16)) + bf2f((bf16)(b.x >> 16)),
                      bf2f((bf16)(a.y & 0xffff)) + bf2f((bf16)(b.y & 0xffff)), bf2f((bf16)(a.y >> 16)) + bf2f((bf16)(b.y >> 16))};
        const float z[4] = {bf2f((bf16)(zz.x & 0xffff)), bf2f((bf16)(zz.x >> 16)), bf2f((bf16)(zz.y & 0xffff)), bf2f((bf16)(zz.y >> 16))};
        float ss = v[0] * v[0] + v[1] * v[1] + v[2] * v[2] + v[3] * v[3];
        ss += __shfl_xor(ss, 1); ss += __shfl_xor(ss, 2); ss += __shfl_xor(ss, 4); ss += __shfl_xor(ss, 8);
        const float rs = 1.0f / sqrtf(ss / 64.f + EPS);
        const int q0 = (lane & 15) * 4; float y[4];
#pragma unroll
        for (int i = 0; i < 4; ++i) y[i] = v[i] * rs * p.dn_norm_g[l * 64 + q0 + i] * silu_f(z[i]);
        u32x2 w; w.x = pk2(y[0], y[1]); w.y = pk2(y[2], y[3]);
        *(u32x2*)(p.mix + tok * DMIX + 256 + lane * 4) = w;
    }
}

__device__ __forceinline__ void final_norm_body(const Params& p, const Ctx& c) {
    const int lane = c.lane, wave = c.wave;
    for (int tok0 = c.vb * 4; tok0 < NTOK; tok0 += c.nvb * 4) {
        float* xr = p.out + (size_t)(tok0 + wave) * D;
        float v[D / 64]; float ss = 0.f;
#pragma unroll
        for (int j = 0; j < D / 64; ++j) { v[j] = xr[j * 64 + lane]; ss += v[j] * v[j]; }
#pragma unroll
        for (int o = 1; o < 64; o <<= 1) ss += __shfl_xor(ss, o);
        const float rs = 1.0f / sqrtf(ss / (float)D + EPS);
#pragma unroll
        for (int j = 0; j < D / 64; ++j) xr[j * 64 + lane] = v[j] * rs * p.final_g[j * 64 + lane];
    }
}

enum { PH_PREP = 0, PH_NORM, PH_GEMM_IN, PH_LOCAL, PH_SCAN, PH_POST, PH_POST2, PH_GEMM_OUT, PH_FINAL };
__device__ __forceinline__ Ctx make_ctx(char* smem) {
    Ctx c; const int hb = UNIFORM((int)(threadIdx.x >> 8));
    c.tid = threadIdx.x & 255; c.lane = c.tid & 63; c.wave = UNIFORM(c.tid >> 6); c.vb = blockIdx.x * 2 + hb; c.nvb = gridDim.x * 2; c.smem = smem + hb * HALF_LDS;
    return c;
}
__device__ __forceinline__ Ctx shifted(const Ctx& c, int by) { Ctx s = c; s.vb = (c.vb + c.nvb - (by % c.nvb)) % c.nvb; return s; }
__device__ __forceinline__ void run_phase(const Params& p, int ph, int l, const Ctx& c0) {
    Ctx c = c0;
    LAUNDER_V(c.tid); c.lane = c.tid & 63; c.wave = UNIFORM(c.tid >> 6); LAUNDER_S(c.vb); LAUNDER_S(l);
    switch (ph) {
    case PH_PREP: prep_weights_body(p, (size_t)c.vb * 256 + c.tid, (size_t)c.nvb * 256); prep_tiled_body(p, c); break;
    case PH_NORM: norm_mod_body(p, l, c); break;
    case PH_GEMM_IN: { EpiProj e{p.proj, p.gates}; gemm_body(p.hbuf, D, p.winT + (size_t)l * NPAD * D, D, NTOK, NPAD, D, e, c); } break;
    case PH_LOCAL:
        dn_d1_body(p, l, c); __syncthreads();
        pool_body(p, l, c); __syncthreads();
        ft_ctx_body(p, shifted(c, 0)); __syncthreads();
        ft_latA_body(p, shifted(c, BATCH * 4)); __syncthreads();
        s5_pass1_body(p, l, c);
        break;
    case PH_SCAN:
        dn_scan_body(p, l, c);
        ft_latB_body(p, shifted(c, NSEQ * 8));
        s5_carry_body(p, l, shifted(c, NSEQ * 8 + DEC_BATCH * 64));
        break;
    case PH_POST: s5_pass3_body(p, l, c); dn_d3_body(p, l, c); break;
    case PH_POST2: {
        EpiGlu eg{&p, l}; gemm_body(p.ybuf, 256, p.gluT + (size_t)l * 65536, 256, NTOK, 256, 256, eg, c); __syncthreads();
        EpiFt ef{&p}; gemm_body(p.fbuf, 256, p.ftwT + (size_t)l * 65536, 256, NTOK, 256, 256, ef, c);
    } break;
    case PH_GEMM_OUT: { EpiOut e{&p, l}; gemm_body(p.mix, DMIX, p.woutT + (size_t)l * D * DMIX, DMIX, NTOK, D, DMIX, e, c); } break;
    case PH_FINAL: final_norm_body(p, c); break;
#ifdef PROBE_PH
    case 10: dn_d1_body(p, l, c); break;
    case 11: pool_body(p, l, c); break;
    case 12: ft_ctx_body(p, c); __syncthreads(); ft_latA_body(p, c); break;
    case 14: s5_pass1_body(p, l, c); break;
    case 15: s5_pass3_body(p, l, c); break;
    case 16: dn_d3_body(p, l, c); break;
    case 17: dn_scan_body(p, l, c); break;
    case 18: ft_latB_body(p, shifted(c, NSEQ * 8)); s5_carry_body(p, l, shifted(c, NSEQ * 8 + DEC_BATCH * 64)); break;
#endif
    }
}
#ifndef EMU
#define XB_TMO      128
#define XB_XCNT(j)  (256  + 64 * (j))
#define XB_XSUB(j)  (1280 + 64 * (j))
#define XB_XGEN(j)  (2304 + 64 * (j))
#define XB_TOP      3328
#define XB_TOPGEN   3392
#define XCD_BAR_WORDS 3456
#define XB_SPIN_CAP (1u << 18)
#define LAS __attribute__((address_space(3)))
__device__ __forceinline__ unsigned xb_ld(unsigned* p)              { return __hip_atomic_load(p, __ATOMIC_RELAXED, __HIP_MEMORY_SCOPE_AGENT); }
__device__ __forceinline__ unsigned xb_add(unsigned* p, unsigned v) { return __hip_atomic_fetch_add(p, v, __ATOMIC_RELAXED, __HIP_MEMORY_SCOPE_AGENT); }
__device__ __forceinline__ unsigned xb_xcc_id() { return (unsigned)__builtin_amdgcn_s_getreg((3 << 11) | 20) & 0xFu; }
#define XB_SPIN(cond, bar) do { unsigned _sp = 0; while (cond) { __builtin_amdgcn_s_sleep(1); \
    if ((++_sp & 255u) == 0u) { if (xb_ld(&(bar)[XB_TMO])) break; if (_sp > XB_SPIN_CAP) { atomicAdd(&(bar)[XB_TMO], 1u); break; } } } } while (0)
struct XcdBarrier { unsigned* bar; unsigned x; volatile LAS unsigned* st; };
__device__ __forceinline__ XcdBarrier xcd_barrier_post(unsigned* bar, volatile LAS unsigned* st) {
    XcdBarrier b; b.bar = bar; b.x = xb_xcc_id(); b.st = st;
    if (threadIdx.x == 0) (void)xb_add(&bar[XB_XCNT(b.x)], 1u);
    return b;
}
__device__ __forceinline__ void xcd_barrier_complete(unsigned* bar, unsigned x, unsigned& nloc, unsigned& nx) {
    const unsigned G = gridDim.x * gridDim.y * gridDim.z;
    unsigned sum, cnt, mine, sp = 0u;
    for (;;) {
        sum = 0u; cnt = 0u; mine = 0u;
#pragma unroll
        for (unsigned j = 0; j < 16; ++j) { const unsigned c = xb_ld(&bar[XB_XCNT(j)]); sum += c; cnt += (c > 0u) ? 1u : 0u; mine = (j == x) ? c : mine; }
        if (sum == G) break;
        __builtin_amdgcn_s_sleep(1);
        if ((++sp & 255u) == 0u) { if (xb_ld(&bar[XB_TMO])) break; if (sp > XB_SPIN_CAP) { atomicAdd(&bar[XB_TMO], 1u); break; } }
    }
    nloc = mine > 0u ? mine : 1u; nx = cnt > 0u ? cnt : 1u;
}
__device__ __forceinline__ void xcd_barrier(const XcdBarrier& b) {
    asm volatile("s_waitcnt vmcnt(0)" ::: "memory");
    __syncthreads();
    if (threadIdx.x == 0) {
        unsigned* bar = b.bar;
        __builtin_amdgcn_s_waitcnt(0);
        unsigned nloc = b.st[0], nx = b.st[1];
        if (nloc == 0u) { xcd_barrier_complete(bar, b.x, nloc, nx); b.st[0] = nloc; b.st[1] = nx; }
        const unsigned old = xb_add(&bar[XB_XSUB(b.x)], 1u);
        const unsigned gen = old / nloc;
        if (old + 1u == (gen + 1u) * nloc) {
            __builtin_amdgcn_fence(__ATOMIC_RELEASE, "agent");
            asm volatile("s_waitcnt vmcnt(0)" ::: "memory");
            const unsigned og = xb_add(&bar[XB_TOP], 1u);
            const unsigned tg = og / nx;
            if (og + 1u == (tg + 1u) * nx) xb_add(&bar[XB_TOPGEN], 1u);
            else XB_SPIN(xb_ld(&bar[XB_TOPGEN]) == tg, bar);
            __builtin_amdgcn_fence(__ATOMIC_ACQUIRE, "agent");
            xb_add(&bar[XB_XGEN(b.x)], 1u);
            asm volatile("s_waitcnt vmcnt(0)" ::: "memory");
        } else {
            XB_SPIN(xb_ld(&bar[XB_XGEN(b.x)]) == gen, bar);
            __builtin_amdgcn_fence(__ATOMIC_ACQUIRE, "agent");
            asm volatile("s_waitcnt vmcnt(0)" ::: "memory");
        }
    }
    __syncthreads();
}
#endif
constexpr int MEGA_LDS = 2 * HALF_LDS + 16;
#ifdef EMU
__global__ void __launch_bounds__(512) k_phase(Params p, int ph, int l) { DYN_LDS(smem); const Ctx c = make_ctx(smem); run_phase(p, ph, l, c); }
#else
__global__ void __launch_bounds__(512) k_mega(Params p) {
    DYN_LDS(smem);
    volatile LAS unsigned* st = (volatile LAS unsigned*)(smem + 2 * HALF_LDS);
    if (threadIdx.x < 4) st[threadIdx.x] = 0u;
    __syncthreads();
    const XcdBarrier bar = xcd_barrier_post(p.bar, st);
#define GRID_SYNC() xcd_barrier(bar)
    const Ctx c = make_ctx(smem);
    run_phase(p, PH_PREP, 0, c); GRID_SYNC();
#ifdef PROBE_SYNCS
#pragma unroll 1
    for (int i = 0; i < PROBE_SYNCS; ++i) GRID_SYNC();
#endif
#ifdef PROBE_PH
#pragma unroll 1
    for (int i = 0; i < PROBE_REP; ++i) { run_phase(p, PROBE_PH, 0, c); GRID_SYNC(); }
#endif
#pragma unroll 1
    for (int l = 0; l < DEPTH; ++l) {
        run_phase(p, PH_NORM, l, c); GRID_SYNC();
        run_phase(p, PH_GEMM_IN, l, c); GRID_SYNC();
        run_phase(p, PH_LOCAL, l, c); GRID_SYNC();
        run_phase(p, PH_SCAN, l, c); GRID_SYNC();
        run_phase(p, PH_POST, l, c); GRID_SYNC();
        run_phase(p, PH_POST2, l, c); GRID_SYNC();
        run_phase(p, PH_GEMM_OUT, l, c); GRID_SYNC();
    }
    run_phase(p, PH_FINAL, 0, c);
}
#endif

static size_t ws_carve(Params& p, char* ws) {
    size_t off = 0;
    auto take = [&](size_t bytes) { size_t o = off; off += (bytes + 255) & ~(size_t)255; return ws ? ws + o : (char*)nullptr; };
    p.bar = (unsigned*)take(16384);
    p.winT = (bf16*)take((size_t)DEPTH * NPAD * D * 2);
    p.woutT = (bf16*)take((size_t)DEPTH * D * DMIX * 2);
    p.ftwT = (bf16*)take((size_t)DEPTH * 65536 * 2);
    p.gluT = (bf16*)take((size_t)DEPTH * 65536 * 2);
    p.poolwT = (bf16*)take((size_t)DEPTH * 4 * 4096 * 2);
    p.Cmat = (bf16*)take((size_t)DEPTH * 16 * 4096 * 2);
    p.tabDc = (bf16*)take(128 * 64 * 2);
    p.tabE = (bf16*)take(128 * 128 * 2);
    p.tabT = (bf16*)take((size_t)SEQ * 2 * SEQ * 2);
    p.ada = (float*)take((size_t)DEPTH * NCOND * 3 * D * 4);
    p.abar = (float*)take((size_t)DEPTH * 2 * 16 * 64 * 2 * 4);
    p.abar64 = (float*)take((size_t)DEPTH * 2 * 16 * 64 * 2 * 4);
    p.bbar = (float*)take((size_t)DEPTH * 2 * 16 * 64 * 32 * 4);
    p.hbuf = (bf16*)take((size_t)NTOK * DMIX * 2);
    p.mix = p.hbuf;
    p.proj = (bf16*)take((size_t)NTOK * NPROJ * 2);
    p.fbuf = (bf16*)take((size_t)NTOK * 256 * 2);
    p.ybuf = (bf16*)take((size_t)NTOK * 256 * 2);
    p.obuf = (bf16*)take((size_t)2 * NTOK * 256 * 2);
    p.Zg = (bf16*)take((size_t)DEC_BATCH * 64 * 256 * 128 * 2);
    p.dnAp = (bf16*)take((size_t)NCH * 8 * 4096 * 2);
    p.dnQh = (bf16*)take((size_t)NCH * 8 * 4096 * 2);
    p.dnBT = (bf16*)take((size_t)NCH * 8 * 4096 * 2);
    p.dnOT = (bf16*)take((size_t)NCH * 8 * 4096 * 2);
    p.gates = (float*)take((size_t)NTOK * 16 * 4);
    p.dnEgl = (float*)take((size_t)NCH * 8 * 4);
    p.s5E = (float*)take((size_t)NCH * 16 * 2 * 128 * 4);
    p.s5S = (float*)take((size_t)NCH * 16 * 2 * 128 * 4);
    return off;
}

#ifdef EMU
void emu_hook(const char* tag, int l, const Params& p);
#define HOOK(tag, l) emu_hook(tag, l, p)
#endif
extern "C" void kernel_launch(void* const* d_in, const int* in_sizes, int n_in, void* d_out, int out_size, void* d_ws, size_t ws_size, hipStream_t stream) {
    Params p;
    memset(&p, 0, sizeof(p));
    const float** ip = (const float**)&p;
    for (int i = 0; i < 29; ++i) ip[i] = (const float*)d_in[i];
    p.out = (float*)d_out;
    const size_t need = ws_carve(p, (char*)d_ws);
    if (need > ws_size || n_in != 29) { fprintf(stderr, "kernel_launch: workspace %zu < %zu or n_in %d\n", ws_size, need, n_in); return; }
#ifdef EMU
    const int G = 6;
    LAUNCH(k_phase, G, 512, MEGA_LDS, stream, p, (int)PH_PREP, 0);
    for (int l = 0; l < DEPTH; ++l)
        for (int ph = PH_NORM; ph <= PH_GEMM_OUT; ++ph) {
            LAUNCH(k_phase, G, 512, MEGA_LDS, stream, p, ph, l);
            if (ph == PH_NORM) HOOK("norm", l);
            if (ph == PH_GEMM_IN) HOOK("proj", l);
            if (ph == PH_POST2) HOOK("mix", l);
            if (ph == PH_GEMM_OUT) HOOK("xout", l);
        }
    LAUNCH(k_phase, G, 512, MEGA_LDS, stream, p, (int)PH_FINAL, 0);
#else
    static int grid = 0;
    if (!grid) {
        int dev = 0, cus = 0, per_cu = 0;
        (void)hipGetDevice(&dev);
        (void)hipDeviceGetAttribute(&cus, hipDeviceAttributeMultiprocessorCount, dev);
        (void)hipFuncSetAttribute((const void*)k_mega, hipFuncAttributeMaxDynamicSharedMemorySize, MEGA_LDS);
        (void)hipOccupancyMaxActiveBlocksPerMultiprocessor(&per_cu, (const void*)k_mega, 512, MEGA_LDS);
        if (per_cu < 1) { fprintf(stderr, "kernel_launch: occupancy query says %d blocks/CU\n", per_cu); per_cu = 1; }
        grid = cus * 1;
        fprintf(stderr, "kernel_launch: cus %d per_cu %d grid %d\n", cus, per_cu, grid);
    }
    (void)hipMemsetAsync(p.bar, 0, 16384, stream);
    void* args[] = {&p};
    hipError_t e = hipLaunchCooperativeKernel((const void*)k_mega, dim3(grid), dim3(512), args, MEGA_LDS, stream);
    if (e != hipSuccess) fprintf(stderr, "cooperative launch failed: %s (grid %d)\n", hipGetErrorString(e), grid);
#endif
}
```

```cpp
#ifdef EMU
#include "hip_emu.h"
#define LAUNCH(k, g, b, l, s, ...) EMU_LAUNCH(k, g, b, l, s, __VA_ARGS__)
#define DYN_LDS(name) char* name = emu::dyn_lds
#define WAVE_SYNC() emu_wave_sync()
#define BLOCK_SYNC() __syncthreads()
#define SCHED_BARRIER()
#define UNIFORM(x) (x)
#define LAUNDER_V(x)
#define LAUNDER_S(x)
#else
#include <hip/hip_runtime.h>
#include <hip/hip_cooperative_groups.h>
#include <cstdio>
#include <cstdint>
#include <cstring>
#define LAUNCH(k, g, b, l, s, ...) hipLaunchKernelGGL(k, dim3(g), dim3(b), l, s, __VA_ARGS__)
#define DYN_LDS(name) extern __shared__ __attribute__((aligned(16))) char name[]
#define WAVE_SYNC() do { __builtin_amdgcn_s_waitcnt(0xc07f); __builtin_amdgcn_wave_barrier(); } while (0)
#define SCHED_BARRIER() __builtin_amdgcn_sched_barrier(0)
#define BLOCK_SYNC() do { asm volatile("s_waitcnt lgkmcnt(0)" ::: "memory"); __builtin_amdgcn_s_barrier(); asm volatile("" ::: "memory"); } while (0)
#define UNIFORM(x) __builtin_amdgcn_readfirstlane(x)
#define LAUNDER_V(x) asm volatile("" : "+v"(x))
#define LAUNDER_S(x) asm volatile("" : "+s"(x))
#endif

#ifndef D_MODEL
#define D_MODEL 1024
#endif
#ifndef BATCH
#define BATCH 16
#endif
#ifndef SEQ
#define SEQ 256
#endif
#ifndef DEPTH
#define DEPTH 4
#endif
#ifndef DEC_BATCH
#define DEC_BATCH 2
#endif
#define DEC_SEQ 4096
constexpr int D = D_MODEL;
constexpr int NCTX = BATCH * SEQ, NLAT = DEC_BATCH * DEC_SEQ, NTOK = NCTX + NLAT;
constexpr int NCH_CTX = NCTX / 64, NCH_LAT = NLAT / 64, NCH = NTOK / 64;
constexpr int CPS_CTX = SEQ / 64, CPS_LAT = 64;
constexpr int NSEQ = BATCH + DEC_BATCH, NCOND = 1 + DEC_BATCH;
constexpr int BR = 256, DMIX = 1024;
constexpr int PU = 0, PZ = 256, QKV = 512, DZ = 1280, SU = 1536, SZ = 1792, FU = 2048, FZ = 2304, NPROJ = 2560, NPAD = 2688;
constexpr int D_IN_PROJ = 2576;
constexpr float EPS = 1e-6f;

typedef unsigned short bf16;
typedef float f32x4 __attribute__((ext_vector_type(4)));
typedef short bf16x8 __attribute__((ext_vector_type(8)));
typedef unsigned u32x2 __attribute__((ext_vector_type(2)));
typedef unsigned u32x4 __attribute__((ext_vector_type(4)));

__device__ __forceinline__ unsigned f2u(float f) { return __builtin_bit_cast(unsigned, f); }
__device__ __forceinline__ float u2f(unsigned u) { return __builtin_bit_cast(float, u); }
#ifdef EMU
__device__ __forceinline__ bf16 f2bf(float f) { unsigned u = f2u(f); return (bf16)((u + 0x7fffu + ((u >> 16) & 1u)) >> 16); }
__device__ __forceinline__ unsigned pk2(float lo, float hi) { return (unsigned)f2bf(lo) | ((unsigned)f2bf(hi) << 16); }
#else
typedef __bf16 hwbf2 __attribute__((ext_vector_type(2)));
typedef float hwf2 __attribute__((ext_vector_type(2)));
__device__ __forceinline__ bf16 f2bf(float f) { const __bf16 h = (__bf16)f; return __builtin_bit_cast(bf16, h); }
__device__ __forceinline__ unsigned pk2(float lo, float hi) { const hwf2 v = {lo, hi}; const hwbf2 b = __builtin_convertvector(v, hwbf2); return __builtin_bit_cast(unsigned, b); }
#endif
__device__ __forceinline__ float bf2f(bf16 h) { return u2f((unsigned)h << 16); }
__device__ __forceinline__ float silu_f(float x) { return x / (1.0f + expf(-x)); }
__device__ __forceinline__ float sigmoid_f(float x) { return 1.0f / (1.0f + expf(-x)); }
__device__ __forceinline__ float softplus_f(float x) { return x > 20.f ? x : log1pf(expf(x)); }
__device__ __forceinline__ float gelu_f(float x) { return 0.5f * x * (1.0f + tanhf(0.7978845608028654f * (x + 0.044715f * x * x * x))); }

template <int MT, int NT>
__device__ __forceinline__ void mma_tiles(f32x4 (&acc)[MT][NT], const bf16* A, int lda, const bf16* B, int ldb, int K, int lane) {
#ifdef EMU
    const int col = lane & 15, rq = (lane >> 4) * 4;
    for (int mt = 0; mt < MT; ++mt) for (int nt = 0; nt < NT; ++nt) for (int r = 0; r < 4; ++r) {
        float s = 0.f; const bf16* a = A + (16 * mt + rq + r) * lda; const bf16* b = B + (16 * nt + col) * ldb;
        for (int k = 0; k < K; ++k) s += bf2f(a[k]) * bf2f(b[k]);
        acc[mt][nt][r] += s;
    }
#else
    const bf16* a0 = A + (lane & 15) * lda + (lane >> 4) * 8;
    const bf16* b0 = B + (lane & 15) * ldb + (lane >> 4) * 8;
    for (int k0 = 0; k0 < K; k0 += 32) {
        bf16x8 a[MT], b[NT];
#pragma unroll
        for (int mt = 0; mt < MT; ++mt) a[mt] = *(const bf16x8*)(a0 + 16 * mt * lda + k0);
#pragma unroll
        for (int nt = 0; nt < NT; ++nt) b[nt] = *(const bf16x8*)(b0 + 16 * nt * ldb + k0);
#pragma unroll
        for (int mt = 0; mt < MT; ++mt)
#pragma unroll
            for (int nt = 0; nt < NT; ++nt) acc[mt][nt] = __builtin_amdgcn_mfma_f32_16x16x32_bf16(a[mt], b[nt], acc[mt][nt], 0, 0, 0);
    }
#endif
}
template <int MT, int NT> __device__ __forceinline__ void zero_acc(f32x4 (&acc)[MT][NT]) {
#pragma unroll
    for (int mt = 0; mt < MT; ++mt)
#pragma unroll
        for (int nt = 0; nt < NT; ++nt) acc[mt][nt] = (f32x4){0.f, 0.f, 0.f, 0.f};
}

struct Params {
    const float *x_prompt, *x_sample, *c, *state_delta, *state_s5, *c_ctx, *w_ada, *b_ada, *norm_g, *w_in, *pool_w, *pool_scale,
        *dn_conv, *dn_a_log, *dn_dt_bias, *dn_norm_g, *s5_a_re, *s5_a_im, *s5_log_dt, *s5_b_re, *s5_b_im, *s5_c_re, *s5_c_im,
        *s5_d, *s5_glu_w, *s5_glu_b, *ft_w, *w_out, *final_g;
    float* out;
    bf16 *winT, *woutT, *ftwT, *gluT, *poolwT, *Cmat, *tabDc, *tabE, *tabT;
    float *ada, *abar, *abar64, *bbar;
    bf16 *hbuf  , *mix, *proj, *fbuf, *ybuf, *obuf, *Zg, *dnAp, *dnQh, *dnBT, *dnOT;
    float *gates, *dnEgl, *s5E, *s5S;
    unsigned* bar;
};
constexpr size_t OUT_DN = (size_t)NTOK * D, OUT_S5 = OUT_DN + (size_t)BATCH * DEPTH * 2 * 4 * 64 * 64;
constexpr size_t OUT_TOTAL = OUT_S5 + (size_t)BATCH * DEPTH * 2 * 2 * 16 * 64;

struct Ctx { int tid, lane, wave, vb, nvb; char* smem; };
constexpr int HALF_LDS = 81664;
__device__ __forceinline__ int loop_iters(int N, const Ctx& c) { const int v0 = c.vb & ~1; return N > v0 ? (N - v0 + c.nvb - 1) / c.nvb : 0; }
__device__ __forceinline__ int cond_of(int tok) { return tok < NCTX ? 0 : 1 + (tok - NCTX) / DEC_SEQ; }
__device__ __forceinline__ const float* xrow_in(const Params& p, int l, int tok) {
    if (l == 0) return tok < NCTX ? p.x_prompt + (size_t)tok * D : p.x_sample + (size_t)(tok - NCTX) * D;
    return p.out + (size_t)tok * D;
}

__device__ __forceinline__ void prep_weights_body(const Params& p, size_t gtid, size_t gsz) {
    for (size_t i = gtid; i < (size_t)DEPTH * 4 * 64 * 64; i += gsz) {
        int c = (int)(i % 64), d = (int)((i / 64) % 64); size_t lg = i / 4096;
        p.poolwT[i] = f2bf(p.pool_w[(lg * 64 + c) * 64 + d]);
    }
    for (size_t i = gtid; i < (size_t)DEPTH * 16 * 16 * 256; i += gsz) {
        int k = (int)(i % 256), pp = (int)((i / 256) % 16), g = (int)((i / 4096) % 16), l = (int)(i / 65536);
        int d = k >> 7, part = (k >> 6) & 1, n = k & 63;
        size_t src = ((((size_t)l * 2 + d) * 16 + g) * 16 + pp) * 64 + n;
        p.Cmat[i] = f2bf(part ? -p.s5_c_im[src] : p.s5_c_re[src]);
    }
    const float TWO_PI = 6.283185307179586f;
    for (size_t i = gtid; i < 128 * 64; i += gsz) {
        int c = (int)(i % 64), n = (int)(i / 64), part = n >> 6, kc = n & 63; int m = (c * kc) & 63;
        float a = TWO_PI * (float)m / 64.f; p.tabDc[i] = f2bf(part ? -sinf(a) : cosf(a));
    }
    for (size_t i = gtid; i < 128 * 128; i += gsz) {
        int kk = (int)(i % 128), n = (int)(i / 128); int pp = n >> 6, k1 = n & 63, pt = kk >> 6, t1 = kk & 63; int m = (t1 * k1) & 63;
        float a = TWO_PI * (float)m / 64.f; float C = cosf(a), S = sinf(a);
        float v = (pp == 0) ? (pt == 0 ? C : S) : (pt == 0 ? -S : C);
        p.tabE[i] = f2bf(v);
    }
    for (size_t i = gtid; i < (size_t)SEQ * 2 * SEQ; i += gsz) {
        int kk = (int)(i % (2 * SEQ)), kt = (int)(i / (2 * SEQ)); int part = kk / SEQ, t = kk % SEQ; int m = (kt * t) % SEQ;
        float a = TWO_PI * (float)m / (float)SEQ; p.tabT[i] = f2bf(part ? sinf(a) : cosf(a));
    }
    for (size_t i = gtid; i < (size_t)DEPTH * 2 * 16 * 64; i += gsz) {
        size_t ldg = i / 64;
        float dt = expf(p.s5_log_dt[ldg]); float are = p.s5_a_re[i], aim = p.s5_a_im[i];
        float mag = expf(are * dt); float abr = mag * cosf(aim * dt), abi = mag * sinf(aim * dt);
        float den = are * are + aim * aim; float nr = abr - 1.0f;
        float cre = (nr * are + abi * aim) / den, cim = (abi * are - nr * aim) / den;
        p.abar[2 * i] = abr; p.abar[2 * i + 1] = abi;
        float pr = abr, pi = abi;
        for (int s = 0; s < 6; ++s) { float t0 = pr * pr - pi * pi, t1 = 2.f * pr * pi; pr = t0; pi = t1; }
        p.abar64[2 * i] = pr; p.abar64[2 * i + 1] = pi;
        for (int pp = 0; pp < 16; ++pp) {
            float bre = p.s5_b_re[i * 16 + pp], bim = p.s5_b_im[i * 16 + pp];
            p.bbar[i * 32 + pp] = cre * bre - cim * bim;
            p.bbar[i * 32 + 16 + pp] = cre * bim + cim * bre;
        }
    }
}


constexpr int PT_KT = D / 64;
constexpr int PT_WIN = DEPTH * (NPAD / 64) * PT_KT;
constexpr int PT_WOUT = DEPTH * (D / 64) * (DMIX / 64);
constexpr int PT_SQ = DEPTH * 2 * 16;
constexpr int PT_ADA = DEPTH * (3 * D / 64);
constexpr int PT_TOTAL = PT_WIN + PT_WOUT + PT_SQ + PT_ADA;
constexpr int PREP_LDS = 64 * 65 * 4 + NCOND * D * 4;
__device__ __forceinline__ void prep_tiled_body(const Params& p, const Ctx& c) {
    float* T = (float*)c.smem;
    float* sc = T + 64 * 65;
    const int tid = c.tid;
    for (int i = tid; i < NCOND * D; i += 256) { const int cc = i / D, k = i % D; sc[i] = silu_f(cc == 0 ? p.c_ctx[k] : p.c[(size_t)(cc - 1) * D + k]); }
    for (int _k = 0, _n = loop_iters(PT_TOTAL, c); _k < _n; ++_k) {
        int item = c.vb + _k * c.nvb; const bool ghost = item >= PT_TOTAL; if (ghost) item = PT_TOTAL - 1;
        int type, l, kt = 0, nt = 0;
        const float* src_ = nullptr; int lds_ = 0, k0 = 0, ncol0 = 0, nvalid = 64; bf16* dst = nullptr; int ldk = 0;
        if (item < PT_WIN) { type = 0; l = item / ((NPAD / 64) * PT_KT); const int r = item % ((NPAD / 64) * PT_KT); nt = r / PT_KT; kt = r % PT_KT;
            const int n0 = nt * 64; const int oc = n0 < 1536 ? n0 : (n0 < NPROJ ? n0 + 16 : 1536); nvalid = n0 < NPROJ ? 64 : (n0 == NPROJ ? 16 : 0);
            src_ = p.w_in + (size_t)l * D * D_IN_PROJ; lds_ = D_IN_PROJ; k0 = kt * 64; ncol0 = oc; dst = p.winT + ((size_t)l * NPAD + n0) * D; ldk = D; }
        else if (item < PT_WIN + PT_WOUT) { type = 0; const int it = item - PT_WIN; l = it / ((D / 64) * (DMIX / 64)); const int r = it % ((D / 64) * (DMIX / 64)); nt = r / (DMIX / 64); kt = r % (DMIX / 64);
            src_ = p.w_out + (size_t)l * DMIX * D; lds_ = D; k0 = kt * 64; ncol0 = nt * 64; dst = p.woutT + ((size_t)l * D + nt * 64) * DMIX; ldk = DMIX; }
        else if (item < PT_WIN + PT_WOUT + PT_SQ) { type = 0; const int it = item - PT_WIN - PT_WOUT; l = it / 32; const int which = (it >> 4) & 1, r = it & 15; nt = r >> 2; kt = r & 3;
            src_ = (which ? p.s5_glu_w : p.ft_w) + (size_t)l * 65536; lds_ = 256; k0 = kt * 64; ncol0 = nt * 64; dst = (which ? p.gluT : p.ftwT) + (size_t)l * 65536 + (size_t)nt * 64 * 256; ldk = 256; }
        else { type = 1; const int it = item - PT_WIN - PT_WOUT - PT_SQ; l = it / (3 * D / 64); nt = it % (3 * D / 64); }
        BLOCK_SYNC();
        if (type == 0) {
            const int cq = (tid & 15) * 4;
#pragma unroll
            for (int i = 0; i < 4; ++i) {
                const int kk = (tid >> 4) + 16 * i;
                f32x4 v = (f32x4){0.f, 0.f, 0.f, 0.f};
                if (cq < nvalid) v = *(const f32x4*)(src_ + (size_t)(k0 + kk) * lds_ + ncol0 + cq);
                T[kk * 65 + cq] = v.x; T[kk * 65 + cq + 1] = v.y; T[kk * 65 + cq + 2] = v.z; T[kk * 65 + cq + 3] = v.w;
            }
        } else {
            const int col = tid & 63, kg = tid >> 6; const int j = nt * 64 + col;
            float a0 = 0.f, a1 = 0.f, a2 = 0.f;
            const float* w = p.w_ada + ((size_t)l * D + kg * (D / 4)) * 3 * D + j;
            for (int k = 0; k < D / 4; ++k) { const float wv = w[(size_t)k * 3 * D]; const int kk = kg * (D / 4) + k; a0 += sc[kk] * wv; a1 += sc[D + kk] * wv; if (NCOND > 2) a2 += sc[2 * D + kk] * wv; }
            T[(kg * 3 + 0) * 65 + col] = a0; T[(kg * 3 + 1) * 65 + col] = a1; T[(kg * 3 + 2) * 65 + col] = a2;
        }
        BLOCK_SYNC();
        if (!ghost) {
            if (type == 0) {
                const int n = tid >> 2, kc = (tid & 3) * 16;
                u32x4 w0, w1;
                w0.x = pk2(T[(kc + 0) * 65 + n], T[(kc + 1) * 65 + n]); w0.y = pk2(T[(kc + 2) * 65 + n], T[(kc + 3) * 65 + n]);
                w0.z = pk2(T[(kc + 4) * 65 + n], T[(kc + 5) * 65 + n]); w0.w = pk2(T[(kc + 6) * 65 + n], T[(kc + 7) * 65 + n]);
                w1.x = pk2(T[(kc + 8) * 65 + n], T[(kc + 9) * 65 + n]); w1.y = pk2(T[(kc + 10) * 65 + n], T[(kc + 11) * 65 + n]);
                w1.z = pk2(T[(kc + 12) * 65 + n], T[(kc + 13) * 65 + n]); w1.w = pk2(T[(kc + 14) * 65 + n], T[(kc + 15) * 65 + n]);
                bf16* d = dst + (size_t)n * ldk + k0 + kc;
                *(u32x4*)d = w0; *(u32x4*)(d + 8) = w1;
            } else if (tid < 64 * NCOND) {
                const int col = tid & 63, cc = tid >> 6; const int j = nt * 64 + col;
                const float v = T[(0 * 3 + cc) * 65 + col] + T[(1 * 3 + cc) * 65 + col] + T[(2 * 3 + cc) * 65 + col] + T[(3 * 3 + cc) * 65 + col];
                p.ada[((size_t)l * NCOND + cc) * 3 * D + j] = v + p.b_ada[(size_t)l * 3 * D + j];
            }
        }
    }
}

__device__ __forceinline__ void norm_mod_body(const Params& p, int l, const Ctx& c) {
    const int lane = c.lane, wave = c.wave;
    for (int tok0 = c.vb * 4; tok0 < NTOK; tok0 += c.nvb * 4) {
        const int tok = tok0 + wave;
        const float* xr = xrow_in(p, l, tok);
        float v[D / 64]; float ss = 0.f;
#pragma unroll
        for (int j = 0; j < D / 64; ++j) { v[j] = xr[j * 64 + lane]; ss += v[j] * v[j]; }
#pragma unroll
        for (int o = 1; o < 64; o <<= 1) ss += __shfl_xor(ss, o);
        const float rs = 1.0f / sqrtf(ss / (float)D + EPS);
        const float* ad = p.ada + ((size_t)l * NCOND + cond_of(tok)) * 3 * D;
        const float* ng = p.norm_g + (size_t)l * D;
#pragma unroll
        for (int j = 0; j < D / 64; ++j) { int i = j * 64 + lane; float h = v[j] * rs * ng[i] * (1.0f + ad[D + i]) + ad[i]; p.hbuf[(size_t)tok * D + i] = f2bf(h); }
    }
}

constexpr int GLD = 72;
template <int TOK> constexpr int gemm_lds() { return 2 * (128 + TOK) * GLD * 2; }
constexpr int GEMM_LDS = gemm_lds<128>();
constexpr int OUT_TOK = (NTOK % 96 == 0) ? 96 : 128;
static_assert(GEMM_LDS <= HALF_LDS, "GEMM LDS");
template <int TOK, class Epi>
__device__ __forceinline__ void gemm_body(const bf16* X, int ldx, const bf16* W, int ldw, int M, int N, int K, const Epi& epi, const Ctx& c) {
    constexpr int NT = TOK / 32;
    constexpr int XCH = TOK * 8 / 256;
    bf16* Ws[2]; bf16* Xs[2];
    Ws[0] = (bf16*)c.smem; Xs[0] = Ws[0] + 128 * GLD; Ws[1] = Xs[0] + TOK * GLD; Xs[1] = Ws[1] + 128 * GLD;
    const int tid = c.tid, lane = c.lane, wave = c.wave, wr = wave >> 1, wc = wave & 1;
    const int nM = M / TOK, nN = N / 128, ntiles = nM * nN;
    for (int _k = 0, _n = loop_iters(ntiles, c); _k < _n; ++_k) {
        int tile = c.vb + _k * c.nvb; const bool ghost = tile >= ntiles; if (ghost) tile = ntiles - 1;
        const int tm = tile / nN, tn = tile % nN;
        const bf16* Xg = X + (size_t)tm * TOK * ldx; const bf16* Wg = W + (size_t)tn * 128 * ldw;
        f32x4 acc[4][NT]; zero_acc(acc);
        u32x4 rw[4], rx[XCH];
        const int r0 = tid >> 3, ck = tid & 7;
#pragma unroll
        for (int i = 0; i < 4; ++i) rw[i] = *(const u32x4*)(Wg + (size_t)(r0 + 32 * i) * ldw + ck * 8);
#pragma unroll
        for (int i = 0; i < XCH; ++i) rx[i] = *(const u32x4*)(Xg + (size_t)(r0 + 32 * i) * ldx + ck * 8);
        BLOCK_SYNC();
#pragma unroll
        for (int i = 0; i < 4; ++i) *(u32x4*)(Ws[0] + (r0 + 32 * i) * GLD + ck * 8) = rw[i];
#pragma unroll
        for (int i = 0; i < XCH; ++i) *(u32x4*)(Xs[0] + (r0 + 32 * i) * GLD + ck * 8) = rx[i];
        BLOCK_SYNC();
        int cur = 0;
        for (int k0 = 0; k0 < K; k0 += 64) {
            const bool more = k0 + 64 < K;
            if (more) {
#pragma unroll
                for (int i = 0; i < 4; ++i) rw[i] = *(const u32x4*)(Wg + (size_t)(r0 + 32 * i) * ldw + k0 + 64 + ck * 8);
#pragma unroll
                for (int i = 0; i < XCH; ++i) rx[i] = *(const u32x4*)(Xg + (size_t)(r0 + 32 * i) * ldx + k0 + 64 + ck * 8);
            }
            mma_tiles<4, NT>(acc, Ws[cur] + wr * 64 * GLD, GLD, Xs[cur] + wc * (TOK / 2) * GLD, GLD, 64, lane);
            if (more) {
#pragma unroll
                for (int i = 0; i < 4; ++i) *(u32x4*)(Ws[cur ^ 1] + (r0 + 32 * i) * GLD + ck * 8) = rw[i];
#pragma unroll
                for (int i = 0; i < XCH; ++i) *(u32x4*)(Xs[cur ^ 1] + (r0 + 32 * i) * GLD + ck * 8) = rx[i];
            }
            BLOCK_SYNC();
            cur ^= 1;
        }
        if (!ghost) {
#pragma unroll
            for (int mt = 0; mt < 4; ++mt)
#pragma unroll
                for (int nt = 0; nt < NT; ++nt) {
                    const int col0 = tn * 128 + wr * 64 + mt * 16 + (lane >> 4) * 4, row = tm * TOK + wc * (TOK / 2) + nt * 16 + (lane & 15);
                    epi(row, col0, acc[mt][nt]);
                }
        }
    }
}
__device__ __forceinline__ u32x2 pack4(const f32x4 v) { u32x2 w; w.x = pk2(v[0], v[1]); w.y = pk2(v[2], v[3]); return w; }
__device__ __forceinline__ f32x4 unpack4(const u32x2 w) { return (f32x4){bf2f((bf16)(w.x & 0xffff)), bf2f((bf16)(w.x >> 16)), bf2f((bf16)(w.y & 0xffff)), bf2f((bf16)(w.y >> 16))}; }
struct EpiProj {
    bf16* proj; float* gates;
    __device__ __forceinline__ void operator()(int row, int col0, const f32x4 v) const {
        if (col0 < NPROJ) *(u32x2*)(proj + (size_t)row * NPROJ + col0) = pack4(v);
        else if (col0 < NPROJ + 16) *(f32x4*)(gates + (size_t)row * 16 + (col0 - NPROJ)) = v;
    }
};
struct EpiOut {
    const Params* p; int l;
    __device__ __forceinline__ void operator()(int row, int col0, const f32x4 v) const {
        const f32x4 g = *(const f32x4*)(p->ada + ((size_t)l * NCOND + cond_of(row)) * 3 * D + 2 * D + col0);
        const f32x4 xi = *(const f32x4*)(xrow_in(*p, l, row) + col0);
        *(f32x4*)(p->out + (size_t)row * D + col0) = xi + g * v;
    }
};
struct EpiGlu {
    const Params* p; int l;
    __device__ __forceinline__ void operator()(int row, int col0, const f32x4 v) const {
        const f32x4 y = unpack4(*(const u32x2*)(p->ybuf + (size_t)row * 256 + col0));
        const f32x4 z = unpack4(*(const u32x2*)(p->proj + (size_t)row * NPROJ + SZ + col0));
        const f32x4 bb = *(const f32x4*)(p->s5_glu_b + l * 256 + col0);
        f32x4 o;
#pragma unroll
        for (int i = 0; i < 4; ++i) o[i] = y[i] * sigmoid_f(v[i] + bb[i]) * silu_f(z[i]);
        *(u32x2*)(p->mix + (size_t)row * DMIX + 512 + col0) = pack4(o);
    }
};
struct EpiFt {
    const Params* p;
    __device__ __forceinline__ void operator()(int row, int col0, const f32x4 v) const {
        const f32x4 z = unpack4(*(const u32x2*)(p->proj + (size_t)row * NPROJ + FZ + col0));
        f32x4 o;
#pragma unroll
        for (int i = 0; i < 4; ++i) o[i] = v[i] * silu_f(z[i]);
        *(u32x2*)(p->mix + (size_t)row * DMIX + 768 + col0) = pack4(o);
    }
};

constexpr int POOL_LDS = 64 * 72 * 2 + 64 * 66 * 4;
template <int W>
__device__ __forceinline__ void pool_item(const Params& p, int l, int ch, int g, bf16* Ps, float* Vs, int tid, int lane, int wave) {
    constexpr int HW = W / 2;
    const bool lat = ch >= NCH_CTX;
    const int c2 = tid & 31, jg = tid >> 5;
    const int cofs = PU + g * 64 + 2 * c2;
    BLOCK_SYNC();
    if (!lat) {
        const int seq = ch / CPS_CTX, ci = ch % CPS_CTX; const size_t tok_seq = (size_t)seq * SEQ;
#pragma unroll
        for (int jj = 0; jj < 8; ++jj) {
            const int j = jg * 8 + jj, t = ci * 64 + j;
            int lo = t - HW; if (lo < 0) lo = 0; int hi = t - HW + W; if (hi > SEQ) hi = SEQ;
            float s0 = 0.f, s1 = 0.f;
#pragma unroll
            for (int k = 0; k < W; ++k) {
                int tt = t - HW + k; const bool ok = tt >= 0 && tt < SEQ; tt = tt < 0 ? 0 : (tt >= SEQ ? SEQ - 1 : tt);
                const unsigned u = *(const unsigned*)(p.proj + (tok_seq + tt) * NPROJ + cofs);
                s0 += ok ? bf2f((bf16)(u & 0xffff)) : 0.f; s1 += ok ? bf2f((bf16)(u >> 16)) : 0.f;
            }
            const unsigned uc = *(const unsigned*)(p.proj + (tok_seq + t) * NPROJ + cofs);
            const float inv = 1.0f / (float)(hi - lo);
            *(unsigned*)(Ps + j * 72 + 2 * c2) = pk2(s0 * inv - bf2f((bf16)(uc & 0xffff)), s1 * inv - bf2f((bf16)(uc >> 16)));
        }
        BLOCK_SYNC(); BLOCK_SYNC();
    } else {
        const int b = (ch - NCH_CTX) / 64, r = (ch - NCH_CTX) % 64; const size_t tok_b = (size_t)NCTX + (size_t)b * DEC_SEQ;
        int lor = r - HW; if (lor < 0) lor = 0; int hir = r - HW + W; if (hir > 64) hir = 64;
        const float invr = 1.0f / (float)(hir - lor);
#pragma unroll
        for (int jj = 0; jj < 8; ++jj) {
            const int col = jg * 8 + jj; float s0 = 0.f, s1 = 0.f;
#pragma unroll
            for (int k = 0; k < W; ++k) {
                int rr = r - HW + k; const bool ok = rr >= 0 && rr < 64; rr = rr < 0 ? 0 : (rr > 63 ? 63 : rr);
                const unsigned u = *(const unsigned*)(p.proj + (tok_b + rr * 64 + col) * NPROJ + cofs);
                s0 += ok ? bf2f((bf16)(u & 0xffff)) : 0.f; s1 += ok ? bf2f((bf16)(u >> 16)) : 0.f;
            }
            Vs[col * 66 + 2 * c2] = s0 * invr; Vs[col * 66 + 2 * c2 + 1] = s1 * invr;
        }
        BLOCK_SYNC();
#pragma unroll
        for (int jj = 0; jj < 8; ++jj) {
            const int col = jg * 8 + jj;
            int lo = col - HW; if (lo < 0) lo = 0; int hi = col - HW + W; if (hi > 64) hi = 64;
            float s0 = 0.f, s1 = 0.f;
            for (int cc = lo; cc < hi; ++cc) { s0 += Vs[cc * 66 + 2 * c2]; s1 += Vs[cc * 66 + 2 * c2 + 1]; }
            const unsigned uc = *(const unsigned*)(p.proj + (tok_b + r * 64 + col) * NPROJ + cofs);
            const float inv = 1.0f / (float)(hi - lo);
            *(unsigned*)(Ps + col * 72 + 2 * c2) = pk2(s0 * inv - bf2f((bf16)(uc & 0xffff)), s1 * inv - bf2f((bf16)(uc >> 16)));
        }
        BLOCK_SYNC();
    }
    {
        f32x4 acc[4][1]; zero_acc(acc);
        mma_tiles<4, 1>(acc, p.poolwT + ((size_t)l * 4 + g) * 4096, 64, Ps + wave * 16 * 72, 72, 64, lane);
        const size_t tok = (size_t)ch * 64 + wave * 16 + (lane & 15);
#pragma unroll
        for (int mt = 0; mt < 4; ++mt) {
            const int d0 = g * 64 + mt * 16 + (lane >> 4) * 4;
            const f32x4 sc = *(const f32x4*)(p.pool_scale + l * 256 + d0);
            const f32x4 z = unpack4(*(const u32x2*)(p.proj + tok * NPROJ + PZ + d0));
            f32x4 o;
#pragma unroll
            for (int i = 0; i < 4; ++i) o[i] = acc[mt][0][i] * sc[i] * silu_f(z[i]);
            *(u32x2*)(p.mix + tok * DMIX + d0) = pack4(o);
        }
    }
}
__device__ __forceinline__ void pool_body(const Params& p, int l, const Ctx& c) {
    bf16* Ps = (bf16*)c.smem;
    float* Vs = (float*)(c.smem + 64 * 72 * 2);
    const int wave = c.wave;
    for (int _k = 0, _n = loop_iters(NCH * 4, c); _k < _n; ++_k) {
        int item = c.vb + _k * c.nvb; if (item >= NCH * 4) item = NCH * 4 - 1;
        int tid = c.tid; LAUNDER_V(tid); const int lane = tid & 63;
        const int ch = item >> 2, g = item & 3;
        switch (g) {
        case 0: pool_item<2>(p, l, ch, g, Ps, Vs, tid, lane, wave); break;
        case 1: pool_item<4>(p, l, ch, g, Ps, Vs, tid, lane, wave); break;
        case 2: pool_item<8>(p, l, ch, g, Ps, Vs, tid, lane, wave); break;
        default: pool_item<16>(p, l, ch, g, Ps, Vs, tid, lane, wave); break;
        }
    }
}

constexpr int FTC_ULD = 72, FTC_GLD = SEQ + 8;
constexpr int FTC_LDS = SEQ * FTC_ULD * 2 + 64 * FTC_GLD * 2;
__device__ __forceinline__ void ft_ctx_body(const Params& p, const Ctx& c) {
    bf16* Us = (bf16*)c.smem;
    bf16* GT = Us + SEQ * FTC_ULD;
    const int tid = c.tid, lane = c.lane, wave = c.wave;
    constexpr int MTW = SEQ / 64;
    constexpr int KQ = SEQ / 64;
    for (int _k = 0, _n = loop_iters(BATCH * 4 * KQ, c); _k < _n; ++_k) {
        int item = c.vb + _k * c.nvb; if (item >= (BATCH * 4 * KQ)) item = (BATCH * 4 * KQ) - 1;
        const int kq = item % KQ, bh = item / KQ, b = bh >> 2, h = bh & 3;
        BLOCK_SYNC();
        for (int i = tid; i < SEQ * 8; i += 256) { const int t = i >> 3, ck = i & 7; *(u32x4*)(Us + t * FTC_ULD + ck * 8) = *(const u32x4*)(p.proj + ((size_t)b * SEQ + t) * NPROJ + FU + h * 64 + ck * 8); }
        BLOCK_SYNC();
        f32x4 facc[4][1]; zero_acc(facc);
        const int kt0 = kq * 64 + wave * 16;
        for (int part = 0; part < 2; ++part) {
#pragma unroll 1
            for (int nh = 0; nh < 2; ++nh) {
                f32x4 g[MTW][2]; zero_acc(g);
                mma_tiles<MTW, 2>(g, Us + wave * (SEQ / 4) * FTC_ULD, FTC_ULD, p.tabDc + (part * 64 + nh * 32) * 64, 64, 64, lane);
#pragma unroll
                for (int mt = 0; mt < MTW; ++mt)
#pragma unroll
                    for (int nt = 0; nt < 2; ++nt) {
                        const int kc = nh * 32 + nt * 16 + (lane & 15), t0 = wave * (SEQ / 4) + mt * 16 + (lane >> 4) * 4;
                        *(u32x2*)(GT + kc * FTC_GLD + t0) = pack4(g[mt][nt]);
                    }
            }
            BLOCK_SYNC();
            mma_tiles<4, 1>(facc, GT, FTC_GLD, p.tabT + (size_t)kt0 * 2 * SEQ + part * SEQ, 2 * SEQ, SEQ, lane);
            BLOCK_SYNC();
        }
        const float sc = 1.0f / sqrtf((float)SEQ * 64.f);
#pragma unroll
        for (int mt = 0; mt < 4; ++mt) {
            const int kt = kt0 + (lane & 15), kc0 = mt * 16 + (lane >> 4) * 4;
            *(u32x2*)(p.fbuf + ((size_t)b * SEQ + kt) * 256 + h * 64 + kc0) = pack4(facc[mt][0] * sc);
        }
    }
}

constexpr int FTA_XS = 0, FTA_Z1T = 64 * 72 * 2, FTA_R = FTA_Z1T + 64 * 136 * 2, FTA_E = FTA_R + 128 * 72 * 2;
constexpr int FTA_LDS = FTA_E + 128 * 136 * 2;
static_assert(FTA_LDS <= HALF_LDS, "ft_latA LDS");
__device__ __forceinline__ void ft_latA_body(const Params& p, const Ctx& c) {
    bf16* Xs = (bf16*)(c.smem + FTA_XS);
    bf16* Z1T = (bf16*)(c.smem + FTA_Z1T);
    bf16* R = (bf16*)(c.smem + FTA_R);
    bf16* Es = (bf16*)(c.smem + FTA_E);
    const int tid = c.tid, lane = c.lane, wave = c.wave;
    for (int _k = 0, _n = loop_iters(DEC_BATCH * 64, c); _k < _n; ++_k) {
        int item = c.vb + _k * c.nvb; if (item >= (DEC_BATCH * 64)) item = (DEC_BATCH * 64) - 1;
        const int b = item >> 6, t2 = item & 63;
        BLOCK_SYNC();
        for (int i = tid; i < 128 * 16; i += 256) { const int r = i >> 4, ck = i & 15; *(u32x4*)(Es + r * 136 + ck * 8) = *(const u32x4*)(p.tabE + r * 128 + ck * 8); }
        for (int h = 0; h < 4; ++h) {
            BLOCK_SYNC();
            for (int i = tid; i < 64 * 8; i += 256) { const int t1 = i >> 3, ck = i & 7; *(u32x4*)(Xs + t1 * 72 + ck * 8) = *(const u32x4*)(p.proj + ((size_t)NCTX + (size_t)b * DEC_SEQ + t1 * 64 + t2) * NPROJ + FU + h * 64 + ck * 8); }
            for (int i = tid; i < 128 * 8; i += 256) { const int r = i >> 3, ck = i & 7; *(u32x4*)(R + r * 72 + ck * 8) = *(const u32x4*)(p.tabDc + r * 64 + ck * 8); }
            BLOCK_SYNC();
            {
                f32x4 a[4][2]; zero_acc(a);
                mma_tiles<4, 2>(a, Xs, 72, R + wave * 32 * 72, 72, 64, lane);
#pragma unroll
                for (int mt = 0; mt < 4; ++mt)
#pragma unroll
                    for (int nt = 0; nt < 2; ++nt) {
                        const int n = wave * 32 + nt * 16 + (lane & 15), part = n >> 6, kc = n & 63, t10 = mt * 16 + (lane >> 4) * 4;
                        *(u32x2*)(Z1T + kc * 136 + part * 64 + t10) = pack4(a[mt][nt]);
                    }
            }
            BLOCK_SYNC();
            {
                f32x4 z[1][8]; zero_acc(z);
                mma_tiles<1, 8>(z, Z1T + wave * 16 * 136, 136, Es, 136, 128, lane);
#pragma unroll
                for (int nt = 0; nt < 4; ++nt) {
                    const int k1 = nt * 16 + (lane & 15); const int m = (t2 * k1) & 4095;
                    const float ang = 6.283185307179586f * (float)m / 4096.f; const float tc = cosf(ang), ts = sinf(ang);
                    const int kc0 = wave * 16 + (lane >> 4) * 4;
                    f32x4 re, im;
#pragma unroll
                    for (int r = 0; r < 4; ++r) { const float a = z[0][nt][r], bb = z[0][nt + 4][r]; re[r] = a * tc + bb * ts; im[r] = bb * tc - a * ts; }
                    *(u32x2*)(R + k1 * 72 + kc0) = pack4(re); *(u32x2*)(R + (64 + k1) * 72 + kc0) = pack4(im);
                }
            }
            BLOCK_SYNC();
#pragma unroll
            for (int it = 0; it < 4; ++it) {
                const int i = tid + 256 * it, row = i >> 3, ck = i & 7, part = row >> 6, k1 = row & 63;
                *(u32x4*)(p.Zg + ((((size_t)b * 64 + k1) * 128 + part * 64 + t2) * 256) + h * 64 + ck * 8) = *(const u32x4*)(R + row * 72 + ck * 8);
            }
        }
    }
}

constexpr int FTB_LDS = 256 * 136 * 2;
__device__ __forceinline__ void ft_latB_body(const Params& p, const Ctx& c) {
    bf16* Zs = (bf16*)c.smem;
    const int lane = c.lane, wave = c.wave;
    for (int _k = 0, _n = loop_iters(DEC_BATCH * 64, c); _k < _n; ++_k) {
        int item = c.vb + _k * c.nvb; if (item >= (DEC_BATCH * 64)) item = (DEC_BATCH * 64) - 1;
        const int b = item >> 6, k1 = item & 63;
        const bf16* zg = p.Zg + ((size_t)b * 64 + k1) * 128 * 256;
        BLOCK_SYNC();
        {
            const int k = (wave & 1) * 64 + lane;
#pragma unroll 4
            for (int it = 0; it < 16; ++it) {
                const int n8 = (wave >> 1) * 16 + it;
                const u32x4 v = *(const u32x4*)(zg + (size_t)k * 256 + n8 * 8);
                bf16* dst = Zs + (n8 * 8) * 136 + k;
                dst[0 * 136] = (bf16)(v.x & 0xffff); dst[1 * 136] = (bf16)(v.x >> 16); dst[2 * 136] = (bf16)(v.y & 0xffff); dst[3 * 136] = (bf16)(v.y >> 16);
                dst[4 * 136] = (bf16)(v.z & 0xffff); dst[5 * 136] = (bf16)(v.z >> 16); dst[6 * 136] = (bf16)(v.w & 0xffff); dst[7 * 136] = (bf16)(v.w >> 16);
            }
        }
        BLOCK_SYNC();
        f32x4 acc[4][4]; zero_acc(acc);
        mma_tiles<4, 4>(acc, Zs + wave * 64 * 136, 136, p.tabE, 128, 128, lane);
#pragma unroll
        for (int mt = 0; mt < 4; ++mt)
#pragma unroll
            for (int nt = 0; nt < 4; ++nt) {
                const int k2 = nt * 16 + (lane & 15), n0 = wave * 64 + mt * 16 + (lane >> 4) * 4;
                *(u32x2*)(p.fbuf + ((size_t)NCTX + (size_t)b * DEC_SEQ + k1 + 64 * k2) * 256 + n0) = pack4(acc[mt][nt] * (1.0f / 512.f));
            }
    }
}

constexpr int S5P1_LDS = 4 * 64 * 16 * 4;
__device__ __forceinline__ void s5_pass1_body(const Params& p, int l, const Ctx& c) {
    const int lane = c.lane, wave = c.wave;
    float* uS = (float*)c.smem + wave * 1024;
    for (int it0 = c.vb * 4; it0 < NCH * 32; it0 += c.nvb * 4) {
        const int item = it0 + wave; const int d = item & 1, g = (item >> 1) & 15, ch = item >> 5;
        WAVE_SYNC();
        for (int i = lane; i < 1024; i += 64) { const int t = i >> 4, pp = i & 15; uS[i] = bf2f(p.proj[((size_t)ch * 64 + t) * NPROJ + SU + g * 16 + pp]); }
        WAVE_SYNC();
        const size_t pi = (((size_t)l * 2 + d) * 16 + g) * 64 + lane;
        const float ar = p.abar[2 * pi], ai = p.abar[2 * pi + 1];
        float bre[16], bim[16];
#pragma unroll
        for (int pp = 0; pp < 16; ++pp) { bre[pp] = p.bbar[pi * 32 + pp]; bim[pp] = p.bbar[pi * 32 + 16 + pp]; }
        float sr = 0.f, si = 0.f;
        for (int tau = 0; tau < 64; ++tau) {
            const int t = d ? 63 - tau : tau; float br = 0.f, bi = 0.f;
#pragma unroll
            for (int pp = 0; pp < 16; ++pp) { const float u = uS[t * 16 + pp]; br += bre[pp] * u; bi += bim[pp] * u; }
            const float nr = ar * sr - ai * si + br, ni = ar * si + ai * sr + bi; sr = nr; si = ni;
        }
        float* E = p.s5E + (((size_t)ch * 16 + g) * 2 + d) * 128;
        E[lane] = sr; E[64 + lane] = si;
    }
}
__device__ __forceinline__ void s5_carry_body(const Params& p, int l, const Ctx& c) {
    for (int i = c.vb * 256 + c.tid; i < NSEQ * 16 * 2 * 64; i += c.nvb * 256) {
        const int n = i & 63, d = (i >> 6) & 1, g = (i >> 7) & 15, seq = i >> 11;
        const bool lat = seq >= BATCH; const int cps = lat ? CPS_LAT : CPS_CTX; const int ch0 = lat ? NCH_CTX + (seq - BATCH) * CPS_LAT : seq * CPS_CTX;
        const size_t pi = (((size_t)l * 2 + d) * 16 + g) * 64 + n;
        const float ar = p.abar64[2 * pi], ai = p.abar64[2 * pi + 1];
        float sr = 0.f, si = 0.f;
        if (lat) { const size_t o = ((((size_t)(seq - BATCH) * DEPTH + l) * 2 + d) * 2) * 1024 + g * 64 + n; sr = p.state_s5[o]; si = p.state_s5[o + 1024]; }
        for (int q = 0; q < cps; ++q) {
            const int ch = ch0 + (d ? cps - 1 - q : q);
            const size_t e = (((size_t)ch * 16 + g) * 2 + d) * 128 + n;
            p.s5S[e] = sr; p.s5S[e + 64] = si;
            const float er = p.s5E[e], ei = p.s5E[e + 64];
            const float nr = ar * sr - ai * si + er, ni = ar * si + ai * sr + ei; sr = nr; si = ni;
        }
        if (!lat) { const size_t o = OUT_S5 + ((((size_t)seq * DEPTH + l) * 2 + d) * 2) * 1024 + g * 64 + n; p.out[o] = sr; p.out[o + 1024] = si; }
    }
}
constexpr int S5P3_LDS = 2 * 64 * 264 * 2 + 2 * 64 * 16 * 4;
__device__ __forceinline__ void s5_pass3_body(const Params& p, int l, const Ctx& c) {
    const int tid = c.tid, lane = c.lane, wave = c.wave, il = wave >> 1, d = wave & 1;
    bf16* Ss = (bf16*)c.smem + il * 64 * 264;
    float* uS = (float*)(c.smem + 2 * 64 * 264 * 2) + il * 1024;
    for (int _k = 0, _n = loop_iters(NCH * 8, c); _k < _n; ++_k) {
        int grp = c.vb + _k * c.nvb; if (grp >= (NCH * 8)) grp = (NCH * 8) - 1;
        const int item = grp * 2 + il; const int g = item & 15, ch = item >> 4;
        BLOCK_SYNC();
        for (int i = (tid & 127); i < 1024; i += 128) { const int t = i >> 4, pp = i & 15; uS[i] = bf2f(p.proj[((size_t)ch * 64 + t) * NPROJ + SU + g * 16 + pp]); }
        BLOCK_SYNC();
        const size_t pi = (((size_t)l * 2 + d) * 16 + g) * 64 + lane;
        const float ar = p.abar[2 * pi], ai = p.abar[2 * pi + 1];
        float bre[16], bim[16];
#pragma unroll
        for (int pp = 0; pp < 16; ++pp) { bre[pp] = p.bbar[pi * 32 + pp]; bim[pp] = p.bbar[pi * 32 + 16 + pp]; }
        const size_t e = (((size_t)ch * 16 + g) * 2 + d) * 128 + lane;
        float sr = p.s5S[e], si = p.s5S[e + 64];
        for (int tau = 0; tau < 64; ++tau) {
            const int t = d ? 63 - tau : tau; float br = 0.f, bi = 0.f;
#pragma unroll
            for (int pp = 0; pp < 16; ++pp) { const float u = uS[t * 16 + pp]; br += bre[pp] * u; bi += bim[pp] * u; }
            const float nr = ar * sr - ai * si + br, ni = ar * si + ai * sr + bi; sr = nr; si = ni;
            Ss[t * 264 + d * 128 + lane] = f2bf(sr); Ss[t * 264 + d * 128 + 64 + lane] = f2bf(si);
        }
        BLOCK_SYNC();
        f32x4 acc[2][1]; zero_acc(acc);
        mma_tiles<2, 1>(acc, Ss + d * 32 * 264, 264, p.Cmat + ((size_t)l * 16 + g) * 4096, 256, 256, lane);
#pragma unroll
        for (int mt = 0; mt < 2; ++mt)
#pragma unroll
            for (int r = 0; r < 4; ++r) {
                const int t = d * 32 + mt * 16 + (lane >> 4) * 4 + r, pp = lane & 15;
                const float y = acc[mt][0][r] + p.s5_d[l * 256 + g * 16 + pp] * uS[t * 16 + pp];
                p.ybuf[((size_t)ch * 64 + t) * 256 + g * 16 + pp] = f2bf(gelu_f(y));
            }
    }
}

constexpr int DN_STG = 0;
constexpr int DN_S1 = 0, DN_S2 = 18432;
constexpr int DN_AB = 36864;
constexpr int DN_QB = DN_AB + 9216, DN_KB = DN_QB + 9216, DN_VB = DN_KB + 9216;
constexpr int DN_SM = DN_VB + 8192;
constexpr int DN1_LDS = DN_SM + 5 * 64 * 4;
static_assert(DN1_LDS <= HALF_LDS, "DN1 LDS");
__device__ __forceinline__ void dn_d1_body(const Params& p, int l, const Ctx& c) {
    char* smem = c.smem;
    float* stq = (float*)(smem + DN_STG); float* stk = stq + 64 * 65;
    bf16* S1 = (bf16*)(smem + DN_S1); bf16* S2 = (bf16*)(smem + DN_S2);
    bf16* Ab = (bf16*)(smem + DN_AB); float* Rb = (float*)(smem + DN_VB);
    bf16* Qb = (bf16*)(smem + DN_QB); bf16* Kb = (bf16*)(smem + DN_KB); bf16* Vb = (bf16*)(smem + DN_VB);
    float* rq = (float*)(smem + DN_SM); float* rk = rq + 64; float* gs = rk + 64; float* bs = gs + 64; float* gcs = bs + 64;
    const int wave = c.wave;
    for (int _k = 0, _n = loop_iters(NCH * 8, c); _k < _n; ++_k) {
        int item = c.vb + _k * c.nvb; if (item >= (NCH * 8)) item = (NCH * 8) - 1;
        int tid = c.tid; LAUNDER_V(tid); const int lane = tid & 63;
        const int d = item & 1, h = (item >> 1) & 3, ch = item >> 3;
        const bool lat = ch >= NCH_CTX;
        const int cps = lat ? CPS_LAT : CPS_CTX; const int ci = lat ? (ch - NCH_CTX) % CPS_LAT : ch % CPS_CTX;
        const int lseq = cps * 64; const size_t tok_seq = (size_t)(ch - ci) * 64;
        BLOCK_SYNC();
        {
            const int jt = tid >> 2, cq = tid & 3, tau = d ? 63 - jt : jt;
            const int pos0 = ci * 64 + jt - 2;
#pragma unroll
            for (int arr = 0; arr < 3; ++arr) {
                float ss = 0.f; float o[16];
#pragma unroll
                for (int hf = 0; hf < 2; ++hf) {
                    const int chn = arr * 256 + h * 64 + cq * 16 + hf * 8;
                    float acc8[8];
#pragma unroll
                    for (int e = 0; e < 8; ++e) acc8[e] = 0.f;
#pragma unroll
                    for (int j = 0; j < 5; ++j) {
                        const int pos = pos0 + j; const bool ok = pos >= 0 && pos < lseq; const int pc = pos < 0 ? 0 : (pos >= lseq ? lseq - 1 : pos);
                        const u32x4 xv = *(const u32x4*)(p.proj + (tok_seq + pc) * NPROJ + QKV + chn);
                        const f32x4 w0 = *(const f32x4*)(p.dn_conv + ((size_t)l * 5 + j) * 768 + chn), w1 = *(const f32x4*)(p.dn_conv + ((size_t)l * 5 + j) * 768 + chn + 4);
                        const float m = ok ? 1.f : 0.f;
                        acc8[0] += m * w0[0] * bf2f((bf16)(xv.x & 0xffff)); acc8[1] += m * w0[1] * bf2f((bf16)(xv.x >> 16));
                        acc8[2] += m * w0[2] * bf2f((bf16)(xv.y & 0xffff)); acc8[3] += m * w0[3] * bf2f((bf16)(xv.y >> 16));
                        acc8[4] += m * w1[0] * bf2f((bf16)(xv.z & 0xffff)); acc8[5] += m * w1[1] * bf2f((bf16)(xv.z >> 16));
                        acc8[6] += m * w1[2] * bf2f((bf16)(xv.w & 0xffff)); acc8[7] += m * w1[3] * bf2f((bf16)(xv.w >> 16));
                    }
#pragma unroll
                    for (int e = 0; e < 8; ++e) { const float s = silu_f(acc8[e]); o[hf * 8 + e] = s; ss += s * s; }
                }
                float sc = 1.f;
                if (arr < 2) { ss += __shfl_xor(ss, 1); ss += __shfl_xor(ss, 2); sc = 1.0f / sqrtf(ss + EPS); }
                bf16* dst = arr == 0 ? Qb + tau * 72 + cq * 16 : (arr == 1 ? Kb + tau * 72 + cq * 16 : Vb + tau * 64 + cq * 16);
                u32x4 w0, w1;
                w0.x = pk2(o[0] * sc, o[1] * sc); w0.y = pk2(o[2] * sc, o[3] * sc); w0.z = pk2(o[4] * sc, o[5] * sc); w0.w = pk2(o[6] * sc, o[7] * sc);
                w1.x = pk2(o[8] * sc, o[9] * sc); w1.y = pk2(o[10] * sc, o[11] * sc); w1.z = pk2(o[12] * sc, o[13] * sc); w1.w = pk2(o[14] * sc, o[15] * sc);
                *(u32x4*)dst = w0; *(u32x4*)(dst + 8) = w1;
            }
            if (wave == 0) {
                const int tg = lane; const size_t tok = (size_t)ch * 64 + (d ? 63 - tg : tg);
                const float braw = p.gates[tok * 16 + d * 4 + h], araw = p.gates[tok * 16 + 8 + d * 4 + h];
                bs[tg] = sigmoid_f(braw);
                float g = -expf(p.dn_a_log[(l * 2 + d) * 4 + h]) * softplus_f(araw + p.dn_dt_bias[(l * 2 + d) * 4 + h]);
#pragma unroll
                for (int o2 = 1; o2 < 64; o2 <<= 1) { const float up = __shfl(g, lane >= o2 ? lane - o2 : lane); g += lane >= o2 ? up : 0.f; }
                gcs[tg] = g;
            }
        }
        BLOCK_SYNC();
        const float gl = gcs[63];
        {
            f32x4 kk[1][4], qk[1][4]; zero_acc(kk); zero_acc(qk);
            mma_tiles<1, 4>(kk, Kb + wave * 16 * 72, 72, Kb, 72, 64, lane);
            mma_tiles<1, 4>(qk, Qb + wave * 16 * 72, 72, Kb, 72, 64, lane);
            BLOCK_SYNC();
#pragma unroll
            for (int nt = 0; nt < 4; ++nt)
#pragma unroll
                for (int r = 0; r < 4; ++r) {
                    const int tau = wave * 16 + (lane >> 4) * 4 + r, sg = nt * 16 + (lane & 15);
                    const float dec = sg <= tau ? expf(gcs[tau] - gcs[sg]) : 0.f;
                    Ab[tau * 72 + sg] = f2bf(sg < tau ? -kk[0][nt][r] * dec * bs[tau] : 0.f);
                    S1[(64 + tau) * 72 + sg] = f2bf(qk[0][nt][r] * 0.125f * dec);
                }
            for (int i = tid; i < 18432 / 16; i += 256) *(u32x4*)((char*)S2 + i * 16) = (u32x4){0u, 0u, 0u, 0u};
            const int tau = lane;
            const float kd = expf(gl - gcs[tau]);
            for (int dk = wave * 16; dk < wave * 16 + 16; ++dk) S1[dk * 72 + tau] = f2bf(bf2f(Kb[tau * 72 + dk]) * kd);
        }
        BLOCK_SYNC();
        {
            f32x4 rhs[4][2];
#pragma unroll
            for (int I = 0; I < 4; ++I)
#pragma unroll
                for (int nt = 0; nt < 2; ++nt)
#pragma unroll
                    for (int r = 0; r < 4; ++r) {
                        const int tau = I * 16 + (lane >> 4) * 4 + r, col = wave * 32 + nt * 16 + (lane & 15);
                        rhs[I][nt][r] = wave < 2 ? bf2f(Kb[tau * 72 + col]) * (bs[tau] * expf(gcs[tau])) : bf2f(Vb[tau * 64 + col - 64]) * bs[tau];
                    }
            BLOCK_SYNC();
#pragma unroll
            for (int I = 0; I < 4; ++I) {
                f32x4 acc[1][2]; acc[0][0] = rhs[I][0]; acc[0][1] = rhs[I][1];
                mma_tiles<1, 2>(acc, Ab + I * 16 * 72, 72, S2 + wave * 32 * 72, 72, 64, lane);
#pragma unroll
                for (int nt = 0; nt < 2; ++nt)
#pragma unroll
                    for (int r = 0; r < 4; ++r) Rb[((lane >> 4) * 4 + r) * 128 + wave * 32 + nt * 16 + (lane & 15)] = acc[0][nt][r];
                BLOCK_SYNC();
                if (tid < 128) {
                    const int col = tid; float x[16];
#pragma unroll
                    for (int r = 0; r < 16; ++r) x[r] = Rb[r * 128 + col];
#pragma unroll
                    for (int r = 1; r < 16; ++r) {
                        const bf16* ar = Ab + (I * 16 + r) * 72 + I * 16;
#pragma unroll
                        for (int k = 0; k < r; ++k) x[r] += bf2f(ar[k]) * x[k];
                    }
                    u32x4 w0, w1;
                    w0.x = pk2(x[0], x[1]); w0.y = pk2(x[2], x[3]); w0.z = pk2(x[4], x[5]); w0.w = pk2(x[6], x[7]);
                    w1.x = pk2(x[8], x[9]); w1.y = pk2(x[10], x[11]); w1.z = pk2(x[12], x[13]); w1.w = pk2(x[14], x[15]);
                    *(u32x4*)(S2 + col * 72 + I * 16) = w0; *(u32x4*)(S2 + col * 72 + I * 16 + 8) = w1;
                }
                BLOCK_SYNC();
            }
        }
        BLOCK_SYNC();
        {
            const size_t ib = (size_t)item * 4096;
            {
                f32x4 acc[1][8]; zero_acc(acc);
                mma_tiles<1, 8>(acc, S2 + wave * 16 * 72, 72, S1, 72, 64, lane);
                const int m0 = wave * 16 + (lane >> 4) * 4;
#pragma unroll
                for (int nt = 0; nt < 4; ++nt) { const int dk = nt * 16 + (lane & 15); *(u32x2*)(p.dnAp + ib + dk * 64 + m0) = pack4(-acc[0][nt]); }
#pragma unroll
                for (int nt = 4; nt < 8; ++nt) {
                    const int tau = (nt - 4) * 16 + (lane & 15); const float qs = 0.125f * expf(gcs[tau]);
                    const f32x4 qe = unpack4(*(const u32x2*)(Qb + tau * 72 + m0));
                    *(u32x2*)(p.dnQh + ib + tau * 64 + m0) = pack4(qe * qs - acc[0][nt]);
                }
            }
            {
                f32x4 acc[1][4]; zero_acc(acc);
                mma_tiles<1, 4>(acc, S1 + wave * 16 * 72, 72, S2 + 64 * 72, 72, 64, lane);
#pragma unroll
                for (int nt = 0; nt < 4; ++nt) { const int dv = nt * 16 + (lane & 15); *(u32x2*)(p.dnBT + ib + dv * 64 + wave * 16 + (lane >> 4) * 4) = pack4(acc[0][nt]); }
            }
            {
                f32x4 acc[1][4]; zero_acc(acc);
                mma_tiles<1, 4>(acc, S2 + (64 + wave * 16) * 72, 72, S1 + 64 * 72, 72, 64, lane);
#pragma unroll
                for (int nt = 0; nt < 4; ++nt) { const int tau = nt * 16 + (lane & 15); *(u32x2*)(p.dnOT + ib + tau * 64 + wave * 16 + (lane >> 4) * 4) = pack4(acc[0][nt]); }
            }
            if (tid == 0) p.dnEgl[item] = expf(gl);
        }
    }
}
constexpr int DN2_LDS = 64 * 72 * 2;
struct ScanOps {
#ifdef EMU
    const bf16 *ap, *qh;
#else
    bf16x8 ap[2], qh[2];
#endif
    u32x2 bt[2], ot[2]; float egl;
};
__device__ __forceinline__ void scan_load(ScanOps& o, const Params& p, int item, int wave, int hb, int lane) {
    const size_t ib = (size_t)item * 4096;
#ifdef EMU
    o.ap = p.dnAp + ib + wave * 16 * 64; o.qh = p.dnQh + ib + wave * 16 * 64;
#else
#pragma unroll
    for (int ks = 0; ks < 2; ++ks) {
        o.ap[ks] = *(const bf16x8*)(p.dnAp + ib + (wave * 16 + (lane & 15)) * 64 + ks * 32 + (lane >> 4) * 8);
        o.qh[ks] = *(const bf16x8*)(p.dnQh + ib + (wave * 16 + (lane & 15)) * 64 + ks * 32 + (lane >> 4) * 8);
    }
#endif
#pragma unroll
    for (int nt = 0; nt < 2; ++nt) {
        const int dv = hb * 32 + nt * 16 + (lane & 15), r0 = wave * 16 + (lane >> 4) * 4;
        o.bt[nt] = *(const u32x2*)(p.dnBT + ib + dv * 64 + r0);
        o.ot[nt] = *(const u32x2*)(p.dnOT + ib + (wave * 16 + (lane & 15)) * 64 + hb * 32 + nt * 16 + (lane >> 4) * 4);
    }
    o.egl = p.dnEgl[item];
}
__device__ __forceinline__ void scan_mma_s(f32x4 (&acc)[1][2], const ScanOps& o, const bf16* STh, int lane) {
#ifdef EMU
    mma_tiles<1, 2>(acc, o.ap, 64, STh, 72, 64, lane);
#else
#pragma unroll
    for (int ks = 0; ks < 2; ++ks)
#pragma unroll
        for (int nt = 0; nt < 2; ++nt) {
            const bf16x8 b = *(const bf16x8*)(STh + (nt * 16 + (lane & 15)) * 72 + ks * 32 + (lane >> 4) * 8);
            acc[0][nt] = __builtin_amdgcn_mfma_f32_16x16x32_bf16(o.ap[ks], b, acc[0][nt], 0, 0, 0);
        }
#endif
}
__device__ __forceinline__ void scan_mma_o(f32x4 (&acc)[2][1], const ScanOps& o, const bf16* STh, int lane) {
#ifdef EMU
    mma_tiles<2, 1>(acc, STh, 72, o.qh, 64, 64, lane);
#else
#pragma unroll
    for (int ks = 0; ks < 2; ++ks)
#pragma unroll
        for (int mt = 0; mt < 2; ++mt) {
            const bf16x8 a = *(const bf16x8*)(STh + (mt * 16 + (lane & 15)) * 72 + ks * 32 + (lane >> 4) * 8);
            acc[mt][0] = __builtin_amdgcn_mfma_f32_16x16x32_bf16(a, o.qh[ks], acc[mt][0], 0, 0, 0);
        }
#endif
}
__device__ __forceinline__ void dn_scan_body(const Params& p, int l, const Ctx& c) {
    const int lane = c.lane, wave = c.wave, hb = c.vb & 1;
    bf16* ST = (bf16*)(c.smem - hb * HALF_LDS);
    bf16* STh = ST + hb * 32 * 72;
    for (int chain = c.vb >> 1; chain < NSEQ * 8; chain += c.nvb >> 1) {
        const int d = chain & 1, h = (chain >> 1) & 3, seq = chain >> 3;
        const bool lat = seq >= BATCH; const int cps = lat ? CPS_LAT : CPS_CTX; const int ch0 = lat ? NCH_CTX + (seq - BATCH) * CPS_LAT : seq * CPS_CTX;
        f32x4 S[1][2];
#pragma unroll
        for (int nt = 0; nt < 2; ++nt)
#pragma unroll
            for (int r = 0; r < 4; ++r) {
                const int dk = wave * 16 + (lane >> 4) * 4 + r, dv = hb * 32 + nt * 16 + (lane & 15);
                S[0][nt][r] = lat ? p.state_delta[(((((size_t)(seq - BATCH) * DEPTH + l) * 2 + d) * 4 + h) * 64 + dk) * 64 + dv] : 0.f;
            }
#define SCAN_ITEM(qq) ((((ch0 + (d ? cps - 1 - ((qq) < cps ? (qq) : cps - 1) : ((qq) < cps ? (qq) : cps - 1))) * 4 + h) * 2) + d)
#define SCAN_STEP(ops, qq) do { \
            const int ch = ch0 + (d ? cps - 1 - (qq) : (qq)); \
            BLOCK_SYNC(); \
            _Pragma("unroll") for (int nt = 0; nt < 2; ++nt) *(u32x2*)(STh + (nt * 16 + (lane & 15)) * 72 + wave * 16 + (lane >> 4) * 4) = pack4(S[0][nt]); \
            BLOCK_SYNC(); \
            f32x4 Sn[1][2], O[2][1]; \
            _Pragma("unroll") for (int nt = 0; nt < 2; ++nt) { Sn[0][nt] = S[0][nt] * ops.egl + unpack4(ops.bt[nt]); O[nt][0] = unpack4(ops.ot[nt]); } \
            scan_mma_s(Sn, ops, STh, lane); \
            scan_mma_o(O, ops, STh, lane); \
            { const int tau = wave * 16 + (lane & 15); const size_t tok = (size_t)ch * 64 + (d ? 63 - tau : tau); \
              _Pragma("unroll") for (int mt = 0; mt < 2; ++mt) *(u32x2*)(p.obuf + ((size_t)d * NTOK + tok) * 256 + h * 64 + hb * 32 + mt * 16 + (lane >> 4) * 4) = pack4(O[mt][0]); } \
            _Pragma("unroll") for (int nt = 0; nt < 2; ++nt) S[0][nt] = Sn[0][nt]; \
        } while (0)
        ScanOps o0, o1, o2, o3;
        scan_load(o0, p, SCAN_ITEM(0), wave, hb, lane); scan_load(o1, p, SCAN_ITEM(1), wave, hb, lane); scan_load(o2, p, SCAN_ITEM(2), wave, hb, lane);
#pragma unroll 1
        for (int q = 0; q < cps; q += 4) {
            scan_load(o3, p, SCAN_ITEM(q + 3), wave, hb, lane); SCHED_BARRIER(); SCAN_STEP(o0, q); SCHED_BARRIER();
            scan_load(o0, p, SCAN_ITEM(q + 4), wave, hb, lane); SCHED_BARRIER(); SCAN_STEP(o1, q + 1); SCHED_BARRIER();
            scan_load(o1, p, SCAN_ITEM(q + 5), wave, hb, lane); SCHED_BARRIER(); SCAN_STEP(o2, q + 2); SCHED_BARRIER();
            scan_load(o2, p, SCAN_ITEM(q + 6), wave, hb, lane); SCHED_BARRIER(); SCAN_STEP(o3, q + 3); SCHED_BARRIER();
        }
#undef SCAN_STEP
#undef SCAN_ITEM
        if (!lat) {
#pragma unroll
            for (int nt = 0; nt < 2; ++nt)
#pragma unroll
                for (int r = 0; r < 4; ++r) {
                    const int dk = wave * 16 + (lane >> 4) * 4 + r, dv = hb * 32 + nt * 16 + (lane & 15);
                    p.out[OUT_DN + (((((size_t)seq * DEPTH + l) * 2 + d) * 4 + h) * 64 + dk) * 64 + dv] = S[0][nt][r];
                }
        }
    }
}
static_assert(CPS_CTX % 4 == 0, "scan ring assumes chunk counts divisible by 4");
__device__ __forceinline__ void dn_d3_body(const Params& p, int l, const Ctx& c) {
    const int lane = c.lane, wave = c.wave;
    for (size_t tok = (size_t)c.vb * 4 + wave; tok < (size_t)NTOK; tok += (size_t)c.nvb * 4) {
        const u32x2 a = *(const u32x2*)(p.obuf + tok * 256 + lane * 4), b = *(const u32x2*)(p.obuf + ((size_t)NTOK + tok) * 256 + lane * 4);
        const u32x2 zz = *(const u32x2*)(p.proj + tok * NPROJ + DZ + lane * 4);
        float v[4] = {bf2f((bf16)(a.x & 0xffff)) + bf2f((bf16)(b.x & 0xffff)), bf2f((bf16)(a.x >> 16)) + bf2f((bf16)(b.x >> 16)),
                      bf2f((bf16)(a.y & 0xffff)) + bf2f((bf16)(b.y & 0xffff)), bf2f((bf16)(a.y >> 16)) + bf2f((bf16)(b.y >> 16))};
        const float z[4] = {bf2f((bf16)(zz.x & 0xffff)), bf2f((bf16)(zz.x >> 16)), bf2f((bf16)(zz.y & 0xffff)), bf2f((bf16)(zz.y >> 16))};
        float ss = v[0] * v[0] + v[1] * v[1] + v[2] * v[2] + v[3] * v[3];
        ss += __shfl_xor(ss, 1); ss += __shfl_xor(ss, 2); ss += __shfl_xor(ss, 4); ss += __shfl_xor(ss, 8);
        const float rs = 1.0f / sqrtf(ss / 64.f + EPS);
        const int q0 = (lane & 15) * 4; float y[4];
#pragma unroll
        for (int i = 0; i < 4; ++i) y[i] = v[i] * rs * p.dn_norm_g[l * 64 + q0 + i] * silu_f(z[i]);
        u32x2 w; w.x = pk2(y[0], y[1]); w.y = pk2(y[2], y[3]);
        *(u32x2*)(p.mix + tok * DMIX + 256 + lane * 4) = w;
    }
}

__device__ __forceinline__ void final_norm_body(const Params& p, const Ctx& c) {
    const int lane = c.lane, wave = c.wave;
    for (int tok0 = c.vb * 4; tok0 < NTOK; tok0 += c.nvb * 4) {
        float* xr = p.out + (size_t)(tok0 + wave) * D;
        float v[D / 64]; float ss = 0.f;
#pragma unroll
        for (int j = 0; j < D / 64; ++j) { v[j] = xr[j * 64 + lane]; ss += v[j] * v[j]; }
#pragma unroll
        for (int o = 1; o < 64; o <<= 1) ss += __shfl_xor(ss, o);
        const float rs = 1.0f / sqrtf(ss / (float)D + EPS);
#pragma unroll
        for (int j = 0; j < D / 64; ++j) xr[j * 64 + lane] = v[j] * rs * p.final_g[j * 64 + lane];
    }
}

enum { PH_PREP = 0, PH_NORM, PH_GEMM_IN, PH_LOCAL, PH_SCAN, PH_POST, PH_POST2, PH_GEMM_OUT, PH_FINAL };
__device__ __forceinline__ Ctx make_ctx(char* smem) {
    Ctx c; const int hb = UNIFORM((int)(threadIdx.x >> 8));
    c.tid = threadIdx.x & 255; c.lane = c.tid & 63; c.wave = UNIFORM(c.tid >> 6); c.vb = blockIdx.x * 2 + hb; c.nvb = gridDim.x * 2; c.smem = smem + hb * HALF_LDS;
    return c;
}
__device__ __forceinline__ Ctx shifted(const Ctx& c, int by) { Ctx s = c; s.vb = (c.vb + c.nvb - (by % c.nvb)) % c.nvb; return s; }
__device__ __forceinline__ void run_phase(const Params& p, int ph, int l, const Ctx& c0) {
    Ctx c = c0;
    LAUNDER_V(c.tid); c.lane = c.tid & 63; c.wave = UNIFORM(c.tid >> 6); LAUNDER_S(c.vb); LAUNDER_S(l);
    switch (ph) {
    case PH_PREP: prep_weights_body(p, (size_t)c.vb * 256 + c.tid, (size_t)c.nvb * 256); prep_tiled_body(p, c); break;
    case PH_NORM: norm_mod_body(p, l, c); break;
    case PH_GEMM_IN: { EpiProj e{p.proj, p.gates}; gemm_body<128>(p.hbuf, D, p.winT + (size_t)l * NPAD * D, D, NTOK, NPAD, D, e, c); } break;
    case PH_LOCAL:
        dn_d1_body(p, l, c); BLOCK_SYNC();
        pool_body(p, l, c); BLOCK_SYNC();
        ft_ctx_body(p, shifted(c, 0)); BLOCK_SYNC();
        ft_latA_body(p, shifted(c, BATCH * 4 * (SEQ / 64))); BLOCK_SYNC();
        s5_pass1_body(p, l, c);
        break;
    case PH_SCAN:
        dn_scan_body(p, l, c);
        ft_latB_body(p, shifted(c, NSEQ * 16));
        s5_carry_body(p, l, shifted(c, NSEQ * 16 + DEC_BATCH * 64));
        break;
    case PH_POST: s5_pass3_body(p, l, c); dn_d3_body(p, l, c); break;
    case PH_POST2: {
        EpiGlu eg{&p, l}; gemm_body<128>(p.ybuf, 256, p.gluT + (size_t)l * 65536, 256, NTOK, 256, 256, eg, c); BLOCK_SYNC();
        EpiFt ef{&p}; gemm_body<128>(p.fbuf, 256, p.ftwT + (size_t)l * 65536, 256, NTOK, 256, 256, ef, c);
    } break;
    case PH_GEMM_OUT: { EpiOut e{&p, l}; gemm_body<OUT_TOK>(p.mix, DMIX, p.woutT + (size_t)l * D * DMIX, DMIX, NTOK, D, DMIX, e, c); } break;
    case PH_FINAL: final_norm_body(p, c); break;
#ifdef PROBE_PH
    case 10: dn_d1_body(p, l, c); break;
    case 11: pool_body(p, l, c); break;
    case 12: ft_ctx_body(p, c); BLOCK_SYNC(); ft_latA_body(p, c); break;
    case 14: s5_pass1_body(p, l, c); break;
    case 15: s5_pass3_body(p, l, c); break;
    case 16: dn_d3_body(p, l, c); break;
    case 17: dn_scan_body(p, l, c); break;
    case 18: ft_latB_body(p, shifted(c, NSEQ * 8)); s5_carry_body(p, l, shifted(c, NSEQ * 8 + DEC_BATCH * 64)); break;
#endif
    }
}
#ifndef EMU
#define XB_TMO      128
#define XB_XCNT(j)  (256  + 64 * (j))
#define XB_XSUB(j)  (1280 + 64 * (j))
#define XB_XGEN(j)  (2304 + 64 * (j))
#define XB_TOP      3328
#define XB_TOPGEN   3392
#define XCD_BAR_WORDS 3456
#define XB_SPIN_CAP (1u << 18)
#define LAS __attribute__((address_space(3)))
__device__ __forceinline__ unsigned xb_ld(unsigned* p)              { return __hip_atomic_load(p, __ATOMIC_RELAXED, __HIP_MEMORY_SCOPE_AGENT); }
__device__ __forceinline__ unsigned xb_add(unsigned* p, unsigned v) { return __hip_atomic_fetch_add(p, v, __ATOMIC_RELAXED, __HIP_MEMORY_SCOPE_AGENT); }
__device__ __forceinline__ unsigned xb_xcc_id() { return (unsigned)__builtin_amdgcn_s_getreg((3 << 11) | 20) & 0xFu; }
#define XB_SPIN(cond, bar) do { unsigned _sp = 0; while (cond) { __builtin_amdgcn_s_sleep(1); \
    if ((++_sp & 255u) == 0u) { if (xb_ld(&(bar)[XB_TMO])) break; if (_sp > XB_SPIN_CAP) { atomicAdd(&(bar)[XB_TMO], 1u); break; } } } } while (0)
struct XcdBarrier { unsigned* bar; unsigned x; volatile LAS unsigned* st; };
__device__ __forceinline__ XcdBarrier xcd_barrier_post(unsigned* bar, volatile LAS unsigned* st) {
    XcdBarrier b; b.bar = bar; b.x = xb_xcc_id(); b.st = st;
    if (threadIdx.x == 0) (void)xb_add(&bar[XB_XCNT(b.x)], 1u);
    return b;
}
__device__ __forceinline__ void xcd_barrier_complete(unsigned* bar, unsigned x, unsigned& nloc, unsigned& nx) {
    const unsigned G = gridDim.x * gridDim.y * gridDim.z;
    unsigned sum, cnt, mine, sp = 0u;
    for (;;) {
        sum = 0u; cnt = 0u; mine = 0u;
#pragma unroll
        for (unsigned j = 0; j < 16; ++j) { const unsigned c = xb_ld(&bar[XB_XCNT(j)]); sum += c; cnt += (c > 0u) ? 1u : 0u; mine = (j == x) ? c : mine; }
        if (sum == G) break;
        __builtin_amdgcn_s_sleep(1);
        if ((++sp & 255u) == 0u) { if (xb_ld(&bar[XB_TMO])) break; if (sp > XB_SPIN_CAP) { atomicAdd(&bar[XB_TMO], 1u); break; } }
    }
    nloc = mine > 0u ? mine : 1u; nx = cnt > 0u ? cnt : 1u;
}
__device__ __forceinline__ void xcd_barrier(const XcdBarrier& b) {
    asm volatile("s_waitcnt vmcnt(0)" ::: "memory");
    __syncthreads();
    if (threadIdx.x == 0) {
        unsigned* bar = b.bar;
        __builtin_amdgcn_s_waitcnt(0);
        unsigned nloc = b.st[0], nx = b.st[1];
        if (nloc == 0u) { xcd_barrier_complete(bar, b.x, nloc, nx); b.st[0] = nloc; b.st[1] = nx; }
        const unsigned old = xb_add(&bar[XB_XSUB(b.x)], 1u);
        const unsigned gen = old / nloc;
        if (old + 1u == (gen + 1u) * nloc) {
            __builtin_amdgcn_fence(__ATOMIC_RELEASE, "agent");
            asm volatile("s_waitcnt vmcnt(0)" ::: "memory");
            const unsigned og = xb_add(&bar[XB_TOP], 1u);
            const unsigned tg = og / nx;
            if (og + 1u == (tg + 1u) * nx) xb_add(&bar[XB_TOPGEN], 1u);
            else XB_SPIN(xb_ld(&bar[XB_TOPGEN]) == tg, bar);
            __builtin_amdgcn_fence(__ATOMIC_ACQUIRE, "agent");
            xb_add(&bar[XB_XGEN(b.x)], 1u);
            asm volatile("s_waitcnt vmcnt(0)" ::: "memory");
        } else {
            XB_SPIN(xb_ld(&bar[XB_XGEN(b.x)]) == gen, bar);
            __builtin_amdgcn_fence(__ATOMIC_ACQUIRE, "agent");
            asm volatile("s_waitcnt vmcnt(0)" ::: "memory");
        }
    }
    __syncthreads();
}
#endif
constexpr int MEGA_LDS = 2 * HALF_LDS + 16;
#ifdef EMU
__global__ void __launch_bounds__(512) k_phase(Params p, int ph, int l) { DYN_LDS(smem); const Ctx c = make_ctx(smem); run_phase(p, ph, l, c); }
#else
__global__ void __launch_bounds__(512) k_mega(Params p) {
    DYN_LDS(smem);
    volatile LAS unsigned* st = (volatile LAS unsigned*)(smem + 2 * HALF_LDS);
    if (threadIdx.x < 4) st[threadIdx.x] = 0u;
    __syncthreads();
    const XcdBarrier bar = xcd_barrier_post(p.bar, st);
#define GRID_SYNC() xcd_barrier(bar)
    const Ctx c = make_ctx(smem);
#ifdef PROBE_TID
    unsigned long long t_acc = 0;
#define TIMED(ph, ...) do { const unsigned long long _t0 = __builtin_amdgcn_s_memrealtime(); __VA_ARGS__; if ((ph) == PROBE_TID) t_acc += __builtin_amdgcn_s_memrealtime() - _t0; } while (0)
#else
#define TIMED(ph, ...) do { __VA_ARGS__; } while (0)
#endif
    TIMED(PH_PREP, run_phase(p, PH_PREP, 0, c); GRID_SYNC());
#ifdef PROBE_SYNCS
#pragma unroll 1
    for (int i = 0; i < PROBE_SYNCS; ++i) GRID_SYNC();
#endif
#ifdef PROBE_PH
#pragma unroll 1
    for (int i = 0; i < PROBE_REP; ++i) { run_phase(p, PROBE_PH, 0, c); GRID_SYNC(); }
#endif
#pragma unroll 1
    for (int l = 0; l < DEPTH; ++l) {
        TIMED(PH_NORM, run_phase(p, PH_NORM, l, c); GRID_SYNC());
        TIMED(PH_GEMM_IN, run_phase(p, PH_GEMM_IN, l, c); GRID_SYNC());
        TIMED(PH_LOCAL, run_phase(p, PH_LOCAL, l, c); GRID_SYNC());
        TIMED(PH_SCAN, run_phase(p, PH_SCAN, l, c); GRID_SYNC());
        TIMED(PH_POST, run_phase(p, PH_POST, l, c); GRID_SYNC());
        TIMED(PH_POST2, run_phase(p, PH_POST2, l, c); GRID_SYNC());
        TIMED(PH_GEMM_OUT, run_phase(p, PH_GEMM_OUT, l, c); GRID_SYNC());
    }
    TIMED(PH_FINAL, run_phase(p, PH_FINAL, 0, c));
#ifdef PROBE_TID
    if (blockIdx.x == 0 && threadIdx.x == 0) { const unsigned long long t1 = __builtin_amdgcn_s_memrealtime(); while (__builtin_amdgcn_s_memrealtime() - t1 < (unsigned long long)PROBE_TK * t_acc) __builtin_amdgcn_s_sleep(8); }
#endif
}
#endif

static size_t ws_carve(Params& p, char* ws) {
    size_t off = 0;
    auto take = [&](size_t bytes) { size_t o = off; off += (bytes + 255) & ~(size_t)255; return ws ? ws + o : (char*)nullptr; };
    p.bar = (unsigned*)take(16384);
    p.winT = (bf16*)take((size_t)DEPTH * NPAD * D * 2);
    p.woutT = (bf16*)take((size_t)DEPTH * D * DMIX * 2);
    p.ftwT = (bf16*)take((size_t)DEPTH * 65536 * 2);
    p.gluT = (bf16*)take((size_t)DEPTH * 65536 * 2);
    p.poolwT = (bf16*)take((size_t)DEPTH * 4 * 4096 * 2);
    p.Cmat = (bf16*)take((size_t)DEPTH * 16 * 4096 * 2);
    p.tabDc = (bf16*)take(128 * 64 * 2);
    p.tabE = (bf16*)take(128 * 128 * 2);
    p.tabT = (bf16*)take((size_t)SEQ * 2 * SEQ * 2);
    p.ada = (float*)take((size_t)DEPTH * NCOND * 3 * D * 4);
    p.abar = (float*)take((size_t)DEPTH * 2 * 16 * 64 * 2 * 4);
    p.abar64 = (float*)take((size_t)DEPTH * 2 * 16 * 64 * 2 * 4);
    p.bbar = (float*)take((size_t)DEPTH * 2 * 16 * 64 * 32 * 4);
    p.hbuf = (bf16*)take((size_t)NTOK * DMIX * 2);
    p.mix = p.hbuf;
    p.proj = (bf16*)take((size_t)NTOK * NPROJ * 2);
    p.fbuf = (bf16*)take((size_t)NTOK * 256 * 2);
    p.ybuf = (bf16*)take((size_t)NTOK * 256 * 2);
    p.obuf = (bf16*)take((size_t)2 * NTOK * 256 * 2);
    p.Zg = (bf16*)take((size_t)DEC_BATCH * 64 * 256 * 128 * 2);
    p.dnAp = (bf16*)take((size_t)NCH * 8 * 4096 * 2);
    p.dnQh = (bf16*)take((size_t)NCH * 8 * 4096 * 2);
    p.dnBT = (bf16*)take((size_t)NCH * 8 * 4096 * 2);
    p.dnOT = (bf16*)take((size_t)NCH * 8 * 4096 * 2);
    p.gates = (float*)take((size_t)NTOK * 16 * 4);
    p.dnEgl = (float*)take((size_t)NCH * 8 * 4);
    p.s5E = (float*)take((size_t)NCH * 16 * 2 * 128 * 4);
    p.s5S = (float*)take((size_t)NCH * 16 * 2 * 128 * 4);
    return off;
}

#ifdef EMU
void emu_hook(const char* tag, int l, const Params& p);
#define HOOK(tag, l) emu_hook(tag, l, p)
#endif
extern "C" void kernel_launch(void* const* d_in, const int* in_sizes, int n_in, void* d_out, int out_size, void* d_ws, size_t ws_size, hipStream_t stream) {
    Params p;
    memset(&p, 0, sizeof(p));
    const float** ip = (const float**)&p;
    for (int i = 0; i < 29; ++i) ip[i] = (const float*)d_in[i];
    p.out = (float*)d_out;
    const size_t need = ws_carve(p, (char*)d_ws);
    if (need > ws_size || n_in != 29) { fprintf(stderr, "kernel_launch: workspace %zu < %zu or n_in %d\n", ws_size, need, n_in); return; }
#ifdef EMU
    const int G = 6;
    LAUNCH(k_phase, G, 512, MEGA_LDS, stream, p, (int)PH_PREP, 0);
    for (int l = 0; l < DEPTH; ++l)
        for (int ph = PH_NORM; ph <= PH_GEMM_OUT; ++ph) {
            LAUNCH(k_phase, G, 512, MEGA_LDS, stream, p, ph, l);
            if (ph == PH_NORM) HOOK("norm", l);
            if (ph == PH_GEMM_IN) HOOK("proj", l);
            if (ph == PH_POST2) HOOK("mix", l);
            if (ph == PH_GEMM_OUT) HOOK("xout", l);
        }
    LAUNCH(k_phase, G, 512, MEGA_LDS, stream, p, (int)PH_FINAL, 0);
#else
    static int grid = 0;
    if (!grid) {
        int dev = 0, cus = 0, per_cu = 0;
        (void)hipGetDevice(&dev);
        (void)hipDeviceGetAttribute(&cus, hipDeviceAttributeMultiprocessorCount, dev);
        (void)hipFuncSetAttribute((const void*)k_mega, hipFuncAttributeMaxDynamicSharedMemorySize, MEGA_LDS);
        (void)hipOccupancyMaxActiveBlocksPerMultiprocessor(&per_cu, (const void*)k_mega, 512, MEGA_LDS);
        if (per_cu < 1) { fprintf(stderr, "kernel_launch: occupancy query says %d blocks/CU\n", per_cu); per_cu = 1; }
        grid = cus * 1;
        fprintf(stderr, "kernel_launch: cus %d per_cu %d grid %d\n", cus, per_cu, grid);
    }
    (void)hipMemsetAsync(p.bar, 0, 16384, stream);
    void* args[] = {&p};
    hipError_t e = hipLaunchCooperativeKernel((const void*)k_mega, dim3(grid), dim3(512), args, MEGA_LDS, stream);
    if (e != hipSuccess) fprintf(stderr, "cooperative launch failed: %s (grid %d)\n", hipGetErrorString(e), grid);
#endif
}
```

```cpp
#ifdef EMU
#include "hip_emu.h"
#define LAUNCH(k, g, b, l, s, ...) EMU_LAUNCH(k, g, b, l, s, __VA_ARGS__)
#define DYN_LDS(name) char* name = emu::dyn_lds
#define WAVE_SYNC() emu_wave_sync()
#define BLOCK_SYNC() __syncthreads()
#define SCHED_BARRIER()
#define UNIFORM(x) (x)
#define LAUNDER_V(x)
#define LAUNDER_S(x)
#else
#include <hip/hip_runtime.h>
#include <hip/hip_cooperative_groups.h>
#include <cstdio>
#include <cstdint>
#include <cstring>
#define LAUNCH(k, g, b, l, s, ...) hipLaunchKernelGGL(k, dim3(g), dim3(b), l, s, __VA_ARGS__)
#define DYN_LDS(name) extern __shared__ __attribute__((aligned(16))) char name[]
#define WAVE_SYNC() do { __builtin_amdgcn_s_waitcnt(0xc07f); __builtin_amdgcn_wave_barrier(); } while (0)
#define SCHED_BARRIER() __builtin_amdgcn_sched_barrier(0)
#ifndef PROBE_TB
#define PROBE_TB 0
#endif
#define BLOCK_SYNC() do { asm volatile("s_waitcnt lgkmcnt(0)" ::: "memory"); __builtin_amdgcn_s_barrier(); asm volatile("" ::: "memory"); } while (0)
#define UNIFORM(x) __builtin_amdgcn_readfirstlane(x)
#define LAUNDER_V(x) asm volatile("" : "+v"(x))
#define LAUNDER_S(x) asm volatile("" : "+s"(x))
#endif

#ifndef D_MODEL
#define D_MODEL 1024
#endif
#ifndef BATCH
#define BATCH 16
#endif
#ifndef SEQ
#define SEQ 256
#endif
#ifndef DEPTH
#define DEPTH 4
#endif
#ifndef DEC_BATCH
#define DEC_BATCH 2
#endif
#define DEC_SEQ 4096
constexpr int D = D_MODEL;
constexpr int NCTX = BATCH * SEQ, NLAT = DEC_BATCH * DEC_SEQ, NTOK = NCTX + NLAT;
constexpr int NCH_CTX = NCTX / 64, NCH_LAT = NLAT / 64, NCH = NTOK / 64;
constexpr int CPS_CTX = SEQ / 64, CPS_LAT = 64;
constexpr int NSEQ = BATCH + DEC_BATCH, NCOND = 1 + DEC_BATCH;
constexpr int BR = 256, DMIX = 1024;
constexpr int PU = 0, PZ = 256, QKV = 512, DZ = 1280, SU = 1536, SZ = 1792, FU = 2048, FZ = 2304, NPROJ = 2560, NPAD = 2688;
constexpr int D_IN_PROJ = 2576;
constexpr float EPS = 1e-6f;

typedef unsigned short bf16;
typedef float f32x4 __attribute__((ext_vector_type(4)));
typedef short bf16x8 __attribute__((ext_vector_type(8)));
typedef float f32x16 __attribute__((ext_vector_type(16)));
typedef unsigned u32x2 __attribute__((ext_vector_type(2)));
typedef unsigned u32x4 __attribute__((ext_vector_type(4)));

__device__ __forceinline__ unsigned f2u(float f) { return __builtin_bit_cast(unsigned, f); }
__device__ __forceinline__ float u2f(unsigned u) { return __builtin_bit_cast(float, u); }
#ifdef EMU
__device__ __forceinline__ bf16 f2bf(float f) { unsigned u = f2u(f); return (bf16)((u + 0x7fffu + ((u >> 16) & 1u)) >> 16); }
__device__ __forceinline__ unsigned pk2(float lo, float hi) { return (unsigned)f2bf(lo) | ((unsigned)f2bf(hi) << 16); }
#else
typedef __bf16 hwbf2 __attribute__((ext_vector_type(2)));
typedef float hwf2 __attribute__((ext_vector_type(2)));
__device__ __forceinline__ bf16 f2bf(float f) { const __bf16 h = (__bf16)f; return __builtin_bit_cast(bf16, h); }
__device__ __forceinline__ unsigned pk2(float lo, float hi) { const hwf2 v = {lo, hi}; const hwbf2 b = __builtin_convertvector(v, hwbf2); return __builtin_bit_cast(unsigned, b); }
#endif
__device__ __forceinline__ float bf2f(bf16 h) { return u2f((unsigned)h << 16); }
__device__ __forceinline__ float silu_f(float x) { return x / (1.0f + expf(-x)); }
__device__ __forceinline__ float sigmoid_f(float x) { return 1.0f / (1.0f + expf(-x)); }
__device__ __forceinline__ float softplus_f(float x) { return x > 20.f ? x : log1pf(expf(x)); }
__device__ __forceinline__ float gelu_f(float x) { return 0.5f * x * (1.0f + tanhf(0.7978845608028654f * (x + 0.044715f * x * x * x))); }

template <int MT, int NT>
__device__ __forceinline__ void mma_tiles(f32x4 (&acc)[MT][NT], const bf16* A, int lda, const bf16* B, int ldb, int K, int lane) {
#ifdef EMU
    const int col = lane & 15, rq = (lane >> 4) * 4;
    for (int mt = 0; mt < MT; ++mt) for (int nt = 0; nt < NT; ++nt) for (int r = 0; r < 4; ++r) {
        float s = 0.f; const bf16* a = A + (16 * mt + rq + r) * lda; const bf16* b = B + (16 * nt + col) * ldb;
        for (int k = 0; k < K; ++k) s += bf2f(a[k]) * bf2f(b[k]);
        acc[mt][nt][r] += s;
    }
#else
    const bf16* a0 = A + (lane & 15) * lda + (lane >> 4) * 8;
    const bf16* b0 = B + (lane & 15) * ldb + (lane >> 4) * 8;
    for (int k0 = 0; k0 < K; k0 += 32) {
        bf16x8 a[MT], b[NT];
#pragma unroll
        for (int mt = 0; mt < MT; ++mt) a[mt] = *(const bf16x8*)(a0 + 16 * mt * lda + k0);
#pragma unroll
        for (int nt = 0; nt < NT; ++nt) b[nt] = *(const bf16x8*)(b0 + 16 * nt * ldb + k0);
#pragma unroll
        for (int mt = 0; mt < MT; ++mt)
#pragma unroll
            for (int nt = 0; nt < NT; ++nt) acc[mt][nt] = __builtin_amdgcn_mfma_f32_16x16x32_bf16(a[mt], b[nt], acc[mt][nt], 0, 0, 0);
    }
#endif
}
__device__ __forceinline__ void mma32(f32x16& acc, const bf16* A, int lda, const bf16* B, int ldb, int lane) {
#ifdef EMU
    const int col = lane & 31, h = lane >> 5;
    for (int r = 0; r < 16; ++r) {
        const int row = (r & 3) + 8 * (r >> 2) + 4 * h; float s = 0.f;
        for (int k = 0; k < 16; ++k) s += bf2f(A[row * lda + k]) * bf2f(B[col * ldb + k]);
        acc[r] += s;
    }
#else
    const bf16x8 a = *(const bf16x8*)(A + (lane & 31) * lda + (lane >> 5) * 8);
    const bf16x8 b = *(const bf16x8*)(B + (lane & 31) * ldb + (lane >> 5) * 8);
    acc = __builtin_amdgcn_mfma_f32_32x32x16_bf16(a, b, acc, 0, 0, 0);
#endif
}
__device__ __forceinline__ float swap_halves(float v, int lane) {
#ifdef EMU
    (void)lane; return __shfl_xor(v, 32);
#else
    const unsigned u = f2u(v); const auto r = __builtin_amdgcn_permlane32_swap(u, u, false, false);
    return u2f((lane & 32) ? r[0] : r[1]);
#endif
}
template <int MT, int NT> __device__ __forceinline__ void zero_acc(f32x4 (&acc)[MT][NT]) {
#pragma unroll
    for (int mt = 0; mt < MT; ++mt)
#pragma unroll
        for (int nt = 0; nt < NT; ++nt) acc[mt][nt] = (f32x4){0.f, 0.f, 0.f, 0.f};
}

struct Params {
    const float *x_prompt, *x_sample, *c, *state_delta, *state_s5, *c_ctx, *w_ada, *b_ada, *norm_g, *w_in, *pool_w, *pool_scale,
        *dn_conv, *dn_a_log, *dn_dt_bias, *dn_norm_g, *s5_a_re, *s5_a_im, *s5_log_dt, *s5_b_re, *s5_b_im, *s5_c_re, *s5_c_im,
        *s5_d, *s5_glu_w, *s5_glu_b, *ft_w, *w_out, *final_g;
    float* out;
    bf16 *winT, *woutT, *ftwT, *gluT, *poolwT, *Cmat, *tabDc, *tabE, *tabT;
    float *ada, *abar, *abar64, *bbar;
    bf16* bbarT;
    bf16 *hbuf  , *mix, *proj, *fbuf, *ybuf, *obuf, *Zg, *dnAp, *dnQh, *dnBT, *dnOT;
    float *gates, *dnEgl, *s5E, *s5S;
    unsigned* bar;
};
constexpr size_t OUT_DN = (size_t)NTOK * D, OUT_S5 = OUT_DN + (size_t)BATCH * DEPTH * 2 * 4 * 64 * 64;
constexpr size_t OUT_TOTAL = OUT_S5 + (size_t)BATCH * DEPTH * 2 * 2 * 16 * 64;

struct Ctx { int tid, lane, wave, vb, nvb; char* smem; };
constexpr int HALF_LDS = 81664;
__device__ __forceinline__ int loop_iters(int N, const Ctx& c) { const int v0 = c.vb & ~1; return N > v0 ? (N - v0 + c.nvb - 1) / c.nvb : 0; }
__device__ __forceinline__ int cond_of(int tok) { return tok < NCTX ? 0 : 1 + (tok - NCTX) / DEC_SEQ; }
__device__ __forceinline__ const float* xrow_in(const Params& p, int l, int tok) {
    if (l == 0) return tok < NCTX ? p.x_prompt + (size_t)tok * D : p.x_sample + (size_t)(tok - NCTX) * D;
    return p.out + (size_t)tok * D;
}

__device__ __forceinline__ void prep_weights_body(const Params& p, size_t gtid, size_t gsz) {
    for (size_t i = gtid; i < (size_t)DEPTH * 4 * 64 * 64; i += gsz) {
        int c = (int)(i % 64), d = (int)((i / 64) % 64); size_t lg = i / 4096;
        p.poolwT[i] = f2bf(p.pool_w[(lg * 64 + c) * 64 + d]);
    }
    for (size_t i = gtid; i < (size_t)DEPTH * 16 * 16 * 256; i += gsz) {
        int k = (int)(i % 256), pp = (int)((i / 256) % 16), g = (int)((i / 4096) % 16), l = (int)(i / 65536);
        int d = k >> 7, part = (k >> 6) & 1, n = k & 63;
        size_t src = ((((size_t)l * 2 + d) * 16 + g) * 16 + pp) * 64 + n;
        p.Cmat[i] = f2bf(part ? -p.s5_c_im[src] : p.s5_c_re[src]);
    }
    const float TWO_PI = 6.283185307179586f;
    for (size_t i = gtid; i < 128 * 64; i += gsz) {
        int c = (int)(i % 64), n = (int)(i / 64), part = n >> 6, kc = n & 63; int m = (c * kc) & 63;
        float a = TWO_PI * (float)m / 64.f; p.tabDc[i] = f2bf(part ? -sinf(a) : cosf(a));
    }
    for (size_t i = gtid; i < 128 * 128; i += gsz) {
        int kk = (int)(i % 128), n = (int)(i / 128); int pp = n >> 6, k1 = n & 63, pt = kk >> 6, t1 = kk & 63; int m = (t1 * k1) & 63;
        float a = TWO_PI * (float)m / 64.f; float C = cosf(a), S = sinf(a);
        float v = (pp == 0) ? (pt == 0 ? C : S) : (pt == 0 ? -S : C);
        p.tabE[i] = f2bf(v);
    }
    for (size_t i = gtid; i < (size_t)SEQ * 2 * SEQ; i += gsz) {
        int kk = (int)(i % (2 * SEQ)), kt = (int)(i / (2 * SEQ)); int part = kk / SEQ, t = kk % SEQ; int m = (kt * t) % SEQ;
        float a = TWO_PI * (float)m / (float)SEQ; p.tabT[i] = f2bf(part ? sinf(a) : cosf(a));
    }
    for (size_t i = gtid; i < (size_t)DEPTH * 2 * 16 * 64; i += gsz) {
        size_t ldg = i / 64;
        float dt = expf(p.s5_log_dt[ldg]); float are = p.s5_a_re[i], aim = p.s5_a_im[i];
        float mag = expf(are * dt); float abr = mag * cosf(aim * dt), abi = mag * sinf(aim * dt);
        float den = are * are + aim * aim; float nr = abr - 1.0f;
        float cre = (nr * are + abi * aim) / den, cim = (abi * are - nr * aim) / den;
        p.abar[2 * i] = abr; p.abar[2 * i + 1] = abi;
        float pr = abr, pi = abi;
        for (int s = 0; s < 6; ++s) { float t0 = pr * pr - pi * pi, t1 = 2.f * pr * pi; pr = t0; pi = t1; }
        p.abar64[2 * i] = pr; p.abar64[2 * i + 1] = pi;
        for (int pp = 0; pp < 16; ++pp) {
            float bre = p.s5_b_re[i * 16 + pp], bim = p.s5_b_im[i * 16 + pp];
            p.bbar[i * 32 + pp] = cre * bre - cim * bim;
            p.bbar[i * 32 + 16 + pp] = cre * bim + cim * bre;
            const size_t ldgi = i / 64; const int nn = (int)(i % 64);
            p.bbarT[(ldgi * 128 + nn) * 16 + pp] = f2bf(cre * bre - cim * bim);
            p.bbarT[(ldgi * 128 + 64 + nn) * 16 + pp] = f2bf(cre * bim + cim * bre);
        }
    }
}


constexpr int PT_KT = D / 64;
constexpr int PT_WIN = DEPTH * (NPAD / 64) * PT_KT;
constexpr int PT_WOUT = DEPTH * (D / 64) * (DMIX / 64);
constexpr int PT_SQ = DEPTH * 2 * 16;
constexpr int PT_ADA = DEPTH * (3 * D / 64);
constexpr int PT_TOTAL = PT_WIN + PT_WOUT + PT_SQ + PT_ADA;
constexpr int PREP_LDS = 64 * 65 * 4 + NCOND * D * 4;
__device__ __forceinline__ void prep_tiled_body(const Params& p, const Ctx& c) {
    float* T = (float*)c.smem;
    float* sc = T + 64 * 65;
    const int tid = c.tid;
    for (int i = tid; i < NCOND * D; i += 256) { const int cc = i / D, k = i % D; sc[i] = silu_f(cc == 0 ? p.c_ctx[k] : p.c[(size_t)(cc - 1) * D + k]); }
    for (int _k = 0, _n = loop_iters(PT_TOTAL, c); _k < _n; ++_k) {
        int item = c.vb + _k * c.nvb; const bool ghost = item >= PT_TOTAL; if (ghost) item = PT_TOTAL - 1;
        int type, l, kt = 0, nt = 0;
        const float* src_ = nullptr; int lds_ = 0, k0 = 0, ncol0 = 0, nvalid = 64; bf16* dst = nullptr; int ldk = 0;
        if (item < PT_WIN) { type = 0; l = item / ((NPAD / 64) * PT_KT); const int r = item % ((NPAD / 64) * PT_KT); nt = r / PT_KT; kt = r % PT_KT;
            const int n0 = nt * 64; const int oc = n0 < 1536 ? n0 : (n0 < NPROJ ? n0 + 16 : 1536); nvalid = n0 < NPROJ ? 64 : (n0 == NPROJ ? 16 : 0);
            src_ = p.w_in + (size_t)l * D * D_IN_PROJ; lds_ = D_IN_PROJ; k0 = kt * 64; ncol0 = oc; dst = p.winT + ((size_t)l * NPAD + n0) * D; ldk = D; }
        else if (item < PT_WIN + PT_WOUT) { type = 0; const int it = item - PT_WIN; l = it / ((D / 64) * (DMIX / 64)); const int r = it % ((D / 64) * (DMIX / 64)); nt = r / (DMIX / 64); kt = r % (DMIX / 64);
            src_ = p.w_out + (size_t)l * DMIX * D; lds_ = D; k0 = kt * 64; ncol0 = nt * 64; dst = p.woutT + ((size_t)l * D + nt * 64) * DMIX; ldk = DMIX; }
        else if (item < PT_WIN + PT_WOUT + PT_SQ) { type = 0; const int it = item - PT_WIN - PT_WOUT; l = it / 32; const int which = (it >> 4) & 1, r = it & 15; nt = r >> 2; kt = r & 3;
            src_ = (which ? p.s5_glu_w : p.ft_w) + (size_t)l * 65536; lds_ = 256; k0 = kt * 64; ncol0 = nt * 64; dst = (which ? p.gluT : p.ftwT) + (size_t)l * 65536 + (size_t)nt * 64 * 256; ldk = 256; }
        else { type = 1; const int it = item - PT_WIN - PT_WOUT - PT_SQ; l = it / (3 * D / 64); nt = it % (3 * D / 64); }
        BLOCK_SYNC();
        if (type == 0) {
            const int cq = (tid & 15) * 4;
#pragma unroll
            for (int i = 0; i < 4; ++i) {
                const int kk = (tid >> 4) + 16 * i;
                f32x4 v = (f32x4){0.f, 0.f, 0.f, 0.f};
                if (cq < nvalid) v = *(const f32x4*)(src_ + (size_t)(k0 + kk) * lds_ + ncol0 + cq);
                T[kk * 65 + cq] = v.x; T[kk * 65 + cq + 1] = v.y; T[kk * 65 + cq + 2] = v.z; T[kk * 65 + cq + 3] = v.w;
            }
        } else {
            const int col = tid & 63, kg = tid >> 6; const int j = nt * 64 + col;
            float a0 = 0.f, a1 = 0.f, a2 = 0.f;
            const float* w = p.w_ada + ((size_t)l * D + kg * (D / 4)) * 3 * D + j;
            for (int k = 0; k < D / 4; ++k) { const float wv = w[(size_t)k * 3 * D]; const int kk = kg * (D / 4) + k; a0 += sc[kk] * wv; a1 += sc[D + kk] * wv; if (NCOND > 2) a2 += sc[2 * D + kk] * wv; }
            T[(kg * 3 + 0) * 65 + col] = a0; T[(kg * 3 + 1) * 65 + col] = a1; T[(kg * 3 + 2) * 65 + col] = a2;
        }
        BLOCK_SYNC();
        if (!ghost) {
            if (type == 0) {
                const int n = tid >> 2, kc = (tid & 3) * 16;
                u32x4 w0, w1;
                w0.x = pk2(T[(kc + 0) * 65 + n], T[(kc + 1) * 65 + n]); w0.y = pk2(T[(kc + 2) * 65 + n], T[(kc + 3) * 65 + n]);
                w0.z = pk2(T[(kc + 4) * 65 + n], T[(kc + 5) * 65 + n]); w0.w = pk2(T[(kc + 6) * 65 + n], T[(kc + 7) * 65 + n]);
                w1.x = pk2(T[(kc + 8) * 65 + n], T[(kc + 9) * 65 + n]); w1.y = pk2(T[(kc + 10) * 65 + n], T[(kc + 11) * 65 + n]);
                w1.z = pk2(T[(kc + 12) * 65 + n], T[(kc + 13) * 65 + n]); w1.w = pk2(T[(kc + 14) * 65 + n], T[(kc + 15) * 65 + n]);
                bf16* d = dst + (size_t)n * ldk + k0 + kc;
                *(u32x4*)d = w0; *(u32x4*)(d + 8) = w1;
            } else if (tid < 64 * NCOND) {
                const int col = tid & 63, cc = tid >> 6; const int j = nt * 64 + col;
                const float v = T[(0 * 3 + cc) * 65 + col] + T[(1 * 3 + cc) * 65 + col] + T[(2 * 3 + cc) * 65 + col] + T[(3 * 3 + cc) * 65 + col];
                p.ada[((size_t)l * NCOND + cc) * 3 * D + j] = v + p.b_ada[(size_t)l * 3 * D + j];
            }
        }
    }
}

__device__ __forceinline__ void norm_mod_body(const Params& p, int l, const Ctx& c) {
    const int lane = c.lane, wave = c.wave;
    for (int tok0 = c.vb * 4; tok0 < NTOK; tok0 += c.nvb * 4) {
        const int tok = tok0 + wave;
        const float* xr = xrow_in(p, l, tok);
        float v[D / 64]; float ss = 0.f;
#pragma unroll
        for (int j = 0; j < D / 64; ++j) { v[j] = xr[j * 64 + lane]; ss += v[j] * v[j]; }
#pragma unroll
        for (int o = 1; o < 64; o <<= 1) ss += __shfl_xor(ss, o);
        const float rs = 1.0f / sqrtf(ss / (float)D + EPS);
        const float* ad = p.ada + ((size_t)l * NCOND + cond_of(tok)) * 3 * D;
        const float* ng = p.norm_g + (size_t)l * D;
#pragma unroll
        for (int j = 0; j < D / 64; ++j) { int i = j * 64 + lane; float h = v[j] * rs * ng[i] * (1.0f + ad[D + i]) + ad[i]; p.hbuf[(size_t)tok * D + i] = f2bf(h); }
    }
}

constexpr int GLD = 72;
template <int TOK> constexpr int gemm_lds() { return 2 * (128 + TOK) * GLD * 2; }
constexpr int GEMM_LDS = gemm_lds<128>();
constexpr int OUT_TOK = (NTOK % 96 == 0) ? 96 : 128;
static_assert(GEMM_LDS <= HALF_LDS, "GEMM LDS");
template <int TOK, class Epi>
__device__ __forceinline__ void gemm_body(const bf16* X, int ldx, const bf16* W, int ldw, int M, int N, int K, const Epi& epi, const Ctx& c) {
    constexpr int NT = TOK / 32;
    constexpr int XCH = TOK * 8 / 256;
    bf16* const lds = (bf16*)c.smem;
    constexpr int STG = (128 + TOK) * GLD, XOFF = 128 * GLD;
    const int tid = c.tid, lane = c.lane, wave = c.wave, wr = wave >> 1, wc = wave & 1;
    const int nM = M / TOK, nN = N / 128, ntiles = nM * nN;
    for (int _k = 0, _n = loop_iters(ntiles, c); _k < _n; ++_k) {
        int tile = c.vb + _k * c.nvb; const bool ghost = tile >= ntiles; if (ghost) tile = ntiles - 1;
        const int tm = tile / nN, tn = tile % nN;
        const bf16* Xg = X + (size_t)tm * TOK * ldx; const bf16* Wg = W + (size_t)tn * 128 * ldw;
        f32x4 acc[4][NT]; zero_acc(acc);
        u32x4 rw[4], rx[XCH];
        const int r0 = tid >> 3, ck = tid & 7;
#pragma unroll
        for (int i = 0; i < 4; ++i) rw[i] = *(const u32x4*)(Wg + (size_t)(r0 + 32 * i) * ldw + ck * 8);
#pragma unroll
        for (int i = 0; i < XCH; ++i) rx[i] = *(const u32x4*)(Xg + (size_t)(r0 + 32 * i) * ldx + ck * 8);
        BLOCK_SYNC();
#pragma unroll
        for (int i = 0; i < 4; ++i) *(u32x4*)(lds + (r0 + 32 * i) * GLD + ck * 8) = rw[i];
#pragma unroll
        for (int i = 0; i < XCH; ++i) *(u32x4*)(lds + XOFF + (r0 + 32 * i) * GLD + ck * 8) = rx[i];
        BLOCK_SYNC();
        int cur = 0;
        for (int k0 = 0; k0 < K; k0 += 64) {
            const bool more = k0 + 64 < K;
            if (more) {
#pragma unroll
                for (int i = 0; i < 4; ++i) rw[i] = *(const u32x4*)(Wg + (size_t)(r0 + 32 * i) * ldw + k0 + 64 + ck * 8);
#pragma unroll
                for (int i = 0; i < XCH; ++i) rx[i] = *(const u32x4*)(Xg + (size_t)(r0 + 32 * i) * ldx + k0 + 64 + ck * 8);
            }
            mma_tiles<4, NT>(acc, lds + cur * STG + wr * 64 * GLD, GLD, lds + cur * STG + XOFF + wc * (TOK / 2) * GLD, GLD, 64, lane);
            if (more) {
#pragma unroll
                for (int i = 0; i < 4; ++i) *(u32x4*)(lds + (cur ^ 1) * STG + (r0 + 32 * i) * GLD + ck * 8) = rw[i];
#pragma unroll
                for (int i = 0; i < XCH; ++i) *(u32x4*)(lds + (cur ^ 1) * STG + XOFF + (r0 + 32 * i) * GLD + ck * 8) = rx[i];
            }
            BLOCK_SYNC();
            cur ^= 1;
        }
        if (!ghost) {
#pragma unroll
            for (int mt = 0; mt < 4; ++mt)
#pragma unroll
                for (int nt = 0; nt < NT; ++nt) {
                    const int col0 = tn * 128 + wr * 64 + mt * 16 + (lane >> 4) * 4, row = tm * TOK + wc * (TOK / 2) + nt * 16 + (lane & 15);
                    epi(row, col0, acc[mt][nt]);
                }
        }
    }
}
__device__ __forceinline__ u32x2 pack4(const f32x4 v) { u32x2 w; w.x = pk2(v[0], v[1]); w.y = pk2(v[2], v[3]); return w; }
__device__ __forceinline__ f32x4 unpack4(const u32x2 w) { return (f32x4){bf2f((bf16)(w.x & 0xffff)), bf2f((bf16)(w.x >> 16)), bf2f((bf16)(w.y & 0xffff)), bf2f((bf16)(w.y >> 16))}; }
struct EpiProj {
    bf16* proj; float* gates;
    __device__ __forceinline__ void operator()(int row, int col0, const f32x4 v) const {
        if (col0 < NPROJ) *(u32x2*)(proj + (size_t)row * NPROJ + col0) = pack4(v);
        else if (col0 < NPROJ + 16) *(f32x4*)(gates + (size_t)row * 16 + (col0 - NPROJ)) = v;
    }
};
struct EpiOut {
    const Params* p; int l;
    __device__ __forceinline__ void operator()(int row, int col0, const f32x4 v) const {
        const f32x4 g = *(const f32x4*)(p->ada + ((size_t)l * NCOND + cond_of(row)) * 3 * D + 2 * D + col0);
        const f32x4 xi = *(const f32x4*)(xrow_in(*p, l, row) + col0);
        *(f32x4*)(p->out + (size_t)row * D + col0) = xi + g * v;
    }
};
struct EpiGlu {
    const Params* p; int l;
    __device__ __forceinline__ void operator()(int row, int col0, const f32x4 v) const {
        const f32x4 y = unpack4(*(const u32x2*)(p->ybuf + (size_t)row * 256 + col0));
        const f32x4 z = unpack4(*(const u32x2*)(p->proj + (size_t)row * NPROJ + SZ + col0));
        const f32x4 bb = *(const f32x4*)(p->s5_glu_b + l * 256 + col0);
        f32x4 o;
#pragma unroll
        for (int i = 0; i < 4; ++i) o[i] = y[i] * sigmoid_f(v[i] + bb[i]) * silu_f(z[i]);
        *(u32x2*)(p->mix + (size_t)row * DMIX + 512 + col0) = pack4(o);
    }
};
struct EpiFt {
    const Params* p;
    __device__ __forceinline__ void operator()(int row, int col0, const f32x4 v) const {
        const f32x4 z = unpack4(*(const u32x2*)(p->proj + (size_t)row * NPROJ + FZ + col0));
        f32x4 o;
#pragma unroll
        for (int i = 0; i < 4; ++i) o[i] = v[i] * silu_f(z[i]);
        *(u32x2*)(p->mix + (size_t)row * DMIX + 768 + col0) = pack4(o);
    }
};

constexpr int POOL_LDS = 64 * 72 * 2 + 64 * 66 * 4;
template <int W>
__device__ __forceinline__ void pool_item(const Params& p, int l, int ch, int g, bf16* Ps, float* Vs, int tid, int lane, int wave) {
    constexpr int HW = W / 2;
    const bool lat = ch >= NCH_CTX;
    const int c2 = tid & 31, jg = tid >> 5;
    const int cofs = PU + g * 64 + 2 * c2;
    BLOCK_SYNC();
    if (!lat) {
        const int seq = ch / CPS_CTX, ci = ch % CPS_CTX; const size_t tok_seq = (size_t)seq * SEQ;
#pragma unroll
        for (int jj = 0; jj < 8; ++jj) {
            const int j = jg * 8 + jj, t = ci * 64 + j;
            int lo = t - HW; if (lo < 0) lo = 0; int hi = t - HW + W; if (hi > SEQ) hi = SEQ;
            float s0 = 0.f, s1 = 0.f;
#pragma unroll
            for (int k = 0; k < W; ++k) {
                int tt = t - HW + k; const bool ok = tt >= 0 && tt < SEQ; tt = tt < 0 ? 0 : (tt >= SEQ ? SEQ - 1 : tt);
                const unsigned u = *(const unsigned*)(p.proj + (tok_seq + tt) * NPROJ + cofs);
                s0 += ok ? bf2f((bf16)(u & 0xffff)) : 0.f; s1 += ok ? bf2f((bf16)(u >> 16)) : 0.f;
            }
            const unsigned uc = *(const unsigned*)(p.proj + (tok_seq + t) * NPROJ + cofs);
            const float inv = 1.0f / (float)(hi - lo);
            *(unsigned*)(Ps + j * 72 + 2 * c2) = pk2(s0 * inv - bf2f((bf16)(uc & 0xffff)), s1 * inv - bf2f((bf16)(uc >> 16)));
        }
        BLOCK_SYNC(); BLOCK_SYNC();
    } else {
        const int b = (ch - NCH_CTX) / 64, r = (ch - NCH_CTX) % 64; const size_t tok_b = (size_t)NCTX + (size_t)b * DEC_SEQ;
        int lor = r - HW; if (lor < 0) lor = 0; int hir = r - HW + W; if (hir > 64) hir = 64;
        const float invr = 1.0f / (float)(hir - lor);
#pragma unroll
        for (int jj = 0; jj < 8; ++jj) {
            const int col = jg * 8 + jj; float s0 = 0.f, s1 = 0.f;
#pragma unroll
            for (int k = 0; k < W; ++k) {
                int rr = r - HW + k; const bool ok = rr >= 0 && rr < 64; rr = rr < 0 ? 0 : (rr > 63 ? 63 : rr);
                const unsigned u = *(const unsigned*)(p.proj + (tok_b + rr * 64 + col) * NPROJ + cofs);
                s0 += ok ? bf2f((bf16)(u & 0xffff)) : 0.f; s1 += ok ? bf2f((bf16)(u >> 16)) : 0.f;
            }
            Vs[col * 66 + 2 * c2] = s0 * invr; Vs[col * 66 + 2 * c2 + 1] = s1 * invr;
        }
        BLOCK_SYNC();
#pragma unroll
        for (int jj = 0; jj < 8; ++jj) {
            const int col = jg * 8 + jj;
            int lo = col - HW; if (lo < 0) lo = 0; int hi = col - HW + W; if (hi > 64) hi = 64;
            float s0 = 0.f, s1 = 0.f;
            for (int cc = lo; cc < hi; ++cc) { s0 += Vs[cc * 66 + 2 * c2]; s1 += Vs[cc * 66 + 2 * c2 + 1]; }
            const unsigned uc = *(const unsigned*)(p.proj + (tok_b + r * 64 + col) * NPROJ + cofs);
            const float inv = 1.0f / (float)(hi - lo);
            *(unsigned*)(Ps + col * 72 + 2 * c2) = pk2(s0 * inv - bf2f((bf16)(uc & 0xffff)), s1 * inv - bf2f((bf16)(uc >> 16)));
        }
        BLOCK_SYNC();
    }
    {
        f32x4 acc[4][1]; zero_acc(acc);
        mma_tiles<4, 1>(acc, p.poolwT + ((size_t)l * 4 + g) * 4096, 64, Ps + wave * 16 * 72, 72, 64, lane);
        const size_t tok = (size_t)ch * 64 + wave * 16 + (lane & 15);
#pragma unroll
        for (int mt = 0; mt < 4; ++mt) {
            const int d0 = g * 64 + mt * 16 + (lane >> 4) * 4;
            const f32x4 sc = *(const f32x4*)(p.pool_scale + l * 256 + d0);
            const f32x4 z = unpack4(*(const u32x2*)(p.proj + tok * NPROJ + PZ + d0));
            f32x4 o;
#pragma unroll
            for (int i = 0; i < 4; ++i) o[i] = acc[mt][0][i] * sc[i] * silu_f(z[i]);
            *(u32x2*)(p.mix + tok * DMIX + d0) = pack4(o);
        }
    }
}
__device__ __forceinline__ void pool_body(const Params& p, int l, const Ctx& c) {
    bf16* Ps = (bf16*)c.smem;
    float* Vs = (float*)(c.smem + 64 * 72 * 2);
    const int wave = c.wave;
    for (int _k = 0, _n = loop_iters(NCH * 4, c); _k < _n; ++_k) {
        int item = c.vb + _k * c.nvb; if (item >= NCH * 4) item = NCH * 4 - 1;
        int tid = c.tid; LAUNDER_V(tid); const int lane = tid & 63;
        const int ch = item >> 2, g = item & 3;
        switch (g) {
        case 0: pool_item<2>(p, l, ch, g, Ps, Vs, tid, lane, wave); break;
        case 1: pool_item<4>(p, l, ch, g, Ps, Vs, tid, lane, wave); break;
        case 2: pool_item<8>(p, l, ch, g, Ps, Vs, tid, lane, wave); break;
        default: pool_item<16>(p, l, ch, g, Ps, Vs, tid, lane, wave); break;
        }
    }
}

constexpr int FTC_ULD = 72, FTC_GLD = SEQ + 8;
constexpr int FTC_LDS = SEQ * FTC_ULD * 2 + 64 * FTC_GLD * 2;
__device__ __forceinline__ void ft_ctx_body(const Params& p, const Ctx& c) {
    bf16* Us = (bf16*)c.smem;
    bf16* GT = Us + SEQ * FTC_ULD;
    const int tid = c.tid, lane = c.lane, wave = c.wave;
    constexpr int MTW = SEQ / 64;
    constexpr int KQ = SEQ / 64;
    for (int _k = 0, _n = loop_iters(BATCH * 4 * KQ, c); _k < _n; ++_k) {
        int item = c.vb + _k * c.nvb; if (item >= (BATCH * 4 * KQ)) item = (BATCH * 4 * KQ) - 1;
        const int kq = item % KQ, bh = item / KQ, b = bh >> 2, h = bh & 3;
        BLOCK_SYNC();
        for (int i = tid; i < SEQ * 8; i += 256) { const int t = i >> 3, ck = i & 7; *(u32x4*)(Us + t * FTC_ULD + ck * 8) = *(const u32x4*)(p.proj + ((size_t)b * SEQ + t) * NPROJ + FU + h * 64 + ck * 8); }
        BLOCK_SYNC();
        f32x4 facc[4][1]; zero_acc(facc);
        const int kt0 = kq * 64 + wave * 16;
        for (int part = 0; part < 2; ++part) {
#pragma unroll 1
            for (int nh = 0; nh < 2; ++nh) {
                f32x4 g[MTW][2]; zero_acc(g);
                mma_tiles<MTW, 2>(g, Us + wave * (SEQ / 4) * FTC_ULD, FTC_ULD, p.tabDc + (part * 64 + nh * 32) * 64, 64, 64, lane);
#pragma unroll
                for (int mt = 0; mt < MTW; ++mt)
#pragma unroll
                    for (int nt = 0; nt < 2; ++nt) {
                        const int kc = nh * 32 + nt * 16 + (lane & 15), t0 = wave * (SEQ / 4) + mt * 16 + (lane >> 4) * 4;
                        *(u32x2*)(GT + kc * FTC_GLD + t0) = pack4(g[mt][nt]);
                    }
            }
            BLOCK_SYNC();
            mma_tiles<4, 1>(facc, GT, FTC_GLD, p.tabT + (size_t)kt0 * 2 * SEQ + part * SEQ, 2 * SEQ, SEQ, lane);
            BLOCK_SYNC();
        }
        const float sc = 1.0f / sqrtf((float)SEQ * 64.f);
#pragma unroll
        for (int mt = 0; mt < 4; ++mt) {
            const int kt = kt0 + (lane & 15), kc0 = mt * 16 + (lane >> 4) * 4;
            *(u32x2*)(p.fbuf + ((size_t)b * SEQ + kt) * 256 + h * 64 + kc0) = pack4(facc[mt][0] * sc);
        }
    }
}

constexpr int FTA_XS = 0, FTA_Z1T = 64 * 72 * 2, FTA_R = FTA_Z1T + 64 * 136 * 2, FTA_E = FTA_R + 128 * 72 * 2;
constexpr int FTA_LDS = FTA_E + 128 * 136 * 2;
static_assert(FTA_LDS <= HALF_LDS, "ft_latA LDS");
__device__ __forceinline__ void ft_latA_body(const Params& p, const Ctx& c) {
    bf16* Xs = (bf16*)(c.smem + FTA_XS);
    bf16* Z1T = (bf16*)(c.smem + FTA_Z1T);
    bf16* R = (bf16*)(c.smem + FTA_R);
    bf16* Es = (bf16*)(c.smem + FTA_E);
    const int tid = c.tid, lane = c.lane, wave = c.wave;
    for (int _k = 0, _n = loop_iters(DEC_BATCH * 64, c); _k < _n; ++_k) {
        int item = c.vb + _k * c.nvb; if (item >= (DEC_BATCH * 64)) item = (DEC_BATCH * 64) - 1;
        const int b = item >> 6, t2 = item & 63;
        BLOCK_SYNC();
        for (int i = tid; i < 128 * 16; i += 256) { const int r = i >> 4, ck = i & 15; *(u32x4*)(Es + r * 136 + ck * 8) = *(const u32x4*)(p.tabE + r * 128 + ck * 8); }
        for (int h = 0; h < 4; ++h) {
            BLOCK_SYNC();
            for (int i = tid; i < 64 * 8; i += 256) { const int t1 = i >> 3, ck = i & 7; *(u32x4*)(Xs + t1 * 72 + ck * 8) = *(const u32x4*)(p.proj + ((size_t)NCTX + (size_t)b * DEC_SEQ + t1 * 64 + t2) * NPROJ + FU + h * 64 + ck * 8); }
            for (int i = tid; i < 128 * 8; i += 256) { const int r = i >> 3, ck = i & 7; *(u32x4*)(R + r * 72 + ck * 8) = *(const u32x4*)(p.tabDc + r * 64 + ck * 8); }
            BLOCK_SYNC();
            {
                f32x4 a[4][2]; zero_acc(a);
                mma_tiles<4, 2>(a, Xs, 72, R + wave * 32 * 72, 72, 64, lane);
#pragma unroll
                for (int mt = 0; mt < 4; ++mt)
#pragma unroll
                    for (int nt = 0; nt < 2; ++nt) {
                        const int n = wave * 32 + nt * 16 + (lane & 15), part = n >> 6, kc = n & 63, t10 = mt * 16 + (lane >> 4) * 4;
                        *(u32x2*)(Z1T + kc * 136 + part * 64 + t10) = pack4(a[mt][nt]);
                    }
            }
            BLOCK_SYNC();
            {
                f32x4 z[1][8]; zero_acc(z);
                mma_tiles<1, 8>(z, Z1T + wave * 16 * 136, 136, Es, 136, 128, lane);
#pragma unroll
                for (int nt = 0; nt < 4; ++nt) {
                    const int k1 = nt * 16 + (lane & 15); const int m = (t2 * k1) & 4095;
                    const float ang = 6.283185307179586f * (float)m / 4096.f; const float tc = cosf(ang), ts = sinf(ang);
                    const int kc0 = wave * 16 + (lane >> 4) * 4;
                    f32x4 re, im;
#pragma unroll
                    for (int r = 0; r < 4; ++r) { const float a = z[0][nt][r], bb = z[0][nt + 4][r]; re[r] = a * tc + bb * ts; im[r] = bb * tc - a * ts; }
                    *(u32x2*)(R + k1 * 72 + kc0) = pack4(re); *(u32x2*)(R + (64 + k1) * 72 + kc0) = pack4(im);
                }
            }
            BLOCK_SYNC();
#pragma unroll
            for (int it = 0; it < 4; ++it) {
                const int i = tid + 256 * it, row = i >> 3, ck = i & 7, part = row >> 6, k1 = row & 63;
                *(u32x4*)(p.Zg + ((((size_t)b * 64 + k1) * 128 + part * 64 + t2) * 256) + h * 64 + ck * 8) = *(const u32x4*)(R + row * 72 + ck * 8);
            }
        }
    }
}

constexpr int FTB_LDS = 256 * 136 * 2;
__device__ __forceinline__ void ft_latB_body(const Params& p, const Ctx& c) {
    bf16* Zs = (bf16*)c.smem;
    const int lane = c.lane, wave = c.wave;
    for (int _k = 0, _n = loop_iters(DEC_BATCH * 64, c); _k < _n; ++_k) {
        int item = c.vb + _k * c.nvb; if (item >= (DEC_BATCH * 64)) item = (DEC_BATCH * 64) - 1;
        const int b = item >> 6, k1 = item & 63;
        const bf16* zg = p.Zg + ((size_t)b * 64 + k1) * 128 * 256;
        BLOCK_SYNC();
        {
            const int k = (wave & 1) * 64 + lane;
#pragma unroll 4
            for (int it = 0; it < 16; ++it) {
                const int n8 = (wave >> 1) * 16 + it;
                const u32x4 v = *(const u32x4*)(zg + (size_t)k * 256 + n8 * 8);
                bf16* dst = Zs + (n8 * 8) * 136 + k;
                dst[0 * 136] = (bf16)(v.x & 0xffff); dst[1 * 136] = (bf16)(v.x >> 16); dst[2 * 136] = (bf16)(v.y & 0xffff); dst[3 * 136] = (bf16)(v.y >> 16);
                dst[4 * 136] = (bf16)(v.z & 0xffff); dst[5 * 136] = (bf16)(v.z >> 16); dst[6 * 136] = (bf16)(v.w & 0xffff); dst[7 * 136] = (bf16)(v.w >> 16);
            }
        }
        BLOCK_SYNC();
        f32x4 acc[4][4]; zero_acc(acc);
        mma_tiles<4, 4>(acc, Zs + wave * 64 * 136, 136, p.tabE, 128, 128, lane);
#pragma unroll
        for (int mt = 0; mt < 4; ++mt)
#pragma unroll
            for (int nt = 0; nt < 4; ++nt) {
                const int k2 = nt * 16 + (lane & 15), n0 = wave * 64 + mt * 16 + (lane >> 4) * 4;
                *(u32x2*)(p.fbuf + ((size_t)NCTX + (size_t)b * DEC_SEQ + k1 + 64 * k2) * 256 + n0) = pack4(acc[mt][nt] * (1.0f / 512.f));
            }
    }
}

template <bool STORE>
__device__ __forceinline__ void s5_scan_wave(const Params& p, int l, int ch, int g, int d, int lane, float (&sr)[2], float (&si)[2], bf16* Ss) {
    const int h = lane >> 5, n0 = lane & 31;
    const size_t ldg = ((size_t)l * 2 + d) * 16 + g;
    float ar[2], ai[2];
#pragma unroll
    for (int j = 0; j < 2; ++j) { const size_t pi = ldg * 64 + j * 32 + n0; ar[j] = p.abar[2 * pi]; ai[j] = p.abar[2 * pi + 1]; }
    const bf16* Bt = p.bbarT + ldg * 128 * 16;
    const bf16* U0 = p.proj + ((size_t)ch * 64 + (d ? 63 : 0)) * NPROJ + SU + g * 16;
    const int ldu = d ? -NPROJ : NPROJ;
#pragma unroll
    for (int mt = 0; mt < 2; ++mt) {
        f32x16 bu[4];
#pragma unroll
        for (int nt = 0; nt < 4; ++nt) { bu[nt] = (f32x16)(0.f); mma32(bu[nt], U0 + mt * 32 * ldu, ldu, Bt + nt * 32 * 16, 16, lane); }
#pragma unroll
        for (int k = 0; k < 4; ++k)
#pragma unroll
            for (int ph = 0; ph < 2; ++ph) {
#pragma unroll
                for (int i = 0; i < 4; ++i) {
                    const int r = 4 * k + i;
#pragma unroll
                    for (int j = 0; j < 2; ++j) {
                        const float nr = ar[j] * sr[j] - ai[j] * si[j] + bu[j][r], ni = ar[j] * si[j] + ai[j] * sr[j] + bu[2 + j][r];
                        sr[j] = nr; si[j] = ni;
                    }
                    if (STORE && h == ph) {
                        const int row = mt * 32 + 8 * k + 4 * ph + i, t = d ? 63 - row : row;
#pragma unroll
                        for (int j = 0; j < 2; ++j) { Ss[t * 264 + d * 128 + j * 32 + n0] = f2bf(sr[j]); Ss[t * 264 + d * 128 + 64 + j * 32 + n0] = f2bf(si[j]); }
                    }
                }
#pragma unroll
                for (int j = 0; j < 2; ++j) { sr[j] = swap_halves(sr[j], lane); si[j] = swap_halves(si[j], lane); }
            }
    }
}
constexpr int S5P1_LDS = 0;
__device__ __forceinline__ void s5_pass1_body(const Params& p, int l, const Ctx& c) {
    const int lane = c.lane, wave = c.wave;
    for (int it0 = c.vb * 4; it0 < NCH * 32; it0 += c.nvb * 4) {
        const int item = it0 + wave; const int d = item & 1, g = (item >> 1) & 15, ch = item >> 5;
        float sr[2] = {0.f, 0.f}, si[2] = {0.f, 0.f};
        s5_scan_wave<false>(p, l, ch, g, d, lane, sr, si, nullptr);
        if (lane < 32) {
            float* E = p.s5E + (((size_t)ch * 16 + g) * 2 + d) * 128;
            E[lane] = sr[0]; E[32 + lane] = sr[1]; E[64 + lane] = si[0]; E[96 + lane] = si[1];
        }
    }
}
__device__ __forceinline__ void s5_carry_body(const Params& p, int l, const Ctx& c) {
    for (int i = c.vb * 256 + c.tid; i < NSEQ * 16 * 2 * 64; i += c.nvb * 256) {
        const int n = i & 63, d = (i >> 6) & 1, g = (i >> 7) & 15, seq = i >> 11;
        const bool lat = seq >= BATCH; const int cps = lat ? CPS_LAT : CPS_CTX; const int ch0 = lat ? NCH_CTX + (seq - BATCH) * CPS_LAT : seq * CPS_CTX;
        const size_t pi = (((size_t)l * 2 + d) * 16 + g) * 64 + n;
        const float ar = p.abar64[2 * pi], ai = p.abar64[2 * pi + 1];
        float sr = 0.f, si = 0.f;
        if (lat) { const size_t o = ((((size_t)(seq - BATCH) * DEPTH + l) * 2 + d) * 2) * 1024 + g * 64 + n; sr = p.state_s5[o]; si = p.state_s5[o + 1024]; }
        for (int q = 0; q < cps; ++q) {
            const int ch = ch0 + (d ? cps - 1 - q : q);
            const size_t e = (((size_t)ch * 16 + g) * 2 + d) * 128 + n;
            p.s5S[e] = sr; p.s5S[e + 64] = si;
            const float er = p.s5E[e], ei = p.s5E[e + 64];
            const float nr = ar * sr - ai * si + er, ni = ar * si + ai * sr + ei; sr = nr; si = ni;
        }
        if (!lat) { const size_t o = OUT_S5 + ((((size_t)seq * DEPTH + l) * 2 + d) * 2) * 1024 + g * 64 + n; p.out[o] = sr; p.out[o + 1024] = si; }
    }
}
constexpr int S5P3_LDS = 2 * 64 * 264 * 2;
__device__ __forceinline__ void s5_pass3_body(const Params& p, int l, const Ctx& c) {
    const int lane = c.lane, wave = c.wave, il = wave >> 1, d = wave & 1;
    bf16* Ss = (bf16*)c.smem + il * 64 * 264;
    for (int _k = 0, _n = loop_iters(NCH * 8, c); _k < _n; ++_k) {
        int grp = c.vb + _k * c.nvb; if (grp >= (NCH * 8)) grp = (NCH * 8) - 1;
        const int item = grp * 2 + il; const int g = item & 15, ch = item >> 4;
        BLOCK_SYNC();
        const size_t e = (((size_t)ch * 16 + g) * 2 + d) * 128;
        float sr[2] = {p.s5S[e + (lane & 31)], p.s5S[e + 32 + (lane & 31)]}, si[2] = {p.s5S[e + 64 + (lane & 31)], p.s5S[e + 96 + (lane & 31)]};
        s5_scan_wave<true>(p, l, ch, g, d, lane, sr, si, Ss);
        BLOCK_SYNC();
        f32x4 acc[2][1]; zero_acc(acc);
        mma_tiles<2, 1>(acc, Ss + d * 32 * 264, 264, p.Cmat + ((size_t)l * 16 + g) * 4096, 256, 256, lane);
#pragma unroll
        for (int mt = 0; mt < 2; ++mt)
#pragma unroll
            for (int r = 0; r < 4; ++r) {
                const int t = d * 32 + mt * 16 + (lane >> 4) * 4 + r, pp = lane & 15;
                const float u = bf2f(p.proj[((size_t)ch * 64 + t) * NPROJ + SU + g * 16 + pp]);
                const float y = acc[mt][0][r] + p.s5_d[l * 256 + g * 16 + pp] * u;
                p.ybuf[((size_t)ch * 64 + t) * 256 + g * 16 + pp] = f2bf(gelu_f(y));
            }
    }
}

constexpr int DN_STG = 0;
constexpr int DN_S1 = 0, DN_S2 = 18432;
constexpr int DN_AB = 36864;
constexpr int DN_QB = DN_AB + 9216, DN_KB = DN_QB + 9216, DN_VB = DN_KB + 9216;
constexpr int DN_SM = DN_VB + 8192;
constexpr int DN1_LDS = DN_SM + 5 * 64 * 4;
static_assert(DN1_LDS <= HALF_LDS, "DN1 LDS");
__device__ __forceinline__ void dn_d1_body(const Params& p, int l, const Ctx& c) {
    char* smem = c.smem;
    float* stq = (float*)(smem + DN_STG); float* stk = stq + 64 * 65;
    bf16* S1 = (bf16*)(smem + DN_S1); bf16* S2 = (bf16*)(smem + DN_S2);
    bf16* Ab = (bf16*)(smem + DN_AB); float* Rb = (float*)(smem + DN_VB);
    bf16* Qb = (bf16*)(smem + DN_QB); bf16* Kb = (bf16*)(smem + DN_KB); bf16* Vb = (bf16*)(smem + DN_VB);
    float* rq = (float*)(smem + DN_SM); float* rk = rq + 64; float* gs = rk + 64; float* bs = gs + 64; float* gcs = bs + 64;
    const int wave = c.wave;
    for (int _k = 0, _n = loop_iters(NCH * 8, c); _k < _n; ++_k) {
        int item = c.vb + _k * c.nvb; if (item >= (NCH * 8)) item = (NCH * 8) - 1;
        int tid = c.tid; LAUNDER_V(tid); const int lane = tid & 63;
        const int d = item & 1, h = (item >> 1) & 3, ch = item >> 3;
        const bool lat = ch >= NCH_CTX;
        const int cps = lat ? CPS_LAT : CPS_CTX; const int ci = lat ? (ch - NCH_CTX) % CPS_LAT : ch % CPS_CTX;
        const int lseq = cps * 64; const size_t tok_seq = (size_t)(ch - ci) * 64;
        BLOCK_SYNC();
        {
            const int jt = tid >> 2, cq = tid & 3, tau = d ? 63 - jt : jt;
            const int pos0 = ci * 64 + jt - 2;
#pragma unroll
            for (int arr = 0; arr < 3; ++arr) {
                float ss = 0.f; float o[16];
#pragma unroll
                for (int hf = 0; hf < 2; ++hf) {
                    const int chn = arr * 256 + h * 64 + cq * 16 + hf * 8;
                    float acc8[8];
#pragma unroll
                    for (int e = 0; e < 8; ++e) acc8[e] = 0.f;
#pragma unroll
                    for (int j = 0; j < 5; ++j) {
                        const int pos = pos0 + j; const bool ok = pos >= 0 && pos < lseq; const int pc = pos < 0 ? 0 : (pos >= lseq ? lseq - 1 : pos);
                        const u32x4 xv = *(const u32x4*)(p.proj + (tok_seq + pc) * NPROJ + QKV + chn);
                        const f32x4 w0 = *(const f32x4*)(p.dn_conv + ((size_t)l * 5 + j) * 768 + chn), w1 = *(const f32x4*)(p.dn_conv + ((size_t)l * 5 + j) * 768 + chn + 4);
                        const float m = ok ? 1.f : 0.f;
                        acc8[0] += m * w0[0] * bf2f((bf16)(xv.x & 0xffff)); acc8[1] += m * w0[1] * bf2f((bf16)(xv.x >> 16));
                        acc8[2] += m * w0[2] * bf2f((bf16)(xv.y & 0xffff)); acc8[3] += m * w0[3] * bf2f((bf16)(xv.y >> 16));
                        acc8[4] += m * w1[0] * bf2f((bf16)(xv.z & 0xffff)); acc8[5] += m * w1[1] * bf2f((bf16)(xv.z >> 16));
                        acc8[6] += m * w1[2] * bf2f((bf16)(xv.w & 0xffff)); acc8[7] += m * w1[3] * bf2f((bf16)(xv.w >> 16));
                    }
#pragma unroll
                    for (int e = 0; e < 8; ++e) { const float s = silu_f(acc8[e]); o[hf * 8 + e] = s; ss += s * s; }
                }
                float sc = 1.f;
                if (arr < 2) { ss += __shfl_xor(ss, 1); ss += __shfl_xor(ss, 2); sc = 1.0f / sqrtf(ss + EPS); }
                bf16* dst = arr == 0 ? Qb + tau * 72 + cq * 16 : (arr == 1 ? Kb + tau * 72 + cq * 16 : Vb + tau * 64 + cq * 16);
                u32x4 w0, w1;
                w0.x = pk2(o[0] * sc, o[1] * sc); w0.y = pk2(o[2] * sc, o[3] * sc); w0.z = pk2(o[4] * sc, o[5] * sc); w0.w = pk2(o[6] * sc, o[7] * sc);
                w1.x = pk2(o[8] * sc, o[9] * sc); w1.y = pk2(o[10] * sc, o[11] * sc); w1.z = pk2(o[12] * sc, o[13] * sc); w1.w = pk2(o[14] * sc, o[15] * sc);
                *(u32x4*)dst = w0; *(u32x4*)(dst + 8) = w1;
            }
            if (wave == 0) {
                const int tg = lane; const size_t tok = (size_t)ch * 64 + (d ? 63 - tg : tg);
                const float braw = p.gates[tok * 16 + d * 4 + h], araw = p.gates[tok * 16 + 8 + d * 4 + h];
                bs[tg] = sigmoid_f(braw);
                float g = -expf(p.dn_a_log[(l * 2 + d) * 4 + h]) * softplus_f(araw + p.dn_dt_bias[(l * 2 + d) * 4 + h]);
#pragma unroll
                for (int o2 = 1; o2 < 64; o2 <<= 1) { const float up = __shfl(g, lane >= o2 ? lane - o2 : lane); g += lane >= o2 ? up : 0.f; }
                gcs[tg] = g;
            }
        }
        BLOCK_SYNC();
        const float gl = gcs[63];
        {
            f32x4 kk[1][4], qk[1][4]; zero_acc(kk); zero_acc(qk);
            mma_tiles<1, 4>(kk, Kb + wave * 16 * 72, 72, Kb, 72, 64, lane);
            mma_tiles<1, 4>(qk, Qb + wave * 16 * 72, 72, Kb, 72, 64, lane);
            BLOCK_SYNC();
#pragma unroll
            for (int nt = 0; nt < 4; ++nt)
#pragma unroll
                for (int r = 0; r < 4; ++r) {
                    const int tau = wave * 16 + (lane >> 4) * 4 + r, sg = nt * 16 + (lane & 15);
                    const float dec = sg <= tau ? expf(gcs[tau] - gcs[sg]) : 0.f;
                    Ab[tau * 72 + sg] = f2bf(sg < tau ? -kk[0][nt][r] * dec * bs[tau] : 0.f);
                    S1[(64 + tau) * 72 + sg] = f2bf(qk[0][nt][r] * 0.125f * dec);
                }
            for (int i = tid; i < 18432 / 16; i += 256) *(u32x4*)((char*)S2 + i * 16) = (u32x4){0u, 0u, 0u, 0u};
            const int tau = lane;
            const float kd = expf(gl - gcs[tau]);
            for (int dk = wave * 16; dk < wave * 16 + 16; ++dk) S1[dk * 72 + tau] = f2bf(bf2f(Kb[tau * 72 + dk]) * kd);
        }
        BLOCK_SYNC();
        {
            f32x4 rhs[4][2];
#pragma unroll
            for (int I = 0; I < 4; ++I)
#pragma unroll
                for (int nt = 0; nt < 2; ++nt)
#pragma unroll
                    for (int r = 0; r < 4; ++r) {
                        const int tau = I * 16 + (lane >> 4) * 4 + r, col = wave * 32 + nt * 16 + (lane & 15);
                        rhs[I][nt][r] = wave < 2 ? bf2f(Kb[tau * 72 + col]) * (bs[tau] * expf(gcs[tau])) : bf2f(Vb[tau * 64 + col - 64]) * bs[tau];
                    }
            BLOCK_SYNC();
#pragma unroll
            for (int I = 0; I < 4; ++I) {
                f32x4 acc[1][2]; acc[0][0] = rhs[I][0]; acc[0][1] = rhs[I][1];
                mma_tiles<1, 2>(acc, Ab + I * 16 * 72, 72, S2 + wave * 32 * 72, 72, 64, lane);
#pragma unroll
                for (int nt = 0; nt < 2; ++nt)
#pragma unroll
                    for (int r = 0; r < 4; ++r) Rb[((lane >> 4) * 4 + r) * 128 + wave * 32 + nt * 16 + (lane & 15)] = acc[0][nt][r];
                BLOCK_SYNC();
                if (tid < 128) {
                    const int col = tid; float x[16];
#pragma unroll
                    for (int r = 0; r < 16; ++r) x[r] = Rb[r * 128 + col];
#pragma unroll
                    for (int r = 1; r < 16; ++r) {
                        const bf16* ar = Ab + (I * 16 + r) * 72 + I * 16;
#pragma unroll
                        for (int k = 0; k < r; ++k) x[r] += bf2f(ar[k]) * x[k];
                    }
                    u32x4 w0, w1;
                    w0.x = pk2(x[0], x[1]); w0.y = pk2(x[2], x[3]); w0.z = pk2(x[4], x[5]); w0.w = pk2(x[6], x[7]);
                    w1.x = pk2(x[8], x[9]); w1.y = pk2(x[10], x[11]); w1.z = pk2(x[12], x[13]); w1.w = pk2(x[14], x[15]);
                    *(u32x4*)(S2 + col * 72 + I * 16) = w0; *(u32x4*)(S2 + col * 72 + I * 16 + 8) = w1;
                }
                BLOCK_SYNC();
            }
        }
        BLOCK_SYNC();
        {
            const size_t ib = (size_t)item * 4096;
            {
                f32x4 acc[1][8]; zero_acc(acc);
                mma_tiles<1, 8>(acc, S2 + wave * 16 * 72, 72, S1, 72, 64, lane);
                const int m0 = wave * 16 + (lane >> 4) * 4;
#pragma unroll
                for (int nt = 0; nt < 4; ++nt) { const int dk = nt * 16 + (lane & 15); *(u32x2*)(p.dnAp + ib + dk * 64 + m0) = pack4(-acc[0][nt]); }
#pragma unroll
                for (int nt = 4; nt < 8; ++nt) {
                    const int tau = (nt - 4) * 16 + (lane & 15); const float qs = 0.125f * expf(gcs[tau]);
                    const f32x4 qe = unpack4(*(const u32x2*)(Qb + tau * 72 + m0));
                    *(u32x2*)(p.dnQh + ib + tau * 64 + m0) = pack4(qe * qs - acc[0][nt]);
                }
            }
            {
                f32x4 acc[1][4]; zero_acc(acc);
                mma_tiles<1, 4>(acc, S1 + wave * 16 * 72, 72, S2 + 64 * 72, 72, 64, lane);
#pragma unroll
                for (int nt = 0; nt < 4; ++nt) { const int dv = nt * 16 + (lane & 15); *(u32x2*)(p.dnBT + ib + dv * 64 + wave * 16 + (lane >> 4) * 4) = pack4(acc[0][nt]); }
            }
            {
                f32x4 acc[1][4]; zero_acc(acc);
                mma_tiles<1, 4>(acc, S2 + (64 + wave * 16) * 72, 72, S1 + 64 * 72, 72, 64, lane);
#pragma unroll
                for (int nt = 0; nt < 4; ++nt) { const int tau = nt * 16 + (lane & 15); *(u32x2*)(p.dnOT + ib + tau * 64 + wave * 16 + (lane >> 4) * 4) = pack4(acc[0][nt]); }
            }
            if (tid == 0) p.dnEgl[item] = expf(gl);
        }
    }
}
constexpr int DN2_LDS = 64 * 72 * 2;
struct ScanOps {
#ifdef EMU
    const bf16 *ap, *qh;
#else
    bf16x8 ap[2], qh[2];
#endif
    u32x2 bt[2], ot[2]; float egl;
};
__device__ __forceinline__ void scan_load(ScanOps& o, const Params& p, int item, int wave, int hb, int lane) {
    const size_t ib = (size_t)item * 4096;
#ifdef EMU
    o.ap = p.dnAp + ib + wave * 16 * 64; o.qh = p.dnQh + ib + wave * 16 * 64;
#else
#pragma unroll
    for (int ks = 0; ks < 2; ++ks) {
        o.ap[ks] = *(const bf16x8*)(p.dnAp + ib + (wave * 16 + (lane & 15)) * 64 + ks * 32 + (lane >> 4) * 8);
        o.qh[ks] = *(const bf16x8*)(p.dnQh + ib + (wave * 16 + (lane & 15)) * 64 + ks * 32 + (lane >> 4) * 8);
    }
#endif
#pragma unroll
    for (int nt = 0; nt < 2; ++nt) {
        const int dv = hb * 32 + nt * 16 + (lane & 15), r0 = wave * 16 + (lane >> 4) * 4;
        o.bt[nt] = *(const u32x2*)(p.dnBT + ib + dv * 64 + r0);
        o.ot[nt] = *(const u32x2*)(p.dnOT + ib + (wave * 16 + (lane & 15)) * 64 + hb * 32 + nt * 16 + (lane >> 4) * 4);
    }
    o.egl = p.dnEgl[item];
}
__device__ __forceinline__ void scan_mma_s(f32x4 (&acc)[1][2], const ScanOps& o, const bf16* STh, int lane) {
#ifdef EMU
    mma_tiles<1, 2>(acc, o.ap, 64, STh, 72, 64, lane);
#else
#pragma unroll
    for (int ks = 0; ks < 2; ++ks)
#pragma unroll
        for (int nt = 0; nt < 2; ++nt) {
            const bf16x8 b = *(const bf16x8*)(STh + (nt * 16 + (lane & 15)) * 72 + ks * 32 + (lane >> 4) * 8);
            acc[0][nt] = __builtin_amdgcn_mfma_f32_16x16x32_bf16(o.ap[ks], b, acc[0][nt], 0, 0, 0);
        }
#endif
}
__device__ __forceinline__ void scan_mma_o(f32x4 (&acc)[2][1], const ScanOps& o, const bf16* STh, int lane) {
#ifdef EMU
    mma_tiles<2, 1>(acc, STh, 72, o.qh, 64, 64, lane);
#else
#pragma unroll
    for (int ks = 0; ks < 2; ++ks)
#pragma unroll
        for (int mt = 0; mt < 2; ++mt) {
            const bf16x8 a = *(const bf16x8*)(STh + (mt * 16 + (lane & 15)) * 72 + ks * 32 + (lane >> 4) * 8);
            acc[mt][0] = __builtin_amdgcn_mfma_f32_16x16x32_bf16(a, o.qh[ks], acc[mt][0], 0, 0, 0);
        }
#endif
}
__device__ __forceinline__ void dn_scan_body(const Params& p, int l, const Ctx& c, int first, int last, int wg, int nwg) {
    const int lane = c.lane, wave = c.wave, hb = c.vb & 1;
    bf16* ST = (bf16*)(c.smem - hb * HALF_LDS);
    bf16* STh = ST + hb * 32 * 72;
    for (int chain = first + wg; chain < last; chain += nwg) {
        const int d = chain & 1, h = (chain >> 1) & 3, seq = chain >> 3;
        const bool lat = seq >= BATCH; const int cps = lat ? CPS_LAT : CPS_CTX; const int ch0 = lat ? NCH_CTX + (seq - BATCH) * CPS_LAT : seq * CPS_CTX;
        f32x4 S[1][2];
#pragma unroll
        for (int nt = 0; nt < 2; ++nt)
#pragma unroll
            for (int r = 0; r < 4; ++r) {
                const int dk = wave * 16 + (lane >> 4) * 4 + r, dv = hb * 32 + nt * 16 + (lane & 15);
                S[0][nt][r] = lat ? p.state_delta[(((((size_t)(seq - BATCH) * DEPTH + l) * 2 + d) * 4 + h) * 64 + dk) * 64 + dv] : 0.f;
            }
#define SCAN_ITEM(qq) ((((ch0 + (d ? cps - 1 - ((qq) < cps ? (qq) : cps - 1) : ((qq) < cps ? (qq) : cps - 1))) * 4 + h) * 2) + d)
#define SCAN_STEP(ops, qq) do { \
            const int ch = ch0 + (d ? cps - 1 - (qq) : (qq)); \
            BLOCK_SYNC(); \
            _Pragma("unroll") for (int nt = 0; nt < 2; ++nt) *(u32x2*)(STh + (nt * 16 + (lane & 15)) * 72 + wave * 16 + (lane >> 4) * 4) = pack4(S[0][nt]); \
            BLOCK_SYNC(); \
            f32x4 Sn[1][2], O[2][1]; \
            _Pragma("unroll") for (int nt = 0; nt < 2; ++nt) { Sn[0][nt] = S[0][nt] * ops.egl + unpack4(ops.bt[nt]); O[nt][0] = unpack4(ops.ot[nt]); } \
            scan_mma_s(Sn, ops, STh, lane); \
            scan_mma_o(O, ops, STh, lane); \
            { const int tau = wave * 16 + (lane & 15); const size_t tok = (size_t)ch * 64 + (d ? 63 - tau : tau); \
              _Pragma("unroll") for (int mt = 0; mt < 2; ++mt) *(u32x2*)(p.obuf + ((size_t)d * NTOK + tok) * 256 + h * 64 + hb * 32 + mt * 16 + (lane >> 4) * 4) = pack4(O[mt][0]); } \
            _Pragma("unroll") for (int nt = 0; nt < 2; ++nt) S[0][nt] = Sn[0][nt]; \
        } while (0)
        ScanOps o0, o1, o2, o3;
        scan_load(o0, p, SCAN_ITEM(0), wave, hb, lane); scan_load(o1, p, SCAN_ITEM(1), wave, hb, lane); scan_load(o2, p, SCAN_ITEM(2), wave, hb, lane);
#pragma unroll 1
        for (int q = 0; q < cps; q += 4) {
            scan_load(o3, p, SCAN_ITEM(q + 3), wave, hb, lane); SCHED_BARRIER(); SCAN_STEP(o0, q); SCHED_BARRIER();
            scan_load(o0, p, SCAN_ITEM(q + 4), wave, hb, lane); SCHED_BARRIER(); SCAN_STEP(o1, q + 1); SCHED_BARRIER();
            scan_load(o1, p, SCAN_ITEM(q + 5), wave, hb, lane); SCHED_BARRIER(); SCAN_STEP(o2, q + 2); SCHED_BARRIER();
            scan_load(o2, p, SCAN_ITEM(q + 6), wave, hb, lane); SCHED_BARRIER(); SCAN_STEP(o3, q + 3); SCHED_BARRIER();
        }
#undef SCAN_STEP
#undef SCAN_ITEM
        if (!lat) {
#pragma unroll
            for (int nt = 0; nt < 2; ++nt)
#pragma unroll
                for (int r = 0; r < 4; ++r) {
                    const int dk = wave * 16 + (lane >> 4) * 4 + r, dv = hb * 32 + nt * 16 + (lane & 15);
                    p.out[OUT_DN + (((((size_t)seq * DEPTH + l) * 2 + d) * 4 + h) * 64 + dk) * 64 + dv] = S[0][nt][r];
                }
        }
    }
}
static_assert(CPS_CTX % 4 == 0, "scan ring assumes chunk counts divisible by 4");
__device__ __forceinline__ void dn_d3_body(const Params& p, int l, const Ctx& c) {
    const int lane = c.lane, wave = c.wave;
    for (size_t tok = (size_t)c.vb * 4 + wave; tok < (size_t)NTOK; tok += (size_t)c.nvb * 4) {
        const u32x2 a = *(const u32x2*)(p.obuf + tok * 256 + lane * 4), b = *(const u32x2*)(p.obuf + ((size_t)NTOK + tok) * 256 + lane * 4);
        const u32x2 zz = *(const u32x2*)(p.proj + tok * NPROJ + DZ + lane * 4);
        float v[4] = {bf2f((bf16)(a.x & 0xffff)) + bf2f((bf16)(b.x & 0xffff)), bf2f((bf16)(a.x >> 16)) + bf2f((bf16)(b.x >> 16)),
                      bf2f((bf16)(a.y & 0xffff)) + bf2f((bf16)(b.y & 0xffff)), bf2f((bf16)(a.y >> 16)) + bf2f((bf16)(b.y >> 16))};
        const float z[4] = {bf2f((bf16)(zz.x & 0xffff)), bf2f((bf16)(zz.x >> 16)), bf2f((bf16)(zz.y & 0xffff)), bf2f((bf16)(zz.y >> 16))};
        float ss = v[0] * v[0] + v[1] * v[1] + v[2] * v[2] + v[3] * v[3];
        ss += __shfl_xor(ss, 1); ss += __shfl_xor(ss, 2); ss += __shfl_xor(ss, 4); ss += __shfl_xor(ss, 8);
        const float rs = 1.0f / sqrtf(ss / 64.f + EPS);
        const int q0 = (lane & 15) * 4; float y[4];
#pragma unroll
        for (int i = 0; i < 4; ++i) y[i] = v[i] * rs * p.dn_norm_g[l * 64 + q0 + i] * silu_f(z[i]);
        u32x2 w; w.x = pk2(y[0], y[1]); w.y = pk2(y[2], y[3]);
        *(u32x2*)(p.mix + tok * DMIX + 256 + lane * 4) = w;
    }
}

__device__ __forceinline__ void final_norm_body(const Params& p, const Ctx& c) {
    const int lane = c.lane, wave = c.wave;
    for (int tok0 = c.vb * 4; tok0 < NTOK; tok0 += c.nvb * 4) {
        float* xr = p.out + (size_t)(tok0 + wave) * D;
        float v[D / 64]; float ss = 0.f;
#pragma unroll
        for (int j = 0; j < D / 64; ++j) { v[j] = xr[j * 64 + lane]; ss += v[j] * v[j]; }
#pragma unroll
        for (int o = 1; o < 64; o <<= 1) ss += __shfl_xor(ss, o);
        const float rs = 1.0f / sqrtf(ss / (float)D + EPS);
#pragma unroll
        for (int j = 0; j < D / 64; ++j) xr[j * 64 + lane] = v[j] * rs * p.final_g[j * 64 + lane];
    }
}

enum { PH_PREP = 0, PH_NORM, PH_GEMM_IN, PH_DN1, PH_CHAIN, PH_W0, PH_W1, PH_W2, PH_W3, PH_D3, PH_GEMM_OUT, PH_FINAL };
__device__ __forceinline__ int n_chain_wgs() { return gridDim.x >= 32 ? DEC_BATCH * 8 : (int)gridDim.x / 2; }
__device__ __forceinline__ Ctx make_ctx(char* smem) {
    Ctx c; const int hb = UNIFORM((int)(threadIdx.x >> 8));
    c.tid = threadIdx.x & 255; c.lane = c.tid & 63; c.wave = UNIFORM(c.tid >> 6); c.vb = blockIdx.x * 2 + hb; c.nvb = gridDim.x * 2; c.smem = smem + hb * HALF_LDS;
    return c;
}
__device__ __forceinline__ Ctx shifted(const Ctx& c, int by) { Ctx s = c; s.vb = (c.vb + c.nvb - (by % c.nvb)) % c.nvb; return s; }
#if defined(PROBE_SUB) && !defined(EMU)
#define SUBT(k, ...) do { const unsigned long long _s0 = __builtin_amdgcn_s_memrealtime(); __VA_ARGS__; if ((k) == PROBE_SUB && blockIdx.x == PROBE_TB && threadIdx.x == 0) p.bar[200] += (unsigned)(__builtin_amdgcn_s_memrealtime() - _s0); } while (0)
#else
#define SUBT(k, ...) do { __VA_ARGS__; } while (0)
#endif
__device__ __forceinline__ void run_phase(const Params& p, int ph, int l, const Ctx& c0) {
    Ctx c = c0;
    LAUNDER_V(c.tid); c.lane = c.tid & 63; c.wave = UNIFORM(c.tid >> 6); LAUNDER_S(c.vb); LAUNDER_S(l);
    const int ncb = n_chain_wgs();
    Ctx w = c; w.vb = c.vb - 2 * ncb; w.nvb = c.nvb - 2 * ncb;
    switch (ph) {
    case PH_PREP: prep_weights_body(p, (size_t)c.vb * 256 + c.tid, (size_t)c.nvb * 256); prep_tiled_body(p, c); break;
    case PH_NORM: norm_mod_body(p, l, c); break;
    case PH_GEMM_IN: { EpiProj e{p.proj, p.gates}; gemm_body<128>(p.hbuf, D, p.winT + (size_t)l * NPAD * D, D, NTOK, NPAD, D, e, c); } break;
    case PH_DN1: dn_d1_body(p, l, c); break;
    case PH_CHAIN: dn_scan_body(p, l, c, BATCH * 8, NSEQ * 8, c.vb >> 1, ncb); break;
    case PH_W0:
        SUBT(0, dn_scan_body(p, l, w, 0, BATCH * 8, w.vb >> 1, w.nvb >> 1)); BLOCK_SYNC();
        SUBT(1, pool_body(p, l, w)); BLOCK_SYNC();
        SUBT(2, ft_ctx_body(p, shifted(w, BATCH * 8))); BLOCK_SYNC();
        SUBT(3, ft_latA_body(p, shifted(w, BATCH * 8 + BATCH * 4 * (SEQ / 64)))); BLOCK_SYNC();
        SUBT(4, s5_pass1_body(p, l, w));
        break;
    case PH_W1:
        SUBT(5, ft_latB_body(p, w));
        SUBT(6, s5_carry_body(p, l, shifted(w, DEC_BATCH * 64)));
        break;
    case PH_W2: {
        SUBT(7, s5_pass3_body(p, l, w)); BLOCK_SYNC();
        EpiFt ef{&p}; SUBT(8, gemm_body<128>(p.fbuf, 256, p.ftwT + (size_t)l * 65536, 256, NTOK, 256, 256, ef, w));
    } break;
    case PH_W3: { EpiGlu eg{&p, l}; gemm_body<128>(p.ybuf, 256, p.gluT + (size_t)l * 65536, 256, NTOK, 256, 256, eg, w); } break;
    case PH_D3: dn_d3_body(p, l, c); break;
    case PH_GEMM_OUT: { EpiOut e{&p, l}; gemm_body<OUT_TOK>(p.mix, DMIX, p.woutT + (size_t)l * D * DMIX, DMIX, NTOK, D, DMIX, e, c); } break;
    case PH_FINAL: final_norm_body(p, c); break;
    }
}
#ifndef EMU
#define XB_TMO      128
#define XB_XCNT(j)  (256  + 64 * (j))
#define XB_XSUB(j)  (1280 + 64 * (j))
#define XB_XGEN(j)  (2304 + 64 * (j))
#define XB_TOP      3328
#define XB_TOPGEN   3392
#define XCD_BAR_WORDS 3456
#define XB_SPIN_CAP (1u << 18)
#define LAS __attribute__((address_space(3)))
__device__ __forceinline__ unsigned xb_ld(unsigned* p)              { return __hip_atomic_load(p, __ATOMIC_RELAXED, __HIP_MEMORY_SCOPE_AGENT); }
__device__ __forceinline__ unsigned xb_add(unsigned* p, unsigned v) { return __hip_atomic_fetch_add(p, v, __ATOMIC_RELAXED, __HIP_MEMORY_SCOPE_AGENT); }
__device__ __forceinline__ unsigned xb_xcc_id() { return (unsigned)__builtin_amdgcn_s_getreg((3 << 11) | 20) & 0xFu; }
#define XB_SPIN(cond, bar) do { unsigned _sp = 0; while (cond) { __builtin_amdgcn_s_sleep(1); \
    if ((++_sp & 255u) == 0u) { if (xb_ld(&(bar)[XB_TMO])) break; if (_sp > XB_SPIN_CAP) { atomicAdd(&(bar)[XB_TMO], 1u); break; } } } } while (0)
struct XcdBarrier { unsigned* bar; unsigned x; volatile LAS unsigned* st; unsigned G; };
__device__ __forceinline__ XcdBarrier xcd_barrier_post(unsigned* bar, volatile LAS unsigned* st, unsigned G) {
    XcdBarrier b; b.bar = bar; b.x = xb_xcc_id(); b.st = st; b.G = G;
    if (threadIdx.x == 0) (void)xb_add(&bar[XB_XCNT(b.x)], 1u);
    return b;
}
__device__ __forceinline__ void xcd_barrier_complete(unsigned* bar, unsigned x, unsigned G, unsigned& nloc, unsigned& nx) {
    unsigned sum, cnt, mine, sp = 0u;
    for (;;) {
        sum = 0u; cnt = 0u; mine = 0u;
#pragma unroll
        for (unsigned j = 0; j < 16; ++j) { const unsigned c = xb_ld(&bar[XB_XCNT(j)]); sum += c; cnt += (c > 0u) ? 1u : 0u; mine = (j == x) ? c : mine; }
        if (sum == G) break;
        __builtin_amdgcn_s_sleep(1);
        if ((++sp & 255u) == 0u) { if (xb_ld(&bar[XB_TMO])) break; if (sp > XB_SPIN_CAP) { atomicAdd(&bar[XB_TMO], 1u); break; } }
    }
    nloc = mine > 0u ? mine : 1u; nx = cnt > 0u ? cnt : 1u;
}
__device__ __forceinline__ void xcd_barrier(const XcdBarrier& b) {
    asm volatile("s_waitcnt vmcnt(0)" ::: "memory");
    __syncthreads();
    if (threadIdx.x == 0) {
        unsigned* bar = b.bar;
        __builtin_amdgcn_s_waitcnt(0);
        unsigned nloc = b.st[0], nx = b.st[1];
        if (nloc == 0u) { xcd_barrier_complete(bar, b.x, b.G, nloc, nx); b.st[0] = nloc; b.st[1] = nx; }
        const unsigned old = xb_add(&bar[XB_XSUB(b.x)], 1u);
        const unsigned gen = old / nloc;
        if (old + 1u == (gen + 1u) * nloc) {
            __builtin_amdgcn_fence(__ATOMIC_RELEASE, "agent");
            asm volatile("s_waitcnt vmcnt(0)" ::: "memory");
            const unsigned og = xb_add(&bar[XB_TOP], 1u);
            const unsigned tg = og / nx;
            if (og + 1u == (tg + 1u) * nx) xb_add(&bar[XB_TOPGEN], 1u);
            else XB_SPIN(xb_ld(&bar[XB_TOPGEN]) == tg, bar);
            __builtin_amdgcn_fence(__ATOMIC_ACQUIRE, "agent");
            xb_add(&bar[XB_XGEN(b.x)], 1u);
            asm volatile("s_waitcnt vmcnt(0)" ::: "memory");
        } else {
            XB_SPIN(xb_ld(&bar[XB_XGEN(b.x)]) == gen, bar);
            __builtin_amdgcn_fence(__ATOMIC_ACQUIRE, "agent");
            asm volatile("s_waitcnt vmcnt(0)" ::: "memory");
        }
    }
    __syncthreads();
}
#endif
constexpr int MEGA_LDS = 2 * HALF_LDS + 16;
#ifdef EMU
__global__ void __launch_bounds__(512) k_phase(Params p, int ph, int l) {
    DYN_LDS(smem); const Ctx c = make_ctx(smem); const bool worker = (int)blockIdx.x >= n_chain_wgs();
    if (ph == PH_CHAIN && worker) return;
    if (ph >= PH_W0 && ph <= PH_W3 && !worker) return;
    run_phase(p, ph, l, c);
}
#else
__global__ void __launch_bounds__(512) k_mega(Params p) {
    DYN_LDS(smem);
    volatile LAS unsigned* st = (volatile LAS unsigned*)(smem + 2 * HALF_LDS);
    if (threadIdx.x < 4) st[threadIdx.x] = 0u;
    __syncthreads();
    const int ncb = n_chain_wgs();
    const bool worker = (int)blockIdx.x >= ncb;
    const XcdBarrier bar = xcd_barrier_post(p.bar, st, gridDim.x);
    XcdBarrier wbar = bar;
    if (worker) wbar = xcd_barrier_post(p.bar + 4096, st + 2, gridDim.x - ncb);
#define GRID_SYNC() xcd_barrier(bar)
#define WORKER_SYNC() xcd_barrier(wbar)
    const Ctx c = make_ctx(smem);
#ifdef PROBE_TID
    unsigned long long t_acc = 0;
#define TIMED(ph, ...) do { const unsigned long long _t0 = __builtin_amdgcn_s_memrealtime(); __VA_ARGS__; if ((ph) == PROBE_TID) t_acc += __builtin_amdgcn_s_memrealtime() - _t0; } while (0)
#else
#define TIMED(ph, ...) do { __VA_ARGS__; } while (0)
#endif
    TIMED(PH_PREP, run_phase(p, PH_PREP, 0, c); GRID_SYNC());
#pragma unroll 1
    for (int l = 0; l < DEPTH; ++l) {
        TIMED(PH_NORM, run_phase(p, PH_NORM, l, c); GRID_SYNC());
        TIMED(PH_GEMM_IN, run_phase(p, PH_GEMM_IN, l, c); GRID_SYNC());
        TIMED(PH_DN1, run_phase(p, PH_DN1, l, c); GRID_SYNC());
        if (!worker) { TIMED(PH_CHAIN, run_phase(p, PH_CHAIN, l, c)); }
        else {
            TIMED(PH_W0, run_phase(p, PH_W0, l, c); WORKER_SYNC());
            TIMED(PH_W1, run_phase(p, PH_W1, l, c); WORKER_SYNC());
            TIMED(PH_W2, run_phase(p, PH_W2, l, c); WORKER_SYNC());
            TIMED(PH_W3, run_phase(p, PH_W3, l, c));
        }
        TIMED(PH_D3, GRID_SYNC(); run_phase(p, PH_D3, l, c); GRID_SYNC());
        TIMED(PH_GEMM_OUT, run_phase(p, PH_GEMM_OUT, l, c); GRID_SYNC());
    }
    TIMED(PH_FINAL, run_phase(p, PH_FINAL, 0, c));
#ifdef PROBE_SUB
    if (blockIdx.x == PROBE_TB && threadIdx.x == 0) t_acc = p.bar[200];
#endif
#ifdef PROBE_TID
    if (blockIdx.x == PROBE_TB && threadIdx.x == 0) { const unsigned long long t1 = __builtin_amdgcn_s_memrealtime(); while (__builtin_amdgcn_s_memrealtime() - t1 < (unsigned long long)PROBE_TK * t_acc) __builtin_amdgcn_s_sleep(8); }
#endif
}
#endif

static size_t ws_carve(Params& p, char* ws) {
    size_t off = 0;
    auto take = [&](size_t bytes) { size_t o = off; off += (bytes + 255) & ~(size_t)255; return ws ? ws + o : (char*)nullptr; };
    p.bar = (unsigned*)take(32768);
    p.winT = (bf16*)take((size_t)DEPTH * NPAD * D * 2);
    p.woutT = (bf16*)take((size_t)DEPTH * D * DMIX * 2);
    p.ftwT = (bf16*)take((size_t)DEPTH * 65536 * 2);
    p.gluT = (bf16*)take((size_t)DEPTH * 65536 * 2);
    p.poolwT = (bf16*)take((size_t)DEPTH * 4 * 4096 * 2);
    p.Cmat = (bf16*)take((size_t)DEPTH * 16 * 4096 * 2);
    p.tabDc = (bf16*)take(128 * 64 * 2);
    p.tabE = (bf16*)take(128 * 128 * 2);
    p.tabT = (bf16*)take((size_t)SEQ * 2 * SEQ * 2);
    p.ada = (float*)take((size_t)DEPTH * NCOND * 3 * D * 4);
    p.abar = (float*)take((size_t)DEPTH * 2 * 16 * 64 * 2 * 4);
    p.abar64 = (float*)take((size_t)DEPTH * 2 * 16 * 64 * 2 * 4);
    p.bbar = (float*)take((size_t)DEPTH * 2 * 16 * 64 * 32 * 4);
    p.bbarT = (bf16*)take((size_t)DEPTH * 2 * 16 * 128 * 16 * 2);
    p.hbuf = (bf16*)take((size_t)NTOK * DMIX * 2);
    p.mix = p.hbuf;
    p.proj = (bf16*)take((size_t)NTOK * NPROJ * 2);
    p.fbuf = (bf16*)take((size_t)NTOK * 256 * 2);
    p.ybuf = (bf16*)take((size_t)NTOK * 256 * 2);
    p.obuf = (bf16*)take((size_t)2 * NTOK * 256 * 2);
    p.Zg = (bf16*)take((size_t)DEC_BATCH * 64 * 256 * 128 * 2);
    p.dnAp = (bf16*)take((size_t)NCH * 8 * 4096 * 2);
    p.dnQh = (bf16*)take((size_t)NCH * 8 * 4096 * 2);
    p.dnBT = (bf16*)take((size_t)NCH * 8 * 4096 * 2);
    p.dnOT = (bf16*)take((size_t)NCH * 8 * 4096 * 2);
    p.gates = (float*)take((size_t)NTOK * 16 * 4);
    p.dnEgl = (float*)take((size_t)NCH * 8 * 4);
    p.s5E = (float*)take((size_t)NCH * 16 * 2 * 128 * 4);
    p.s5S = (float*)take((size_t)NCH * 16 * 2 * 128 * 4);
    return off;
}

#ifdef EMU
void emu_hook(const char* tag, int l, const Params& p);
#define HOOK(tag, l) emu_hook(tag, l, p)
#endif
extern "C" void kernel_launch(void* const* d_in, const int* in_sizes, int n_in, void* d_out, int out_size, void* d_ws, size_t ws_size, hipStream_t stream) {
    Params p;
    memset(&p, 0, sizeof(p));
    const float** ip = (const float**)&p;
    for (int i = 0; i < 29; ++i) ip[i] = (const float*)d_in[i];
    p.out = (float*)d_out;
    const size_t need = ws_carve(p, (char*)d_ws);
    if (need > ws_size || n_in != 29) { fprintf(stderr, "kernel_launch: workspace %zu < %zu or n_in %d\n", ws_size, need, n_in); return; }
#ifdef EMU
    const int G = 6;
    LAUNCH(k_phase, G, 512, MEGA_LDS, stream, p, (int)PH_PREP, 0);
    for (int l = 0; l < DEPTH; ++l)
        for (int ph = PH_NORM; ph <= PH_GEMM_OUT; ++ph) {
            LAUNCH(k_phase, G, 512, MEGA_LDS, stream, p, ph, l);
            if (ph == PH_NORM) HOOK("norm", l);
            if (ph == PH_GEMM_IN) HOOK("proj", l);
            if (ph == PH_D3) HOOK("mix", l);
            if (ph == PH_GEMM_OUT) HOOK("xout", l);
        }
    LAUNCH(k_phase, G, 512, MEGA_LDS, stream, p, (int)PH_FINAL, 0);
#else
    static int grid = 0;
    if (!grid) {
        int dev = 0, cus = 0, per_cu = 0;
        (void)hipGetDevice(&dev);
        (void)hipDeviceGetAttribute(&cus, hipDeviceAttributeMultiprocessorCount, dev);
        (void)hipFuncSetAttribute((const void*)k_mega, hipFuncAttributeMaxDynamicSharedMemorySize, MEGA_LDS);
        (void)hipOccupancyMaxActiveBlocksPerMultiprocessor(&per_cu, (const void*)k_mega, 512, MEGA_LDS);
        if (per_cu < 1) { fprintf(stderr, "kernel_launch: occupancy query says %d blocks/CU\n", per_cu); per_cu = 1; }
        grid = cus * 1;
        fprintf(stderr, "kernel_launch: cus %d per_cu %d grid %d\n", cus, per_cu, grid);
    }
    (void)hipMemsetAsync(p.bar, 0, 32768, stream);
    void* args[] = {&p};
    hipError_t e = hipLaunchCooperativeKernel((const void*)k_mega, dim3(grid), dim3(512), args, MEGA_LDS, stream);
    if (e != hipSuccess) fprintf(stderr, "cooperative launch failed: %s (grid %d)\n", hipGetErrorString(e), grid);
#endif
}
```

```cpp
#ifdef EMU
#include "hip_emu.h"
#define LAUNCH(k, g, b, l, s, ...) EMU_LAUNCH(k, g, b, l, s, __VA_ARGS__)
#define DYN_LDS(name) char* name = emu::dyn_lds
#define WAVE_SYNC() emu_wave_sync()
#define BLOCK_SYNC() __syncthreads()
#define SCHED_BARRIER()
#define UNIFORM(x) (x)
#define LAUNDER_V(x)
#define LAUNDER_S(x)
#else
#include <hip/hip_runtime.h>
#include <hip/hip_cooperative_groups.h>
#include <cstdio>
#include <cstdint>
#include <cstring>
#define LAUNCH(k, g, b, l, s, ...) hipLaunchKernelGGL(k, dim3(g), dim3(b), l, s, __VA_ARGS__)
#define DYN_LDS(name) extern __shared__ __attribute__((aligned(16))) char name[]
#define WAVE_SYNC() do { __builtin_amdgcn_s_waitcnt(0xc07f); __builtin_amdgcn_wave_barrier(); } while (0)
#define SCHED_BARRIER() __builtin_amdgcn_sched_barrier(0)
#ifndef PROBE_TB
#define PROBE_TB 0
#endif
#define BLOCK_SYNC() do { asm volatile("s_waitcnt lgkmcnt(0)" ::: "memory"); __builtin_amdgcn_s_barrier(); asm volatile("" ::: "memory"); } while (0)
#define UNIFORM(x) __builtin_amdgcn_readfirstlane(x)
#define LAUNDER_V(x) asm volatile("" : "+v"(x))
#define LAUNDER_S(x) asm volatile("" : "+s"(x))
#endif

#ifndef D_MODEL
#define D_MODEL 1024
#endif
#ifndef BATCH
#define BATCH 16
#endif
#ifndef SEQ
#define SEQ 256
#endif
#ifndef DEPTH
#define DEPTH 4
#endif
#ifndef DEC_BATCH
#define DEC_BATCH 2
#endif
#define DEC_SEQ 4096
constexpr int D = D_MODEL;
constexpr int NCTX = BATCH * SEQ, NLAT = DEC_BATCH * DEC_SEQ, NTOK = NCTX + NLAT;
constexpr int NCH_CTX = NCTX / 64, NCH_LAT = NLAT / 64, NCH = NTOK / 64;
constexpr int CPS_CTX = SEQ / 64, CPS_LAT = 64;
constexpr int NSEQ = BATCH + DEC_BATCH, NCOND = 1 + DEC_BATCH;
constexpr int BR = 256, DMIX = 1024;
constexpr int PU = 0, PZ = 256, QKV = 512, DZ = 1280, SU = 1536, SZ = 1792, FU = 2048, FZ = 2304, NPROJ = 2560, NPAD = 2688;
constexpr int D_IN_PROJ = 2576;
constexpr float EPS = 1e-6f;

typedef unsigned short bf16;
typedef float f32x4 __attribute__((ext_vector_type(4)));
typedef short bf16x8 __attribute__((ext_vector_type(8)));
typedef float f32x16 __attribute__((ext_vector_type(16)));
typedef unsigned u32x2 __attribute__((ext_vector_type(2)));
typedef unsigned u32x4 __attribute__((ext_vector_type(4)));

__device__ __forceinline__ unsigned f2u(float f) { return __builtin_bit_cast(unsigned, f); }
__device__ __forceinline__ float u2f(unsigned u) { return __builtin_bit_cast(float, u); }
#ifdef EMU
__device__ __forceinline__ bf16 f2bf(float f) { unsigned u = f2u(f); return (bf16)((u + 0x7fffu + ((u >> 16) & 1u)) >> 16); }
__device__ __forceinline__ unsigned pk2(float lo, float hi) { return (unsigned)f2bf(lo) | ((unsigned)f2bf(hi) << 16); }
#else
typedef __bf16 hwbf2 __attribute__((ext_vector_type(2)));
typedef float hwf2 __attribute__((ext_vector_type(2)));
__device__ __forceinline__ bf16 f2bf(float f) { const __bf16 h = (__bf16)f; return __builtin_bit_cast(bf16, h); }
__device__ __forceinline__ unsigned pk2(float lo, float hi) { const hwf2 v = {lo, hi}; const hwbf2 b = __builtin_convertvector(v, hwbf2); return __builtin_bit_cast(unsigned, b); }
#endif
__device__ __forceinline__ float bf2f(bf16 h) { return u2f((unsigned)h << 16); }
#ifdef EMU
__device__ __forceinline__ float fexp(float x) { return expf(x); }
__device__ __forceinline__ float frcp(float x) { return 1.0f / x; }
__device__ __forceinline__ float fsin(float x) { return sinf(x); }
__device__ __forceinline__ float fcos(float x) { return cosf(x); }
#else
__device__ __forceinline__ float fexp(float x) { return __expf(x); }
__device__ __forceinline__ float frcp(float x) { return __builtin_amdgcn_rcpf(x); }
__device__ __forceinline__ float fsin(float x) { return __sinf(x); }
__device__ __forceinline__ float fcos(float x) { return __cosf(x); }
#endif
__device__ __forceinline__ float sigmoid_f(float x) { return frcp(1.0f + fexp(-x)); }
__device__ __forceinline__ float silu_f(float x) { return x * sigmoid_f(x); }
__device__ __forceinline__ float softplus_f(float x) { return x > 20.f ? x : log1pf(fexp(x)); }
__device__ __forceinline__ float gelu_f(float x) { return x * sigmoid_f(1.5957691216057308f * (x + 0.044715f * x * x * x)); }

template <int MT, int NT>
__device__ __forceinline__ void mma_tiles(f32x4 (&acc)[MT][NT], const bf16* A, int lda, const bf16* B, int ldb, int K, int lane) {
#ifdef EMU
    const int col = lane & 15, rq = (lane >> 4) * 4;
    for (int mt = 0; mt < MT; ++mt) for (int nt = 0; nt < NT; ++nt) for (int r = 0; r < 4; ++r) {
        float s = 0.f; const bf16* a = A + (16 * mt + rq + r) * lda; const bf16* b = B + (16 * nt + col) * ldb;
        for (int k = 0; k < K; ++k) s += bf2f(a[k]) * bf2f(b[k]);
        acc[mt][nt][r] += s;
    }
#else
    const bf16* a0 = A + (lane & 15) * lda + (lane >> 4) * 8;
    const bf16* b0 = B + (lane & 15) * ldb + (lane >> 4) * 8;
    for (int k0 = 0; k0 < K; k0 += 32) {
        bf16x8 a[MT], b[NT];
#pragma unroll
        for (int mt = 0; mt < MT; ++mt) a[mt] = *(const bf16x8*)(a0 + 16 * mt * lda + k0);
#pragma unroll
        for (int nt = 0; nt < NT; ++nt) b[nt] = *(const bf16x8*)(b0 + 16 * nt * ldb + k0);
#pragma unroll
        for (int mt = 0; mt < MT; ++mt)
#pragma unroll
            for (int nt = 0; nt < NT; ++nt) acc[mt][nt] = __builtin_amdgcn_mfma_f32_16x16x32_bf16(a[mt], b[nt], acc[mt][nt], 0, 0, 0);
    }
#endif
}
__device__ __forceinline__ void mma32(f32x16& acc, const bf16* A, int lda, const bf16* B, int ldb, int lane) {
#ifdef EMU
    const int col = lane & 31, h = lane >> 5;
    for (int r = 0; r < 16; ++r) {
        const int row = (r & 3) + 8 * (r >> 2) + 4 * h; float s = 0.f;
        for (int k = 0; k < 16; ++k) s += bf2f(A[row * lda + k]) * bf2f(B[col * ldb + k]);
        acc[r] += s;
    }
#else
    const bf16x8 a = *(const bf16x8*)(A + (lane & 31) * lda + (lane >> 5) * 8);
    const bf16x8 b = *(const bf16x8*)(B + (lane & 31) * ldb + (lane >> 5) * 8);
    acc = __builtin_amdgcn_mfma_f32_32x32x16_bf16(a, b, acc, 0, 0, 0);
#endif
}
__device__ __forceinline__ float swap_halves(float v, int lane) {
#ifdef EMU
    (void)lane; return __shfl_xor(v, 32);
#else
    const unsigned u = f2u(v); const auto r = __builtin_amdgcn_permlane32_swap(u, u, false, false);
    return u2f((lane & 32) ? r[0] : r[1]);
#endif
}
template <int MT, int NT, int KS>
__device__ __forceinline__ void mma_tiles_u(f32x4 (&acc)[MT][NT], const bf16* A, int lda, const bf16* B, int ldb, int lane) {
#ifdef EMU
    mma_tiles<MT, NT>(acc, A, lda, B, ldb, 32 * KS, lane);
#else
    const bf16* a0 = A + (lane & 15) * lda + (lane >> 4) * 8;
    const bf16* b0 = B + (lane & 15) * ldb + (lane >> 4) * 8;
#pragma unroll
    for (int ks = 0; ks < KS; ++ks) {
        bf16x8 a[MT], b[NT];
#pragma unroll
        for (int mt = 0; mt < MT; ++mt) a[mt] = *(const bf16x8*)(a0 + 16 * mt * lda + ks * 32);
#pragma unroll
        for (int nt = 0; nt < NT; ++nt) b[nt] = *(const bf16x8*)(b0 + 16 * nt * ldb + ks * 32);
#pragma unroll
        for (int mt = 0; mt < MT; ++mt)
#pragma unroll
            for (int nt = 0; nt < NT; ++nt) acc[mt][nt] = __builtin_amdgcn_mfma_f32_16x16x32_bf16(a[mt], b[nt], acc[mt][nt], 0, 0, 0);
    }
#endif
}
template <int MT, int NT, int KS, bool PA, bool PB>
__device__ __forceinline__ void mma_tiles_pf(f32x4 (&acc)[MT][NT], const bf16* A, int lda, const bf16* B, int ldb, int lane) {
#ifdef EMU
    mma_tiles<MT, NT>(acc, A, lda, B, ldb, 32 * KS, lane);
#else
    const bf16* a0 = A + (lane & 15) * lda + (lane >> 4) * 8;
    const bf16* b0 = B + (lane & 15) * ldb + (lane >> 4) * 8;
    bf16x8 ga[PA ? KS : 1][MT], gb[PB ? KS : 1][NT];
    if (PA) {
#pragma unroll
        for (int ks = 0; ks < KS; ++ks)
#pragma unroll
            for (int mt = 0; mt < MT; ++mt) ga[ks][mt] = *(const bf16x8*)(a0 + 16 * mt * lda + ks * 32);
    }
    if (PB) {
#pragma unroll
        for (int ks = 0; ks < KS; ++ks)
#pragma unroll
            for (int nt = 0; nt < NT; ++nt) gb[ks][nt] = *(const bf16x8*)(b0 + 16 * nt * ldb + ks * 32);
    }
    SCHED_BARRIER();
#pragma unroll
    for (int ks = 0; ks < KS; ++ks) {
        bf16x8 a[MT], b[NT];
#pragma unroll
        for (int mt = 0; mt < MT; ++mt) a[mt] = PA ? ga[ks][mt] : *(const bf16x8*)(a0 + 16 * mt * lda + ks * 32);
#pragma unroll
        for (int nt = 0; nt < NT; ++nt) b[nt] = PB ? gb[ks][nt] : *(const bf16x8*)(b0 + 16 * nt * ldb + ks * 32);
#pragma unroll
        for (int mt = 0; mt < MT; ++mt)
#pragma unroll
            for (int nt = 0; nt < NT; ++nt) acc[mt][nt] = __builtin_amdgcn_mfma_f32_16x16x32_bf16(a[mt], b[nt], acc[mt][nt], 0, 0, 0);
    }
#endif
}
template <int NT>
__device__ __forceinline__ void mma_k16(f32x4 (&acc)[1][NT], const bf16* A, int lda, const bf16* B, int ldb, int lane) {
#ifdef EMU
    const int col = lane & 15, rq = (lane >> 4) * 4;
    for (int nt = 0; nt < NT; ++nt) for (int r = 0; r < 4; ++r) {
        float s = 0.f; const bf16* a = A + (rq + r) * lda; const bf16* b = B + (16 * nt + col) * ldb;
        for (int k = 0; k < 16; ++k) s += bf2f(a[k]) * bf2f(b[k]);
        acc[0][nt][r] += s;
    }
#else
    const int kq = ((lane >> 4) & 1) * 8;
    bf16x8 a = *(const bf16x8*)(A + (lane & 15) * lda + kq);
    const bf16x8 z = {};
    a = lane < 32 ? a : z;
#pragma unroll
    for (int nt = 0; nt < NT; ++nt) {
        const bf16x8 b = *(const bf16x8*)(B + (16 * nt + (lane & 15)) * ldb + kq);
        acc[0][nt] = __builtin_amdgcn_mfma_f32_16x16x32_bf16(a, b, acc[0][nt], 0, 0, 0);
    }
#endif
}
__device__ __forceinline__ float bf_at(const u32x4& a0, const u32x4& a1, int k) {
    const unsigned w = k < 8 ? a0[(k & 7) >> 1] : a1[(k & 7) >> 1];
    return bf2f((bf16)((k & 1) ? (w >> 16) : (w & 0xffff)));
}
template <int MT, int NT> __device__ __forceinline__ void zero_acc(f32x4 (&acc)[MT][NT]) {
#pragma unroll
    for (int mt = 0; mt < MT; ++mt)
#pragma unroll
        for (int nt = 0; nt < NT; ++nt) acc[mt][nt] = (f32x4){0.f, 0.f, 0.f, 0.f};
}

struct Params {
    const float *x_prompt, *x_sample, *c, *state_delta, *state_s5, *c_ctx, *w_ada, *b_ada, *norm_g, *w_in, *pool_w, *pool_scale,
        *dn_conv, *dn_a_log, *dn_dt_bias, *dn_norm_g, *s5_a_re, *s5_a_im, *s5_log_dt, *s5_b_re, *s5_b_im, *s5_c_re, *s5_c_im,
        *s5_d, *s5_glu_w, *s5_glu_b, *ft_w, *w_out, *final_g;
    float* out;
    bf16 *winT, *woutT, *ftwT, *gluT, *poolwT, *Cmat, *tabDc, *tabE, *tabT;
    float *ada, *abar, *abar64, *bbar;
    bf16* bbarT;
    bf16 *hbuf  , *mix, *proj, *fbuf, *ybuf, *obuf, *Zg, *dnAp, *dnQh, *dnBT, *dnOT;
    float *gates, *dnEgl, *s5E, *s5S;
    unsigned* bar;
    float* sumsq;
    float *gsv, *sW;
    bf16* xg;
    bf16* xb;
};
constexpr size_t OUT_DN = (size_t)NTOK * D, OUT_S5 = OUT_DN + (size_t)BATCH * DEPTH * 2 * 4 * 64 * 64;
constexpr size_t OUT_TOTAL = OUT_S5 + (size_t)BATCH * DEPTH * 2 * 2 * 16 * 64;

struct Ctx { int tid, lane, wave, vb, nvb; char* smem; unsigned* q; unsigned* qslot; };
constexpr int HALF_LDS = 81664;
__device__ __forceinline__ int loop_iters(int N, const Ctx& c) { const int v0 = c.vb & ~1; return N > v0 ? (N - v0 + c.nvb - 1) / c.nvb : 0; }
template <int STEP>
__device__ __forceinline__ int item_base(const Ctx& c, int k, int N) {
    if (c.q == nullptr) { const int b = (STEP == 2 ? (c.vb & ~1) : (c.vb >> 1)) + k * (STEP == 2 ? c.nvb : (c.nvb >> 1)); return b < N ? b : -1; }
    BLOCK_SYNC();
    if (threadIdx.x == 0) *c.qslot = atomicAdd(c.q, (unsigned)STEP);
    BLOCK_SYNC();
    const int b = (int)*c.qslot;
    return b < N ? b : -1;
}
__device__ __forceinline__ int cond_of(int tok) { return tok < NCTX ? 0 : 1 + (tok - NCTX) / DEC_SEQ; }
__device__ __forceinline__ const float* xrow_in(const Params& p, int l, int tok) {
    if (l == 0) return tok < NCTX ? p.x_prompt + (size_t)tok * D : p.x_sample + (size_t)(tok - NCTX) * D;
    return p.out + (size_t)tok * D;
}

__device__ __forceinline__ void prep_weights_body(const Params& p, size_t gtid, size_t gsz) {
    for (size_t i = gtid; i < (size_t)DEPTH * 4 * 64 * 64; i += gsz) {
        int c = (int)(i % 64), d = (int)((i / 64) % 64); size_t lg = i / 4096;
        p.poolwT[i] = f2bf(p.pool_w[(lg * 64 + c) * 64 + d]);
    }
    for (size_t i = gtid; i < (size_t)DEPTH * 16 * 16 * 256; i += gsz) {
        int k = (int)(i % 256), pp = (int)((i / 256) % 16), g = (int)((i / 4096) % 16), l = (int)(i / 65536);
        int d = k >> 7, part = (k >> 6) & 1, n = k & 63;
        size_t src = ((((size_t)l * 2 + d) * 16 + g) * 16 + pp) * 64 + n;
        p.Cmat[i] = f2bf(part ? -p.s5_c_im[src] : p.s5_c_re[src]);
    }
    const float TWO_PI = 6.283185307179586f;
    for (size_t i = gtid; i < 128 * 64; i += gsz) {
        int c = (int)(i % 64), n = (int)(i / 64), part = n >> 6, kc = n & 63; int m = (c * kc) & 63;
        float a = TWO_PI * (float)m / 64.f; p.tabDc[i] = f2bf(part ? -sinf(a) : cosf(a));
    }
    for (size_t i = gtid; i < 128 * 128; i += gsz) {
        int kk = (int)(i % 128), n = (int)(i / 128); int pp = n >> 6, k1 = n & 63, pt = kk >> 6, t1 = kk & 63; int m = (t1 * k1) & 63;
        float a = TWO_PI * (float)m / 64.f; float C = cosf(a), S = sinf(a);
        float v = (pp == 0) ? (pt == 0 ? C : S) : (pt == 0 ? -S : C);
        p.tabE[i] = f2bf(v);
    }
    for (size_t i = gtid; i < (size_t)SEQ * 2 * SEQ; i += gsz) {
        int kk = (int)(i % (2 * SEQ)), kt = (int)(i / (2 * SEQ)); int part = kk / SEQ, t = kk % SEQ; int m = (kt * t) % SEQ;
        float a = TWO_PI * (float)m / (float)SEQ; p.tabT[i] = f2bf(part ? sinf(a) : cosf(a));
    }
    for (size_t i = gtid; i < (size_t)DEPTH * 2 * 16 * 64; i += gsz) {
        size_t ldg = i / 64;
        float dt = expf(p.s5_log_dt[ldg]); float are = p.s5_a_re[i], aim = p.s5_a_im[i];
        float mag = expf(are * dt); float abr = mag * cosf(aim * dt), abi = mag * sinf(aim * dt);
        float den = are * are + aim * aim; float nr = abr - 1.0f;
        float cre = (nr * are + abi * aim) / den, cim = (abi * are - nr * aim) / den;
        p.abar[2 * i] = abr; p.abar[2 * i + 1] = abi;
        float pr = abr, pi = abi;
        for (int s = 0; s < 6; ++s) { float t0 = pr * pr - pi * pi, t1 = 2.f * pr * pi; pr = t0; pi = t1; }
        p.abar64[2 * i] = pr; p.abar64[2 * i + 1] = pi;
        for (int pp = 0; pp < 16; ++pp) {
            float bre = p.s5_b_re[i * 16 + pp], bim = p.s5_b_im[i * 16 + pp];
            p.bbar[i * 32 + pp] = cre * bre - cim * bim;
            p.bbar[i * 32 + 16 + pp] = cre * bim + cim * bre;
            const size_t ldgi = i / 64; const int nn = (int)(i % 64);
            p.bbarT[(ldgi * 128 + nn) * 16 + pp] = f2bf(cre * bre - cim * bim);
            p.bbarT[(ldgi * 128 + 64 + nn) * 16 + pp] = f2bf(cre * bim + cim * bre);
        }
    }
}


constexpr int PT_KT = D / 64;
constexpr int PT_WIN = DEPTH * (NPAD / 64) * PT_KT;
constexpr int PT_WOUT = DEPTH * (D / 64) * (DMIX / 64);
constexpr int PT_SQ = DEPTH * 2 * 16;
constexpr int PT_ADA = DEPTH * (3 * D / 64);
constexpr int PT_TOTAL = PT_WIN + PT_WOUT + PT_SQ + PT_ADA;
constexpr int PREP_LDS = 64 * 65 * 4 + NCOND * D * 4;
__device__ __forceinline__ void prep_tiled_body(const Params& p, const Ctx& c) {
    float* T = (float*)c.smem;
    float* sc = T + 64 * 65;
    const int tid = c.tid;
    for (int i = tid; i < NCOND * D; i += 256) { const int cc = i / D, k = i % D; sc[i] = silu_f(cc == 0 ? p.c_ctx[k] : p.c[(size_t)(cc - 1) * D + k]); }
    for (int _k = 0, _b; (_b = item_base<2>(c, _k, PT_TOTAL)) >= 0; ++_k) {
        int item = _b + (c.vb & 1); const bool ghost = item >= PT_TOTAL; if (ghost) item = PT_TOTAL - 1;
        int type, l, kt = 0, nt = 0;
        const float* src_ = nullptr; int lds_ = 0, k0 = 0, ncol0 = 0, nvalid = 64; bf16* dst = nullptr; int ldk = 0;
        if (item < PT_WIN) { type = 0; l = item / ((NPAD / 64) * PT_KT); const int r = item % ((NPAD / 64) * PT_KT); nt = r / PT_KT; kt = r % PT_KT;
            const int n0 = nt * 64; const int oc = n0 < 1536 ? n0 : (n0 < NPROJ ? n0 + 16 : 1536); nvalid = n0 < NPROJ ? 64 : (n0 == NPROJ ? 16 : 0);
            src_ = p.w_in + (size_t)l * D * D_IN_PROJ; lds_ = D_IN_PROJ; k0 = kt * 64; ncol0 = oc; dst = p.winT + ((size_t)l * NPAD + n0) * D; ldk = D; }
        else if (item < PT_WIN + PT_WOUT) { type = 0; const int it = item - PT_WIN; l = it / ((D / 64) * (DMIX / 64)); const int r = it % ((D / 64) * (DMIX / 64)); nt = r / (DMIX / 64); kt = r % (DMIX / 64);
            src_ = p.w_out + (size_t)l * DMIX * D; lds_ = D; k0 = kt * 64; ncol0 = nt * 64; dst = p.woutT + ((size_t)l * D + nt * 64) * DMIX; ldk = DMIX; }
        else if (item < PT_WIN + PT_WOUT + PT_SQ) { type = 0; const int it = item - PT_WIN - PT_WOUT; l = it / 32; const int which = (it >> 4) & 1, r = it & 15; nt = r >> 2; kt = r & 3;
            src_ = (which ? p.s5_glu_w : p.ft_w) + (size_t)l * 65536; lds_ = 256; k0 = kt * 64; ncol0 = nt * 64; dst = (which ? p.gluT : p.ftwT) + (size_t)l * 65536 + (size_t)nt * 64 * 256; ldk = 256; }
        else { type = 1; const int it = item - PT_WIN - PT_WOUT - PT_SQ; l = it / (3 * D / 64); nt = it % (3 * D / 64); }
        BLOCK_SYNC();
        if (type == 0) {
            const int cq = (tid & 15) * 4;
#pragma unroll
            for (int i = 0; i < 4; ++i) {
                const int kk = (tid >> 4) + 16 * i;
                f32x4 v = (f32x4){0.f, 0.f, 0.f, 0.f};
                if (cq < nvalid) v = *(const f32x4*)(src_ + (size_t)(k0 + kk) * lds_ + ncol0 + cq);
                T[kk * 65 + cq] = v.x; T[kk * 65 + cq + 1] = v.y; T[kk * 65 + cq + 2] = v.z; T[kk * 65 + cq + 3] = v.w;
            }
        } else {
            const int cq = tid & 15, kg = tid >> 4; const int j = nt * 64 + cq * 4;
            f32x4 a0 = (f32x4){0.f, 0.f, 0.f, 0.f}, a1 = a0, a2 = a0;
            const float* w = p.w_ada + ((size_t)l * D + kg * (D / 16)) * 3 * D + j;
#pragma unroll 8
            for (int k = 0; k < D / 16; ++k) { const f32x4 wv = *(const f32x4*)(w + (size_t)k * 3 * D); const int kk = kg * (D / 16) + k; a0 += wv * sc[kk]; a1 += wv * sc[D + kk]; if (NCOND > 2) a2 += wv * sc[2 * D + kk]; }
#pragma unroll
            for (int e = 0; e < 4; ++e) { T[(kg * 3 + 0) * 65 + cq * 4 + e] = a0[e]; T[(kg * 3 + 1) * 65 + cq * 4 + e] = a1[e]; T[(kg * 3 + 2) * 65 + cq * 4 + e] = a2[e]; }
        }
        BLOCK_SYNC();
        if (!ghost) {
            if (type == 0) {
                const int n = tid >> 2, kc = (tid & 3) * 16;
                u32x4 w0, w1;
                w0.x = pk2(T[(kc + 0) * 65 + n], T[(kc + 1) * 65 + n]); w0.y = pk2(T[(kc + 2) * 65 + n], T[(kc + 3) * 65 + n]);
                w0.z = pk2(T[(kc + 4) * 65 + n], T[(kc + 5) * 65 + n]); w0.w = pk2(T[(kc + 6) * 65 + n], T[(kc + 7) * 65 + n]);
                w1.x = pk2(T[(kc + 8) * 65 + n], T[(kc + 9) * 65 + n]); w1.y = pk2(T[(kc + 10) * 65 + n], T[(kc + 11) * 65 + n]);
                w1.z = pk2(T[(kc + 12) * 65 + n], T[(kc + 13) * 65 + n]); w1.w = pk2(T[(kc + 14) * 65 + n], T[(kc + 15) * 65 + n]);
                bf16* d = dst + (size_t)n * ldk + k0 + kc;
                *(u32x4*)d = w0; *(u32x4*)(d + 8) = w1;
            } else if (tid < 64 * NCOND) {
                const int col = tid & 63, cc = tid >> 6; const int j = nt * 64 + col;
                float v = 0.f;
#pragma unroll
                for (int kg = 0; kg < 16; ++kg) v += T[(kg * 3 + cc) * 65 + col];
                p.ada[((size_t)l * NCOND + cc) * 3 * D + j] = v + p.b_ada[(size_t)l * 3 * D + j];
            }
        }
    }
}

__device__ __forceinline__ void prep2_body(const Params& p, const Ctx& c) {
    const size_t gtid = (size_t)c.vb * 256 + c.tid, gsz = (size_t)c.nvb * 256;
    for (size_t i = gtid; i < (size_t)DEPTH * NCOND * D; i += gsz) {
        const int k = (int)(i % D); const size_t lc = i / D; const int l = (int)(lc / NCOND);
        p.gsv[i] = p.norm_g[(size_t)l * D + k] * (1.0f + p.ada[lc * 3 * D + D + k]);
    }
    constexpr int KS = 16, KL = D / KS, NB = (NPAD + 255) / 256;
    float* sh = (float*)c.smem;
    for (int _k = 0, _b; (_b = item_base<2>(c, _k, DEPTH * KS * NB)) >= 0; ++_k) {
        int it = _b + (c.vb & 1); const bool ghost = it >= DEPTH * KS * NB; if (ghost) it = DEPTH * KS * NB - 1;
        const int nb = it % NB, kq = (it / NB) % KS, l = it / (NB * KS);
        BLOCK_SYNC();
        for (int i = c.tid; i < NCOND * KL; i += 256) sh[i] = p.ada[((size_t)l * NCOND + i / KL) * 3 * D + kq * KL + i % KL];
        BLOCK_SYNC();
        const int n = nb * 256 + c.tid;
        const int oc = n < 1536 ? n : (n < NPROJ ? n + 16 : (n < NPROJ + 16 ? 1536 + (n - NPROJ) : -1));
        if (ghost || n >= NPAD || oc < 0) continue;
        float a[NCOND];
#pragma unroll
        for (int cc = 0; cc < NCOND; ++cc) a[cc] = 0.f;
        const float* wp = p.w_in + ((size_t)l * D + kq * KL) * D_IN_PROJ + oc;
#pragma unroll 4
        for (int k4 = 0; k4 < KL; k4 += 4) {
            const float w0 = wp[(size_t)(k4 + 0) * D_IN_PROJ], w1 = wp[(size_t)(k4 + 1) * D_IN_PROJ], w2 = wp[(size_t)(k4 + 2) * D_IN_PROJ], w3 = wp[(size_t)(k4 + 3) * D_IN_PROJ];
#pragma unroll
            for (int cc = 0; cc < NCOND; ++cc) { const f32x4 s = *(const f32x4*)(sh + cc * KL + k4); a[cc] += s[0] * w0 + s[1] * w1 + s[2] * w2 + s[3] * w3; }
        }
#pragma unroll
        for (int cc = 0; cc < NCOND; ++cc) atomicAdd(p.sW + ((size_t)l * NCOND + cc) * NPAD + n, a[cc]);
    }
    const int lane = c.lane, wave = c.wave;
    for (int tok0 = c.vb * 4; tok0 < NTOK; tok0 += c.nvb * 4) {
        const int tok = tok0 + wave; const int cnd = cond_of(tok);
        const float* xr = xrow_in(p, 0, tok);
        float ss = 0.f;
#pragma unroll
        for (int j = 0; j < D / 64; ++j) {
            const int k = j * 64 + lane; const float v = xr[k]; ss += v * v;
            p.xg[(size_t)tok * D + k] = f2bf(v * p.norm_g[k] * (1.0f + p.ada[(size_t)cnd * 3 * D + D + k]));
        }
#pragma unroll
        for (int o = 1; o < 64; o <<= 1) ss += __shfl_xor(ss, o);
        if (lane == 0) p.sumsq[tok] = ss;
    }
}
__device__ __forceinline__ void input_sumsq_body_unused(const Params& p, const Ctx& c) {
    const int lane = c.lane, wave = c.wave;
    for (int tok0 = c.vb * 4; tok0 < NTOK; tok0 += c.nvb * 4) {
        const int tok = tok0 + wave;
        const float* xr = xrow_in(p, 0, tok);
        float ss = 0.f;
#pragma unroll
        for (int j = 0; j < D / 64; ++j) { const float v = xr[j * 64 + lane]; ss += v * v; }
#pragma unroll
        for (int o = 1; o < 64; o <<= 1) ss += __shfl_xor(ss, o);
        if (lane == 0) p.sumsq[tok] = ss;
    }
}

constexpr int GLD = 72;
template <int TOK> constexpr int gemm_lds() { return 2 * (128 + TOK) * GLD * 2; }
constexpr int GEMM_LDS = gemm_lds<128>();
constexpr int OUT_TOK = (NTOK % 96 == 0) ? 96 : 128;
static_assert(GEMM_LDS <= HALF_LDS, "GEMM LDS");
struct XSrc { const bf16* X; int ldx; const Params* p; int l; };
__device__ __forceinline__ u32x2 pack4(const f32x4 v);
__device__ __forceinline__ f32x4 unpack4(const u32x2 w);
template <int TOK, int MODE, class Epi>
__device__ __forceinline__ void gemm_body(const XSrc xs, const bf16* W, int ldw, int M, int N, int K, const Epi& epi, const Ctx& c) {
    constexpr int NT = TOK / 32;
    constexpr int XCH = TOK * 8 / 256;
    bf16* const lds = (bf16*)c.smem;
    constexpr int STG = (128 + TOK) * GLD, XOFF = 128 * GLD;
    const int tid = c.tid, lane = c.lane, wave = c.wave, wr = wave >> 1, wc = wave & 1;
    const int nM = M / TOK, nN = N / 128, ntiles = nM * nN;
    const Params& p = *xs.p; const int l = xs.l;
    for (int _k = 0, _b; (_b = item_base<2>(c, _k, ntiles)) >= 0; ++_k) {
        int tile = _b + (c.vb & 1); const bool ghost = tile >= ntiles; if (ghost) tile = ntiles - 1;
        const int tm = tile / nN, tn = tile % nN;
        const bf16* Wg = W + (size_t)tn * 128 * ldw;
        f32x4 acc[4][NT]; zero_acc(acc);
        u32x4 rw[4], rxa[XCH], rxb[XCH], rxc[XCH];
        (void)rxb; (void)rxc;
        const int r0 = tid >> 3, ck = tid & 7;
#define GEMM_ISSUE(k0_) do { \
            _Pragma("unroll") for (int i = 0; i < 4; ++i) rw[i] = *(const u32x4*)(Wg + (size_t)(r0 + 32 * i) * ldw + (k0_) + ck * 8); \
            const int kk = (k0_) + ck * 8; \
            _Pragma("unroll") for (int i = 0; i < XCH; ++i) { \
                const int row = tm * TOK + r0 + 32 * i; \
                if (MODE == 0) rxa[i] = *(const u32x4*)(xs.X + (size_t)row * xs.ldx + kk); \
                else if (kk >= 256 && kk < 512) { \
                    rxa[i] = *(const u32x4*)(p.obuf + (size_t)row * 256 + kk - 256); \
                    rxb[i] = *(const u32x4*)(p.obuf + ((size_t)NTOK + row) * 256 + kk - 256); \
                    rxc[i] = *(const u32x4*)(p.proj + (size_t)row * NPROJ + DZ + kk - 256); \
                } else rxa[i] = *(const u32x4*)(p.mix + (size_t)row * DMIX + kk); \
            } \
        } while (0)
#define GEMM_FINISH(dst_, i, k0_) do { \
            u32x4 o_ = rxa[i]; const int kk = (k0_) + ck * 8; \
            if (MODE == 2 && kk >= 256 && kk < 512) {     \
                const u32x4 a_ = rxa[i], b_ = rxb[i], z_ = rxc[i]; \
                const f32x4 v0 = unpack4((u32x2){a_.x, a_.y}) + unpack4((u32x2){b_.x, b_.y}), v1 = unpack4((u32x2){a_.z, a_.w}) + unpack4((u32x2){b_.z, b_.w}); \
                float ss = v0[0] * v0[0] + v0[1] * v0[1] + v0[2] * v0[2] + v0[3] * v0[3] + v1[0] * v1[0] + v1[1] * v1[1] + v1[2] * v1[2] + v1[3] * v1[3]; \
                ss += __shfl_xor(ss, 1); ss += __shfl_xor(ss, 2); ss += __shfl_xor(ss, 4); \
                const float rn = 1.0f / sqrtf(ss / 64.f + EPS); \
                const f32x4 z0 = unpack4((u32x2){z_.x, z_.y}), z1 = unpack4((u32x2){z_.z, z_.w}); \
                const float* gg = p.dn_norm_g + l * 64 + ck * 8; \
                f32x4 y0, y1; \
                _Pragma("unroll") for (int e = 0; e < 4; ++e) { y0[e] = v0[e] * rn * gg[e] * silu_f(z0[e]); y1[e] = v1[e] * rn * gg[4 + e] * silu_f(z1[e]); } \
                const u32x2 w0 = pack4(y0), w1 = pack4(y1); o_ = (u32x4){w0.x, w0.y, w1.x, w1.y}; \
            } \
            *(u32x4*)(dst_) = o_; \
        } while (0)
        GEMM_ISSUE(0);
        BLOCK_SYNC();
#pragma unroll
        for (int i = 0; i < 4; ++i) *(u32x4*)(lds + (r0 + 32 * i) * GLD + ck * 8) = rw[i];
#pragma unroll
        for (int i = 0; i < XCH; ++i) GEMM_FINISH(lds + XOFF + (r0 + 32 * i) * GLD + ck * 8, i, 0);
        BLOCK_SYNC();
        int cur = 0;
        for (int k0 = 0; k0 < K; k0 += 64) {
            const bool more = k0 + 64 < K;
            if (more) GEMM_ISSUE(k0 + 64);
            mma_tiles<4, NT>(acc, lds + cur * STG + wr * 64 * GLD, GLD, lds + cur * STG + XOFF + wc * (TOK / 2) * GLD, GLD, 64, lane);
            if (more) {
#pragma unroll
                for (int i = 0; i < 4; ++i) *(u32x4*)(lds + (cur ^ 1) * STG + (r0 + 32 * i) * GLD + ck * 8) = rw[i];
#pragma unroll
                for (int i = 0; i < XCH; ++i) GEMM_FINISH(lds + (cur ^ 1) * STG + XOFF + (r0 + 32 * i) * GLD + ck * 8, i, k0 + 64);
            }
            BLOCK_SYNC();
            cur ^= 1;
        }
        if (!ghost) {
#pragma unroll
            for (int nt = 0; nt < NT; ++nt) {
                const int row = tm * TOK + wc * (TOK / 2) + nt * 16 + (lane & 15);
                float ss = 0.f;
                const float rowv = epi.row_scalar(row);
                typename Epi::Pre pre[4];
#pragma unroll
                for (int mt = 0; mt < 4; ++mt) pre[mt] = epi.pre(row, tn * 128 + wr * 64 + mt * 16 + (lane >> 4) * 4);
#pragma unroll
                for (int mt = 0; mt < 4; ++mt) ss += epi(row, tn * 128 + wr * 64 + mt * 16 + (lane >> 4) * 4, acc[mt][nt], rowv, pre[mt]);
                if (Epi::ROWSUM) { ss += __shfl_xor(ss, 16); ss += __shfl_xor(ss, 32); if ((lane >> 4) == 0) epi.rowsum(row, ss); }
            }
        }
    }
}
__device__ __forceinline__ u32x2 pack4(const f32x4 v) { u32x2 w; w.x = pk2(v[0], v[1]); w.y = pk2(v[2], v[3]); return w; }
__device__ __forceinline__ f32x4 unpack4(const u32x2 w) { return (f32x4){bf2f((bf16)(w.x & 0xffff)), bf2f((bf16)(w.x >> 16)), bf2f((bf16)(w.y & 0xffff)), bf2f((bf16)(w.y >> 16))}; }
struct EpiProj {
    static constexpr bool ROWSUM = false;
    const Params* p; int l;
    __device__ __forceinline__ void rowsum(int, float) const {}
    __device__ __forceinline__ float row_scalar(int row) const { return 1.0f / sqrtf(p->sumsq[row] / (float)D + EPS); }
    struct Pre {}; __device__ __forceinline__ Pre pre(int, int) const { return Pre{}; }
    __device__ __forceinline__ float operator()(int row, int col0, const f32x4 acc, float rstd, const Pre&) const {
        const f32x4 v = acc * rstd + *(const f32x4*)(p->sW + ((size_t)l * NCOND + cond_of(row)) * NPAD + col0);
        if (col0 < NPROJ) *(u32x2*)(p->proj + (size_t)row * NPROJ + col0) = pack4(v);
        else if (col0 < NPROJ + 16) *(f32x4*)(p->gates + (size_t)row * 16 + (col0 - NPROJ)) = v;
        return 0.f;
    }
};
struct EpiOut {
    static constexpr bool ROWSUM = true;
    const Params* p; int l;
    __device__ __forceinline__ void rowsum(int row, float ss) const { atomicAdd(p->sumsq + row, ss); }
    __device__ __forceinline__ float row_scalar(int) const { return 0.f; }
    struct Pre {}; __device__ __forceinline__ Pre pre(int, int) const { return Pre{}; }
    __device__ __forceinline__ float operator()(int row, int col0, const f32x4 v, float, const Pre&) const {
        const f32x4 g = *(const f32x4*)(p->ada + ((size_t)l * NCOND + cond_of(row)) * 3 * D + 2 * D + col0);
        const f32x4 xi = l == 0 ? *(const f32x4*)(xrow_in(*p, 0, row) + col0) : unpack4(*(const u32x2*)(p->xb + (size_t)row * D + col0));
        const f32x4 xn = xi + g * v;
        if (l + 1 < DEPTH) {
            *(u32x2*)(p->xb + (size_t)row * D + col0) = pack4(xn);
            *(u32x2*)(p->xg + (size_t)row * D + col0) = pack4(xn * *(const f32x4*)(p->gsv + ((size_t)(l + 1) * NCOND + cond_of(row)) * D + col0));
        } else *(f32x4*)(p->out + (size_t)row * D + col0) = xn;
        return xn[0] * xn[0] + xn[1] * xn[1] + xn[2] * xn[2] + xn[3] * xn[3];
    }
};
struct EpiGlu {
    static constexpr bool ROWSUM = false;
    const Params* p; int l;
    __device__ __forceinline__ void rowsum(int, float) const {}
    __device__ __forceinline__ float row_scalar(int) const { return 0.f; }
    struct Pre { u32x2 y, z; f32x4 bb; };
    __device__ __forceinline__ Pre pre(int row, int col0) const {
        Pre q; q.y = *(const u32x2*)(p->ybuf + (size_t)row * 256 + col0); q.z = *(const u32x2*)(p->proj + (size_t)row * NPROJ + SZ + col0); q.bb = *(const f32x4*)(p->s5_glu_b + l * 256 + col0); return q;
    }
    __device__ __forceinline__ float operator()(int row, int col0, const f32x4 v, float, const Pre& q) const {
        const f32x4 y = unpack4(q.y), z = unpack4(q.z), bb = q.bb;
        f32x4 o;
#pragma unroll
        for (int i = 0; i < 4; ++i) o[i] = y[i] * sigmoid_f(v[i] + bb[i]) * silu_f(z[i]);
        *(u32x2*)(p->mix + (size_t)row * DMIX + 512 + col0) = pack4(o);
        return 0.f;
    }
};
struct EpiFt {
    static constexpr bool ROWSUM = false;
    const Params* p;
    __device__ __forceinline__ void rowsum(int, float) const {}
    __device__ __forceinline__ float row_scalar(int) const { return 0.f; }
    struct Pre { u32x2 z; };
    __device__ __forceinline__ Pre pre(int row, int col0) const { Pre q; q.z = *(const u32x2*)(p->proj + (size_t)row * NPROJ + FZ + col0); return q; }
    __device__ __forceinline__ float operator()(int row, int col0, const f32x4 v, float, const Pre& q) const {
        const f32x4 z = unpack4(q.z);
        f32x4 o;
#pragma unroll
        for (int i = 0; i < 4; ++i) o[i] = v[i] * silu_f(z[i]);
        *(u32x2*)(p->mix + (size_t)row * DMIX + 768 + col0) = pack4(o);
        return 0.f;
    }
};

constexpr int POOL_LDS = 64 * 72 * 2 + 64 * 68 * 4;
template <int W>
__device__ __forceinline__ void pool_item(const Params& p, int l, int ch, int g, bf16* Ps, float* Vs, int tid, int lane, int wave) {
    constexpr int HW = W / 2;
    const bool lat = ch >= NCH_CTX;
    const int pos = tid >> 2, q4 = tid & 3;
    const int cofs = PU + g * 64 + q4 * 16;
    float s[16]; u32x4 c0 = (u32x4){0u, 0u, 0u, 0u}, c1 = c0;
#pragma unroll
    for (int e = 0; e < 16; ++e) s[e] = 0.f;
    BLOCK_SYNC();
    if (!lat) {
        const int seq = ch / CPS_CTX, ci = ch % CPS_CTX; const size_t tok_seq = (size_t)seq * SEQ; const int t = ci * 64 + pos;
        int lo = t - HW; if (lo < 0) lo = 0; int hi = t - HW + W; if (hi > SEQ) hi = SEQ;
#pragma unroll
        for (int k = 0; k < W; ++k) {
            int tt = t - HW + k; const float m = (tt >= 0 && tt < SEQ) ? 1.f : 0.f; tt = tt < 0 ? 0 : (tt >= SEQ ? SEQ - 1 : tt);
            const u32x4 a0 = *(const u32x4*)(p.proj + (tok_seq + tt) * NPROJ + cofs), a1 = *(const u32x4*)(p.proj + (tok_seq + tt) * NPROJ + cofs + 8);
            if (k == HW) { c0 = a0; c1 = a1; }
            const f32x4 f0 = unpack4((u32x2){a0.x, a0.y}), f1 = unpack4((u32x2){a0.z, a0.w}), f2 = unpack4((u32x2){a1.x, a1.y}), f3 = unpack4((u32x2){a1.z, a1.w});
#pragma unroll
            for (int e = 0; e < 4; ++e) { s[e] += m * f0[e]; s[4 + e] += m * f1[e]; s[8 + e] += m * f2[e]; s[12 + e] += m * f3[e]; }
        }
        const float inv = 1.0f / (float)(hi - lo);
        const f32x4 u0 = unpack4((u32x2){c0.x, c0.y}), u1 = unpack4((u32x2){c0.z, c0.w}), u2 = unpack4((u32x2){c1.x, c1.y}), u3 = unpack4((u32x2){c1.z, c1.w});
        u32x4 w0, w1;
        w0.x = pk2(s[0] * inv - u0[0], s[1] * inv - u0[1]); w0.y = pk2(s[2] * inv - u0[2], s[3] * inv - u0[3]); w0.z = pk2(s[4] * inv - u1[0], s[5] * inv - u1[1]); w0.w = pk2(s[6] * inv - u1[2], s[7] * inv - u1[3]);
        w1.x = pk2(s[8] * inv - u2[0], s[9] * inv - u2[1]); w1.y = pk2(s[10] * inv - u2[2], s[11] * inv - u2[3]); w1.z = pk2(s[12] * inv - u3[0], s[13] * inv - u3[1]); w1.w = pk2(s[14] * inv - u3[2], s[15] * inv - u3[3]);
        *(u32x4*)(Ps + pos * 72 + q4 * 16) = w0; *(u32x4*)(Ps + pos * 72 + q4 * 16 + 8) = w1;
        BLOCK_SYNC(); BLOCK_SYNC();
    } else {
        const int b = (ch - NCH_CTX) / 64, r = (ch - NCH_CTX) % 64; const size_t tok_b = (size_t)NCTX + (size_t)b * DEC_SEQ; const int col = pos;
        int lor = r - HW; if (lor < 0) lor = 0; int hir = r - HW + W; if (hir > 64) hir = 64;
        const float invr = 1.0f / (float)(hir - lor);
#pragma unroll
        for (int k = 0; k < W; ++k) {
            int rr = r - HW + k; const float m = (rr >= 0 && rr < 64) ? 1.f : 0.f; rr = rr < 0 ? 0 : (rr > 63 ? 63 : rr);
            const u32x4 a0 = *(const u32x4*)(p.proj + (tok_b + rr * 64 + col) * NPROJ + cofs), a1 = *(const u32x4*)(p.proj + (tok_b + rr * 64 + col) * NPROJ + cofs + 8);
            if (k == HW) { c0 = a0; c1 = a1; }
            const f32x4 f0 = unpack4((u32x2){a0.x, a0.y}), f1 = unpack4((u32x2){a0.z, a0.w}), f2 = unpack4((u32x2){a1.x, a1.y}), f3 = unpack4((u32x2){a1.z, a1.w});
#pragma unroll
            for (int e = 0; e < 4; ++e) { s[e] += m * f0[e]; s[4 + e] += m * f1[e]; s[8 + e] += m * f2[e]; s[12 + e] += m * f3[e]; }
        }
#pragma unroll
        for (int e = 0; e < 16; e += 4) *(f32x4*)(Vs + col * 68 + q4 * 16 + e) = (f32x4){s[e] * invr, s[e + 1] * invr, s[e + 2] * invr, s[e + 3] * invr};
        BLOCK_SYNC();
        int lo = col - HW; if (lo < 0) lo = 0; int hi = col - HW + W; if (hi > 64) hi = 64;
        f32x4 h0 = (f32x4){0.f, 0.f, 0.f, 0.f}, h1 = h0, h2 = h0, h3 = h0;
        for (int cc = lo; cc < hi; ++cc) { const float* v = Vs + cc * 68 + q4 * 16; h0 += *(const f32x4*)v; h1 += *(const f32x4*)(v + 4); h2 += *(const f32x4*)(v + 8); h3 += *(const f32x4*)(v + 12); }
        const float inv = 1.0f / (float)(hi - lo);
        const u32x2 w0 = pack4(h0 * inv - unpack4((u32x2){c0.x, c0.y})), w1 = pack4(h1 * inv - unpack4((u32x2){c0.z, c0.w})), w2 = pack4(h2 * inv - unpack4((u32x2){c1.x, c1.y})), w3 = pack4(h3 * inv - unpack4((u32x2){c1.z, c1.w}));
        *(u32x4*)(Ps + col * 72 + q4 * 16) = (u32x4){w0.x, w0.y, w1.x, w1.y}; *(u32x4*)(Ps + col * 72 + q4 * 16 + 8) = (u32x4){w2.x, w2.y, w3.x, w3.y};
        BLOCK_SYNC();
    }
    {
        f32x4 acc[4][1]; zero_acc(acc);
        const size_t tok = (size_t)ch * 64 + wave * 16 + (lane & 15);
        f32x4 sc[4]; u32x2 zz[4];
#pragma unroll
        for (int mt = 0; mt < 4; ++mt) {
            const int d0 = g * 64 + mt * 16 + (lane >> 4) * 4;
            sc[mt] = *(const f32x4*)(p.pool_scale + l * 256 + d0); zz[mt] = *(const u32x2*)(p.proj + tok * NPROJ + PZ + d0);
        }
        mma_tiles_pf<4, 1, 2, true, false>(acc, p.poolwT + ((size_t)l * 4 + g) * 4096, 64, Ps + wave * 16 * 72, 72, lane);
#pragma unroll
        for (int mt = 0; mt < 4; ++mt) {
            const int d0 = g * 64 + mt * 16 + (lane >> 4) * 4;
            const f32x4 z = unpack4(zz[mt]);
            f32x4 o;
#pragma unroll
            for (int i = 0; i < 4; ++i) o[i] = acc[mt][0][i] * sc[mt][i] * silu_f(z[i]);
            *(u32x2*)(p.mix + tok * DMIX + d0) = pack4(o);
        }
    }
}
__device__ __forceinline__ void pool_body(const Params& p, int l, const Ctx& c) {
    bf16* Ps = (bf16*)c.smem;
    float* Vs = (float*)(c.smem + 64 * 72 * 2);
    const int wave = c.wave;
    for (int _k = 0, _b; (_b = item_base<2>(c, _k, NCH * 4)) >= 0; ++_k) {
        int item = _b + (c.vb & 1); if (item >= NCH * 4) item = NCH * 4 - 1;
        int tid = c.tid; LAUNDER_V(tid); const int lane = tid & 63;
        const int ch = NCH - 1 - item % NCH, g = 3 - item / NCH;
        switch (g) {
        case 0: pool_item<2>(p, l, ch, g, Ps, Vs, tid, lane, wave); break;
        case 1: pool_item<4>(p, l, ch, g, Ps, Vs, tid, lane, wave); break;
        case 2: pool_item<8>(p, l, ch, g, Ps, Vs, tid, lane, wave); break;
        default: pool_item<16>(p, l, ch, g, Ps, Vs, tid, lane, wave); break;
        }
    }
}

constexpr int FTC_ULD = 72, FTC_GLD = SEQ + 8;
constexpr int FTC_LDS = SEQ * FTC_ULD * 2 + 64 * FTC_GLD * 2;
__device__ __forceinline__ void ft_ctx_body(const Params& p, const Ctx& c) {
    bf16* Us = (bf16*)c.smem;
    bf16* GT = Us + SEQ * FTC_ULD;
    const int tid = c.tid, lane = c.lane, wave = c.wave;
    constexpr int MTW = SEQ / 64;
    constexpr int KQ = SEQ / 64;
    for (int _k = 0, _b; (_b = item_base<2>(c, _k, BATCH * 4 * KQ)) >= 0; ++_k) {
        int item = _b + (c.vb & 1); if (item >= (BATCH * 4 * KQ)) item = (BATCH * 4 * KQ) - 1;
        const int kq = item % KQ, bh = item / KQ, b = bh >> 2, h = bh & 3;
        BLOCK_SYNC();
        for (int i = tid; i < SEQ * 8; i += 256) { const int t = i >> 3, ck = i & 7; *(u32x4*)(Us + t * FTC_ULD + ck * 8) = *(const u32x4*)(p.proj + ((size_t)b * SEQ + t) * NPROJ + FU + h * 64 + ck * 8); }
        BLOCK_SYNC();
        f32x4 facc[4][1]; zero_acc(facc);
        const int kt0 = kq * 64 + wave * 16;
        for (int part = 0; part < 2; ++part) {
#pragma unroll 1
            for (int nh = 0; nh < 2; ++nh) {
                f32x4 g[MTW][2]; zero_acc(g);
                mma_tiles_pf<MTW, 2, 2, false, true>(g, Us + wave * (SEQ / 4) * FTC_ULD, FTC_ULD, p.tabDc + (part * 64 + nh * 32) * 64, 64, lane);
#pragma unroll
                for (int mt = 0; mt < MTW; ++mt)
#pragma unroll
                    for (int nt = 0; nt < 2; ++nt) {
                        const int kc = nh * 32 + nt * 16 + (lane & 15), t0 = wave * (SEQ / 4) + mt * 16 + (lane >> 4) * 4;
                        *(u32x2*)(GT + kc * FTC_GLD + t0) = pack4(g[mt][nt]);
                    }
            }
            BLOCK_SYNC();
            mma_tiles_pf<4, 1, SEQ / 32, false, true>(facc, GT, FTC_GLD, p.tabT + (size_t)kt0 * 2 * SEQ + part * SEQ, 2 * SEQ, lane);
            BLOCK_SYNC();
        }
        const float sc = 1.0f / sqrtf((float)SEQ * 64.f);
#pragma unroll
        for (int mt = 0; mt < 4; ++mt) {
            const int kt = kt0 + (lane & 15), kc0 = mt * 16 + (lane >> 4) * 4;
            *(u32x2*)(p.fbuf + ((size_t)b * SEQ + kt) * 256 + h * 64 + kc0) = pack4(facc[mt][0] * sc);
        }
    }
}

constexpr int FTA_XS = 0, FTA_Z1T = 64 * 72 * 2, FTA_R = FTA_Z1T + 64 * 136 * 2, FTA_E = FTA_R + 128 * 72 * 2;
constexpr int FTA_LDS = FTA_E + 128 * 136 * 2;
static_assert(FTA_LDS <= HALF_LDS, "ft_latA LDS");
__device__ __forceinline__ void ft_latA_body(const Params& p, const Ctx& c) {
    bf16* Xs = (bf16*)(c.smem + FTA_XS);
    bf16* Z1T = (bf16*)(c.smem + FTA_Z1T);
    bf16* R = (bf16*)(c.smem + FTA_R);
    bf16* Es = (bf16*)(c.smem + FTA_E);
    const int tid = c.tid, lane = c.lane, wave = c.wave;
    for (int _k = 0, _b; (_b = item_base<2>(c, _k, DEC_BATCH * 64)) >= 0; ++_k) {
        int item = _b + (c.vb & 1); if (item >= (DEC_BATCH * 64)) item = (DEC_BATCH * 64) - 1;
        const int b = item >> 6, t2 = item & 63;
        BLOCK_SYNC();
        for (int i = tid; i < 128 * 16; i += 256) { const int r = i >> 4, ck = i & 15; *(u32x4*)(Es + r * 136 + ck * 8) = *(const u32x4*)(p.tabE + r * 128 + ck * 8); }
        for (int h = 0; h < 4; ++h) {
            BLOCK_SYNC();
            for (int i = tid; i < 64 * 8; i += 256) { const int t1 = i >> 3, ck = i & 7; *(u32x4*)(Xs + t1 * 72 + ck * 8) = *(const u32x4*)(p.proj + ((size_t)NCTX + (size_t)b * DEC_SEQ + t1 * 64 + t2) * NPROJ + FU + h * 64 + ck * 8); }
            for (int i = tid; i < 128 * 8; i += 256) { const int r = i >> 3, ck = i & 7; *(u32x4*)(R + r * 72 + ck * 8) = *(const u32x4*)(p.tabDc + r * 64 + ck * 8); }
            BLOCK_SYNC();
            {
                f32x4 a[4][2]; zero_acc(a);
                mma_tiles<4, 2>(a, Xs, 72, R + wave * 32 * 72, 72, 64, lane);
#pragma unroll
                for (int mt = 0; mt < 4; ++mt)
#pragma unroll
                    for (int nt = 0; nt < 2; ++nt) {
                        const int n = wave * 32 + nt * 16 + (lane & 15), part = n >> 6, kc = n & 63, t10 = mt * 16 + (lane >> 4) * 4;
                        *(u32x2*)(Z1T + kc * 136 + part * 64 + t10) = pack4(a[mt][nt]);
                    }
            }
            BLOCK_SYNC();
            {
                f32x4 z[1][8]; zero_acc(z);
                mma_tiles<1, 8>(z, Z1T + wave * 16 * 136, 136, Es, 136, 128, lane);
#pragma unroll
                for (int nt = 0; nt < 4; ++nt) {
                    const int k1 = nt * 16 + (lane & 15); const int m = (t2 * k1) & 4095;
                    const float ang = 6.283185307179586f * (float)m / 4096.f; const float tc = fcos(ang), ts = fsin(ang);
                    const int kc0 = wave * 16 + (lane >> 4) * 4;
                    f32x4 re, im;
#pragma unroll
                    for (int r = 0; r < 4; ++r) { const float a = z[0][nt][r], bb = z[0][nt + 4][r]; re[r] = a * tc + bb * ts; im[r] = bb * tc - a * ts; }
                    *(u32x2*)(R + k1 * 72 + kc0) = pack4(re); *(u32x2*)(R + (64 + k1) * 72 + kc0) = pack4(im);
                }
            }
            BLOCK_SYNC();
#pragma unroll
            for (int it = 0; it < 4; ++it) {
                const int i = tid + 256 * it, row = i >> 3, ck = i & 7, part = row >> 6, k1 = row & 63;
                *(u32x4*)(p.Zg + ((((size_t)b * 64 + k1) * 128 + part * 64 + t2) * 256) + h * 64 + ck * 8) = *(const u32x4*)(R + row * 72 + ck * 8);
            }
        }
    }
}

constexpr int FTB_LDS = 256 * 136 * 2;
__device__ __forceinline__ void ft_latB_body(const Params& p, const Ctx& c) {
    bf16* Zs = (bf16*)c.smem;
    const int lane = c.lane, wave = c.wave;
    for (int _k = 0, _b; (_b = item_base<2>(c, _k, DEC_BATCH * 128)) >= 0; ++_k) {
        int item = _b + (c.vb & 1); if (item >= (DEC_BATCH * 128)) item = (DEC_BATCH * 128) - 1;
        const int nh = item & 1, k1 = (item >> 1) & 63, b = item >> 7;
        const bf16* zg = p.Zg + ((size_t)b * 64 + k1) * 128 * 256;
        BLOCK_SYNC();
        {
            const int k = (wave & 1) * 64 + lane;
            {
            u32x4 vv[8];
#pragma unroll
            for (int j = 0; j < 8; ++j) vv[j] = *(const u32x4*)(zg + (size_t)k * 256 + (nh * 16 + (wave >> 1) * 8 + j) * 8);
#pragma unroll
            for (int j = 0; j < 8; ++j) {
                const int n8 = (wave >> 1) * 8 + j;
                const u32x4 v = vv[j];
                bf16* dst = Zs + (n8 * 8) * 136 + k;
                dst[0 * 136] = (bf16)(v.x & 0xffff); dst[1 * 136] = (bf16)(v.x >> 16); dst[2 * 136] = (bf16)(v.y & 0xffff); dst[3 * 136] = (bf16)(v.y >> 16);
                dst[4 * 136] = (bf16)(v.z & 0xffff); dst[5 * 136] = (bf16)(v.z >> 16); dst[6 * 136] = (bf16)(v.w & 0xffff); dst[7 * 136] = (bf16)(v.w >> 16);
            }
            }
        }
        BLOCK_SYNC();
        f32x4 acc[2][4]; zero_acc(acc);
        mma_tiles_u<2, 4, 4>(acc, Zs + wave * 32 * 136, 136, p.tabE, 128, lane);
#pragma unroll
        for (int mt = 0; mt < 2; ++mt)
#pragma unroll
            for (int nt = 0; nt < 4; ++nt) {
                const int k2 = nt * 16 + (lane & 15), n0 = nh * 128 + wave * 32 + mt * 16 + (lane >> 4) * 4;
                *(u32x2*)(p.fbuf + ((size_t)NCTX + (size_t)b * DEC_SEQ + k1 + 64 * k2) * 256 + n0) = pack4(acc[mt][nt] * (1.0f / 512.f));
            }
    }
}

template <bool STORE>
__device__ __forceinline__ void s5_scan_pair(const Params& p, int l, int cp, int g, int d, int j, int lane, float& sr, float& si, bf16* Ss) {
    const int h = lane >> 5, n0 = lane & 31;
    const size_t ldg = ((size_t)l * 2 + d) * 16 + g;
    const size_t pi = ldg * 64 + j * 32 + n0;
    const float ar = p.abar[2 * pi], ai = p.abar[2 * pi + 1];
    const bf16* Bt = p.bbarT + ldg * 128 * 16;
#ifndef EMU
    const int m = lane & 31, mh = (m >> 2) & 1, mt4 = 4 * (m >> 3) + (m & 3);
    const bf16* Ua = p.proj + ((size_t)(2 * cp + mh) * 64) * NPROJ + SU + g * 16 + (lane >> 5) * 8;
    const bf16x8 bre = *(const bf16x8*)(Bt + (j * 32 + n0) * 16 + (lane >> 5) * 8), bim = *(const bf16x8*)(Bt + ((2 + j) * 32 + n0) * 16 + (lane >> 5) * 8);
    bf16x8 ua[4];
#pragma unroll
    for (int mt = 0; mt < 4; ++mt) { const int row = mt * 16 + mt4, tok = d ? 63 - row : row; ua[mt] = *(const bf16x8*)(Ua + (size_t)tok * NPROJ); }
#endif
    bf16* Sd = STORE ? Ss + h * 64 * 264 + d * 128 + j * 32 + n0 : nullptr;
#pragma unroll
    for (int mt = 0; mt < 4; ++mt) {
        f32x16 bur = (f32x16)(0.f), bui = (f32x16)(0.f);
#ifdef EMU
        for (int r = 0; r < 16; ++r) {
            const int row = mt * 16 + r, tok = d ? 63 - row : row;
            const bf16* u = p.proj + ((size_t)(2 * cp + h) * 64 + tok) * NPROJ + SU + g * 16;
            float s0 = 0.f, s1 = 0.f;
            for (int k = 0; k < 16; ++k) { s0 += bf2f(u[k]) * bf2f(Bt[(j * 32 + n0) * 16 + k]); s1 += bf2f(u[k]) * bf2f(Bt[((2 + j) * 32 + n0) * 16 + k]); }
            bur[r] = s0; bui[r] = s1;
        }
#else
        bur = __builtin_amdgcn_mfma_f32_32x32x16_bf16(ua[mt], bre, bur, 0, 0, 0);
        bui = __builtin_amdgcn_mfma_f32_32x32x16_bf16(ua[mt], bim, bui, 0, 0, 0);
#endif
#pragma unroll
        for (int r = 0; r < 16; ++r) {
            const float nr = ar * sr - ai * si + bur[r], ni = ar * si + ai * sr + bui[r];
            sr = nr; si = ni;
            if (STORE) { const int row = mt * 16 + r, t = d ? 63 - row : row; Sd[t * 264] = f2bf(sr); Sd[t * 264 + 64] = f2bf(si); }
        }
    }
}
constexpr int S5P1_LDS = 0;
__device__ __forceinline__ void s5_pass1_body(const Params& p, int l, const Ctx& c) {
    const int lane = c.lane, wave = c.wave;
    for (int _k = 0, _b; (_b = item_base<2>(c, _k, NCH * 8)) >= 0; ++_k) {
        const int grp = _b + (c.vb & 1); if (grp >= NCH * 8) continue;
        const int wi = grp * 4 + wave; const int j = wi & 1, d = (wi >> 1) & 1, g = (wi >> 2) & 15, cp = wi >> 6;
        float sr = 0.f, si = 0.f;
        s5_scan_pair<false>(p, l, cp, g, d, j, lane, sr, si, nullptr);
        float* E = p.s5E + (((size_t)(2 * cp + (lane >> 5)) * 16 + g) * 2 + d) * 128 + j * 32 + (lane & 31);
        E[0] = sr; E[64] = si;
    }
}
__device__ __forceinline__ void s5_carry_body(const Params& p, int l, const Ctx& c) {
    for (int _k = 0, _b; (_b = item_base<2>(c, _k, NSEQ * 8)) >= 0; ++_k) {
        const int chunk = _b + (c.vb & 1); if (chunk >= NSEQ * 8) continue;
        const int i = chunk * 256 + c.tid;
        const int n = i & 63, d = (i >> 6) & 1, g = (i >> 7) & 15, seq = i >> 11;
        const bool lat = seq >= BATCH; const int cps = lat ? CPS_LAT : CPS_CTX; const int ch0 = lat ? NCH_CTX + (seq - BATCH) * CPS_LAT : seq * CPS_CTX;
        const size_t pi = (((size_t)l * 2 + d) * 16 + g) * 64 + n;
        const float ar = p.abar64[2 * pi], ai = p.abar64[2 * pi + 1];
        float sr = 0.f, si = 0.f;
        if (lat) { const size_t o = ((((size_t)(seq - BATCH) * DEPTH + l) * 2 + d) * 2) * 1024 + g * 64 + n; sr = p.state_s5[o]; si = p.state_s5[o + 1024]; }
        for (int q0 = 0; q0 < cps; q0 += 4) {
            float er[4], ei[4]; size_t ee[4];
#pragma unroll
            for (int j = 0; j < 4; ++j) { const int ch = ch0 + (d ? cps - 1 - (q0 + j) : (q0 + j)); ee[j] = (((size_t)ch * 16 + g) * 2 + d) * 128 + n; er[j] = p.s5E[ee[j]]; ei[j] = p.s5E[ee[j] + 64]; }
#pragma unroll
            for (int j = 0; j < 4; ++j) {
                p.s5S[ee[j]] = sr; p.s5S[ee[j] + 64] = si;
                const float nr = ar * sr - ai * si + er[j], ni = ar * si + ai * sr + ei[j]; sr = nr; si = ni;
            }
        }
        if (!lat) { const size_t o = OUT_S5 + ((((size_t)seq * DEPTH + l) * 2 + d) * 2) * 1024 + g * 64 + n; p.out[o] = sr; p.out[o + 1024] = si; }
    }
}
constexpr int S5P3_LDS = 2 * 64 * 264 * 2;
__device__ __forceinline__ void s5_pass3_body(const Params& p, int l, const Ctx& c) {
    const int lane = c.lane, wave = c.wave, il = wave >> 1, d = wave & 1;
    bf16* Ss = (bf16*)c.smem + il * 64 * 264;
    for (int _k = 0, _b; (_b = item_base<2>(c, _k, NCH * 8)) >= 0; ++_k) {
        int grp = _b + (c.vb & 1); if (grp >= (NCH * 8)) grp = (NCH * 8) - 1;
        const int g = grp & 15, cp = grp >> 4, ch = 2 * cp + il;
        BLOCK_SYNC();
        const size_t e = (((size_t)(2 * cp + (lane >> 5)) * 16 + g) * 2 + d) * 128 + il * 32 + (lane & 31);
        float sr = p.s5S[e], si = p.s5S[e + 64];
        s5_scan_pair<true>(p, l, cp, g, d, il, lane, sr, si, (bf16*)c.smem);
        BLOCK_SYNC();
        f32x4 acc[2][1]; zero_acc(acc);
        bf16 uu[2][4]; const int pp = lane & 15;
#pragma unroll
        for (int mt = 0; mt < 2; ++mt)
#pragma unroll
            for (int r = 0; r < 4; ++r) uu[mt][r] = p.proj[((size_t)ch * 64 + d * 32 + mt * 16 + (lane >> 4) * 4 + r) * NPROJ + SU + g * 16 + pp];
        const float dsk = p.s5_d[l * 256 + g * 16 + pp];
        mma_tiles_pf<2, 1, 8, false, true>(acc, Ss + d * 32 * 264, 264, p.Cmat + ((size_t)l * 16 + g) * 4096, 256, lane);
#pragma unroll
        for (int mt = 0; mt < 2; ++mt)
#pragma unroll
            for (int r = 0; r < 4; ++r) {
                const int t = d * 32 + mt * 16 + (lane >> 4) * 4 + r;
                const float y = acc[mt][0][r] + dsk * bf2f(uu[mt][r]);
                p.ybuf[((size_t)ch * 64 + t) * 256 + g * 16 + pp] = f2bf(gelu_f(y));
            }
    }
}

constexpr int DN_STG = 0;
constexpr int DN_S1 = 0, DN_S2 = 18432;
constexpr int DN_AB = 36864;
constexpr int DN_QB = DN_AB + 9216, DN_KB = DN_QB + 9216, DN_VB = DN_KB + 9216;
constexpr int DN_SM = DN_VB + 8192;
constexpr int DN_TB = DN_SM + 5 * 64 * 4;
constexpr int DN1_LDS = DN_TB + 2048;
static_assert(DN1_LDS <= HALF_LDS, "DN1 LDS");
__device__ __forceinline__ void dn_d1_body(const Params& p, int l, const Ctx& c) {
    char* smem = c.smem;
    float* stq = (float*)(smem + DN_STG); float* stk = stq + 64 * 65;
    bf16* S1 = (bf16*)(smem + DN_S1); bf16* S2 = (bf16*)(smem + DN_S2);
    bf16* Ab = (bf16*)(smem + DN_AB);
    bf16* Qb = (bf16*)(smem + DN_QB); bf16* Kb = (bf16*)(smem + DN_KB); bf16* Vb = (bf16*)(smem + DN_VB);
    float* rq = (float*)(smem + DN_SM); float* rk = rq + 64; float* gs = rk + 64; float* bs = gs + 64; float* gcs = bs + 64;
    const int wave = c.wave;
    for (int _k = 0, _b; (_b = item_base<2>(c, _k, NCH * 8)) >= 0; ++_k) {
        int item = _b + (c.vb & 1); if (item >= (NCH * 8)) item = (NCH * 8) - 1;
        int tid = c.tid; LAUNDER_V(tid); const int lane = tid & 63;
        const int d = item & 1, h = (item >> 1) & 3, ch = item >> 3;
        const bool lat = ch >= NCH_CTX;
        const int cps = lat ? CPS_LAT : CPS_CTX; const int ci = lat ? (ch - NCH_CTX) % CPS_LAT : ch % CPS_CTX;
        const int lseq = cps * 64; const size_t tok_seq = (size_t)(ch - ci) * 64;
        BLOCK_SYNC();
        {
            bf16* Rw = (bf16*)(smem + DN_S1);
            float* Cw = (float*)(smem + DN_S1 + 68 * 200 * 2);
            {
                u32x4 v[7]; f32x4 cwv = (f32x4){0.f, 0.f, 0.f, 0.f};
#pragma unroll
                for (int j = 0; j < 7; ++j) {
                    const int i = tid + j * 256, row = i / 24, ck8 = i % 24, arr = ck8 >> 3, c8 = ck8 & 7;
                    const int pos = ci * 64 + row - 2;
                    v[j] = (u32x4){0u, 0u, 0u, 0u};
                    if (i < 68 * 24 && pos >= 0 && pos < lseq) v[j] = *(const u32x4*)(p.proj + (tok_seq + pos) * NPROJ + QKV + arr * 256 + h * 64 + c8 * 8);
                }
                const int cj = tid / 48, cq4 = tid % 48;
                if (tid < 5 * 48) cwv = *(const f32x4*)(p.dn_conv + ((size_t)l * 5 + cj) * 768 + (cq4 >> 4) * 256 + h * 64 + (cq4 & 15) * 4);
#pragma unroll
                for (int j = 0; j < 7; ++j) {
                    const int i = tid + j * 256, row = i / 24, ck8 = i % 24;
                    if (i < 68 * 24) *(u32x4*)(Rw + row * 200 + ck8 * 8) = v[j];
                }
                if (tid < 5 * 48) *(f32x4*)(Cw + cj * 192 + (cq4 >> 4) * 64 + (cq4 & 15) * 4) = cwv;
            }
            BLOCK_SYNC();
            const int jt = tid >> 2, cq = tid & 3, tau = d ? 63 - jt : jt;
#pragma unroll
            for (int arr = 0; arr < 3; ++arr) {
                float ss = 0.f; float o[16];
#pragma unroll
                for (int hf = 0; hf < 2; ++hf) {
                    const int cl = arr * 64 + cq * 16 + hf * 8;
                    float acc8[8];
#pragma unroll
                    for (int e = 0; e < 8; ++e) acc8[e] = 0.f;
#pragma unroll
                    for (int j = 0; j < 5; ++j) {
                        const u32x4 xv = *(const u32x4*)(Rw + (jt + j) * 200 + cl);
                        const f32x4 w0 = *(const f32x4*)(Cw + j * 192 + cl), w1 = *(const f32x4*)(Cw + j * 192 + cl + 4);
                        acc8[0] += w0[0] * bf2f((bf16)(xv.x & 0xffff)); acc8[1] += w0[1] * bf2f((bf16)(xv.x >> 16));
                        acc8[2] += w0[2] * bf2f((bf16)(xv.y & 0xffff)); acc8[3] += w0[3] * bf2f((bf16)(xv.y >> 16));
                        acc8[4] += w1[0] * bf2f((bf16)(xv.z & 0xffff)); acc8[5] += w1[1] * bf2f((bf16)(xv.z >> 16));
                        acc8[6] += w1[2] * bf2f((bf16)(xv.w & 0xffff)); acc8[7] += w1[3] * bf2f((bf16)(xv.w >> 16));
                    }
#pragma unroll
                    for (int e = 0; e < 8; ++e) { const float s = silu_f(acc8[e]); o[hf * 8 + e] = s; ss += s * s; }
                }
                float sc = 1.f;
                if (arr < 2) { ss += __shfl_xor(ss, 1); ss += __shfl_xor(ss, 2); sc = 1.0f / sqrtf(ss + EPS); }
                bf16* dst = arr == 0 ? Qb + tau * 72 + cq * 16 : (arr == 1 ? Kb + tau * 72 + cq * 16 : Vb + tau * 64 + cq * 16);
                u32x4 w0, w1;
                w0.x = pk2(o[0] * sc, o[1] * sc); w0.y = pk2(o[2] * sc, o[3] * sc); w0.z = pk2(o[4] * sc, o[5] * sc); w0.w = pk2(o[6] * sc, o[7] * sc);
                w1.x = pk2(o[8] * sc, o[9] * sc); w1.y = pk2(o[10] * sc, o[11] * sc); w1.z = pk2(o[12] * sc, o[13] * sc); w1.w = pk2(o[14] * sc, o[15] * sc);
                *(u32x4*)dst = w0; *(u32x4*)(dst + 8) = w1;
            }
            if (wave == 0) {
                const int tg = lane; const size_t tok = (size_t)ch * 64 + (d ? 63 - tg : tg);
                const float braw = p.gates[tok * 16 + d * 4 + h], araw = p.gates[tok * 16 + 8 + d * 4 + h];
                bs[tg] = sigmoid_f(braw);
                float g = -fexp(p.dn_a_log[(l * 2 + d) * 4 + h]) * softplus_f(araw + p.dn_dt_bias[(l * 2 + d) * 4 + h]);
#pragma unroll
                for (int o2 = 1; o2 < 64; o2 <<= 1) { const float up = __shfl(g, lane >= o2 ? lane - o2 : lane); g += lane >= o2 ? up : 0.f; }
                gcs[tg] = g;
            }
        }
        BLOCK_SYNC();
        const float gl = gcs[63];
        {
            f32x4 kk[1][4], qk[1][4]; zero_acc(kk); zero_acc(qk);
            mma_tiles<1, 4>(kk, Kb + wave * 16 * 72, 72, Kb, 72, 64, lane);
            mma_tiles<1, 4>(qk, Kb + wave * 16 * 72, 72, Qb, 72, 64, lane);
            BLOCK_SYNC();
            const int sg0 = wave * 16 + (lane >> 4) * 4;
            const f32x4 gsg = *(const f32x4*)(gcs + sg0);
#pragma unroll
            for (int nt = 0; nt < 4; ++nt) {
                const int tau = nt * 16 + (lane & 15); const float gt = gcs[tau], bt = bs[tau];
                f32x4 av, sv;
#pragma unroll
                for (int r = 0; r < 4; ++r) {
                    const int sg = sg0 + r;
                    const float dec = sg <= tau ? fexp(gt - gsg[r]) : 0.f;
                    av[r] = sg < tau ? -kk[0][nt][r] * dec * bt : 0.f;
                    sv[r] = qk[0][nt][r] * 0.125f * dec;
                }
                *(u32x2*)(Ab + tau * 72 + sg0) = pack4(av);
                *(u32x2*)(S1 + (64 + tau) * 72 + sg0) = pack4(sv);
            }
            for (int i = tid; i < 18432 / 16; i += 256) *(u32x4*)((char*)S2 + i * 16) = (u32x4){0u, 0u, 0u, 0u};
            const int tau = lane;
            const float kd = fexp(gl - gcs[tau]);
            {
                const u32x4 k0 = *(const u32x4*)(Kb + tau * 72 + wave * 16), k1 = *(const u32x4*)(Kb + tau * 72 + wave * 16 + 8);
#pragma unroll
                for (int e = 0; e < 16; ++e) S1[(wave * 16 + e) * 72 + tau] = f2bf(bf_at(k0, k1, e) * kd);
            }
        }
        BLOCK_SYNC();
        {
            bf16* Tb = (bf16*)(smem + DN_TB);
            if (wave == 0) {
                const int I = lane >> 4; float x[16]; const float fl = (float)(lane & 15);
#pragma unroll
                for (int r = 0; r < 16; ++r) {
                    const u32x4 a0 = *(const u32x4*)(Ab + (I * 16 + r) * 72 + I * 16), a1 = *(const u32x4*)(Ab + (I * 16 + r) * 72 + I * 16 + 8);
                    float s = fmaxf(1.f - fabsf(fl - (float)r), 0.f);
#pragma unroll
                    for (int k = 0; k < r; ++k) s += bf_at(a0, a1, k) * x[k];
                    x[r] = s;
                }
#pragma unroll
                for (int r = 0; r < 16; ++r) Tb[(I * 16 + r) * 16 + (lane & 15)] = f2bf(x[r]);
            }
            f32x4 rhs[4][2];
#pragma unroll
            for (int I = 0; I < 4; ++I)
#pragma unroll
                for (int nt = 0; nt < 2; ++nt)
#pragma unroll
                    for (int r = 0; r < 4; ++r) {
                        const int tau = I * 16 + (lane >> 4) * 4 + r, col = wave * 32 + nt * 16 + (lane & 15);
                        rhs[I][nt][r] = wave < 2 ? bf2f(Kb[tau * 72 + col]) * (bs[tau] * fexp(gcs[tau])) : bf2f(Vb[tau * 64 + col - 64]) * bs[tau];
                    }
            BLOCK_SYNC();
            bf16* Rt = (bf16*)(smem + DN_VB);
#pragma unroll
            for (int I = 0; I < 4; ++I) {
                f32x4 acc[1][2]; acc[0][0] = rhs[I][0]; acc[0][1] = rhs[I][1];
                if (I > 0) mma_tiles<1, 2>(acc, Ab + I * 16 * 72, 72, S2 + wave * 32 * 72, 72, I < 3 ? 32 : 64, lane);
#pragma unroll
                for (int nt = 0; nt < 2; ++nt) *(u32x2*)(Rt + (wave * 32 + nt * 16 + (lane & 15)) * 24 + (lane >> 4) * 4) = pack4(acc[0][nt]);
                WAVE_SYNC();
                f32x4 xa[1][2]; zero_acc(xa);
                mma_k16<2>(xa, Tb + I * 256, 16, Rt + wave * 32 * 24, 24, lane);
#pragma unroll
                for (int nt = 0; nt < 2; ++nt) *(u32x2*)(S2 + (wave * 32 + nt * 16 + (lane & 15)) * 72 + I * 16 + (lane >> 4) * 4) = pack4(xa[0][nt]);
                WAVE_SYNC();
            }
        }
        BLOCK_SYNC();
        {
            const size_t ib = (size_t)item * 4096;
            {
                f32x4 acc[1][8]; zero_acc(acc);
                mma_tiles<1, 8>(acc, S2 + wave * 16 * 72, 72, S1, 72, 64, lane);
                const int m0 = wave * 16 + (lane >> 4) * 4;
#pragma unroll
                for (int nt = 0; nt < 4; ++nt) { const int dk = nt * 16 + (lane & 15); *(u32x2*)(p.dnAp + ib + dk * 64 + m0) = pack4(-acc[0][nt]); }
#pragma unroll
                for (int nt = 4; nt < 8; ++nt) {
                    const int tau = (nt - 4) * 16 + (lane & 15); const float qs = 0.125f * fexp(gcs[tau]);
                    const f32x4 qe = unpack4(*(const u32x2*)(Qb + tau * 72 + m0));
                    *(u32x2*)(p.dnQh + ib + tau * 64 + m0) = pack4(qe * qs - acc[0][nt]);
                }
            }
            {
                f32x4 acc[1][4]; zero_acc(acc);
                mma_tiles<1, 4>(acc, S1 + wave * 16 * 72, 72, S2 + 64 * 72, 72, 64, lane);
#pragma unroll
                for (int nt = 0; nt < 4; ++nt) { const int dv = nt * 16 + (lane & 15); *(u32x2*)(p.dnBT + ib + dv * 64 + wave * 16 + (lane >> 4) * 4) = pack4(acc[0][nt]); }
            }
            {
                f32x4 acc[1][4]; zero_acc(acc);
                mma_tiles<1, 4>(acc, S2 + (64 + wave * 16) * 72, 72, S1 + 64 * 72, 72, 64, lane);
#pragma unroll
                for (int nt = 0; nt < 4; ++nt) { const int tau = nt * 16 + (lane & 15); *(u32x2*)(p.dnOT + ib + tau * 64 + wave * 16 + (lane >> 4) * 4) = pack4(acc[0][nt]); }
            }
            if (tid == 0) p.dnEgl[item] = fexp(gl);
        }
    }
}
constexpr int DN2_LDS = 2 * 16 * 72 * 2;
struct ScanOps {
#ifdef EMU
    const bf16 *ap, *qh;
#else
    bf16x8 ap[2], qh[2];
#endif
    u32x2 bt, ot; float egl;
};
__device__ __forceinline__ void scan_load(ScanOps& o, const Params& p, int item, int wave, int cg, int lane) {
    const size_t ib = (size_t)item * 4096;
#ifdef EMU
    o.ap = p.dnAp + ib + wave * 16 * 64; o.qh = p.dnQh + ib + wave * 16 * 64;
#else
#pragma unroll
    for (int ks = 0; ks < 2; ++ks) {
        o.ap[ks] = *(const bf16x8*)(p.dnAp + ib + (wave * 16 + (lane & 15)) * 64 + ks * 32 + (lane >> 4) * 8);
        o.qh[ks] = *(const bf16x8*)(p.dnQh + ib + (wave * 16 + (lane & 15)) * 64 + ks * 32 + (lane >> 4) * 8);
    }
#endif
    o.bt = *(const u32x2*)(p.dnBT + ib + (cg * 16 + (lane & 15)) * 64 + wave * 16 + (lane >> 4) * 4);
    o.ot = *(const u32x2*)(p.dnOT + ib + (wave * 16 + (lane & 15)) * 64 + cg * 16 + (lane >> 4) * 4);
    o.egl = p.dnEgl[item];
}
__device__ __forceinline__ void scan_mma_s(f32x4 (&acc)[1][1], const ScanOps& o, const bf16* STq, int lane) {
#ifdef EMU
    mma_tiles<1, 1>(acc, o.ap, 64, STq, 72, 64, lane);
#else
#pragma unroll
    for (int ks = 0; ks < 2; ++ks) {
        const bf16x8 b = *(const bf16x8*)(STq + (lane & 15) * 72 + ks * 32 + (lane >> 4) * 8);
        acc[0][0] = __builtin_amdgcn_mfma_f32_16x16x32_bf16(o.ap[ks], b, acc[0][0], 0, 0, 0);
    }
#endif
}
__device__ __forceinline__ void scan_mma_o(f32x4 (&acc)[1][1], const ScanOps& o, const bf16* STq, int lane) {
#ifdef EMU
    mma_tiles<1, 1>(acc, STq, 72, o.qh, 64, 64, lane);
#else
#pragma unroll
    for (int ks = 0; ks < 2; ++ks) {
        const bf16x8 a = *(const bf16x8*)(STq + (lane & 15) * 72 + ks * 32 + (lane >> 4) * 8);
        acc[0][0] = __builtin_amdgcn_mfma_f32_16x16x32_bf16(a, o.qh[ks], acc[0][0], 0, 0, 0);
    }
#endif
}
__device__ __forceinline__ void dn_scan_body(const Params& p, int l, const Ctx& c, int first, int last, int wg, int nwg) {
    const int lane = c.lane, wave = c.wave, hb = c.vb & 1;
    bf16* STh = (bf16*)c.smem;
    for (int _k = 0, _b; (_b = (c.q ? item_base<1>(c, _k, (last - first) * 2) : (wg + _k * nwg < (last - first) * 2 ? wg + _k * nwg : -1))) >= 0; ++_k) {
        const int chain = first + (_b >> 1), cg = (_b & 1) * 2 + hb;
        const int d = chain & 1, h = (chain >> 1) & 3, seq = chain >> 3;
        const bool lat = seq >= BATCH; const int cps = lat ? CPS_LAT : CPS_CTX; const int ch0 = lat ? NCH_CTX + (seq - BATCH) * CPS_LAT : seq * CPS_CTX;
        f32x4 S[1][1];
#pragma unroll
        for (int r = 0; r < 4; ++r) {
            const int dk = wave * 16 + (lane >> 4) * 4 + r, dv = cg * 16 + (lane & 15);
            S[0][0][r] = lat ? p.state_delta[(((((size_t)(seq - BATCH) * DEPTH + l) * 2 + d) * 4 + h) * 64 + dk) * 64 + dv] : 0.f;
        }
#define SCAN_ITEM(qq) ((((ch0 + (d ? cps - 1 - ((qq) < cps ? (qq) : cps - 1) : ((qq) < cps ? (qq) : cps - 1))) * 4 + h) * 2) + d)
#define SCAN_STEP(ops, qq) do { \
            const int ch = ch0 + (d ? cps - 1 - (qq) : (qq)); \
            bf16* const STq = STh + ((qq) & 1) * (16 * 72);     \
            *(u32x2*)(STq + (lane & 15) * 72 + wave * 16 + (lane >> 4) * 4) = pack4(S[0][0]); \
            BLOCK_SYNC(); \
            f32x4 Sn[1][1], O[1][1]; \
            Sn[0][0] = S[0][0] * ops.egl + unpack4(ops.bt); O[0][0] = unpack4(ops.ot); \
            scan_mma_s(Sn, ops, STq, lane); \
            scan_mma_o(O, ops, STq, lane); \
            { const int tau = wave * 16 + (lane & 15); const size_t tok = (size_t)ch * 64 + (d ? 63 - tau : tau); \
              *(u32x2*)(p.obuf + ((size_t)d * NTOK + tok) * 256 + h * 64 + cg * 16 + (lane >> 4) * 4) = pack4(O[0][0]); } \
            S[0][0] = Sn[0][0]; \
        } while (0)
        BLOCK_SYNC();
        ScanOps o0, o1, o2, o3;
        scan_load(o0, p, SCAN_ITEM(0), wave, cg, lane); scan_load(o1, p, SCAN_ITEM(1), wave, cg, lane); scan_load(o2, p, SCAN_ITEM(2), wave, cg, lane);
#pragma unroll 1
        for (int q = 0; q < cps; q += 4) {
            scan_load(o3, p, SCAN_ITEM(q + 3), wave, cg, lane); SCHED_BARRIER(); SCAN_STEP(o0, q); SCHED_BARRIER();
            scan_load(o0, p, SCAN_ITEM(q + 4), wave, cg, lane); SCHED_BARRIER(); SCAN_STEP(o1, q + 1); SCHED_BARRIER();
            scan_load(o1, p, SCAN_ITEM(q + 5), wave, cg, lane); SCHED_BARRIER(); SCAN_STEP(o2, q + 2); SCHED_BARRIER();
            scan_load(o2, p, SCAN_ITEM(q + 6), wave, cg, lane); SCHED_BARRIER(); SCAN_STEP(o3, q + 3); SCHED_BARRIER();
        }
#undef SCAN_STEP
#undef SCAN_ITEM
        if (!lat) {
#pragma unroll
            for (int r = 0; r < 4; ++r) {
                const int dk = wave * 16 + (lane >> 4) * 4 + r, dv = cg * 16 + (lane & 15);
                p.out[OUT_DN + (((((size_t)seq * DEPTH + l) * 2 + d) * 4 + h) * 64 + dk) * 64 + dv] = S[0][0][r];
            }
        }
    }
}
static_assert(CPS_CTX % 4 == 0, "scan ring assumes chunk counts divisible by 4");
__device__ __forceinline__ void dn_d3_body(const Params& p, int l, const Ctx& c) {
    const int lane = c.lane, wave = c.wave;
    constexpr int UB = 6;
    const int q0 = (lane & 15) * 4;
    const size_t tstep = (size_t)c.nvb * 4;
    for (size_t tok0 = (size_t)c.vb * 4 + wave; tok0 < (size_t)NTOK; tok0 += tstep * UB) {
        const f32x4 gn = *(const f32x4*)(p.dn_norm_g + l * 64 + q0);
        u32x2 a[UB], b[UB], zz[UB];
#pragma unroll
        for (int j = 0; j < UB; ++j) {
            const size_t tok = tok0 + tstep * j;
            a[j] = b[j] = zz[j] = (u32x2){0u, 0u};
            if (tok < (size_t)NTOK) { a[j] = *(const u32x2*)(p.obuf + tok * 256 + lane * 4); b[j] = *(const u32x2*)(p.obuf + ((size_t)NTOK + tok) * 256 + lane * 4); zz[j] = *(const u32x2*)(p.proj + tok * NPROJ + DZ + lane * 4); }
        }
#pragma unroll
        for (int j = 0; j < UB; ++j) {
            const size_t tok = tok0 + tstep * j;
            const f32x4 v = unpack4(a[j]) + unpack4(b[j]), z = unpack4(zz[j]);
            float ss = v[0] * v[0] + v[1] * v[1] + v[2] * v[2] + v[3] * v[3];
            ss += __shfl_xor(ss, 1); ss += __shfl_xor(ss, 2); ss += __shfl_xor(ss, 4); ss += __shfl_xor(ss, 8);
            const float rs = 1.0f / sqrtf(ss / 64.f + EPS);
            f32x4 y;
#pragma unroll
            for (int i = 0; i < 4; ++i) y[i] = v[i] * rs * gn[i] * silu_f(z[i]);
            if (tok < (size_t)NTOK) *(u32x2*)(p.mix + tok * DMIX + 256 + lane * 4) = pack4(y);
        }
    }
}

__device__ __forceinline__ void final_norm_body(const Params& p, const Ctx& c) {
    const int lane = c.lane, wave = c.wave;
    for (int tok0 = c.vb * 4; tok0 < NTOK; tok0 += c.nvb * 4) {
        const int tok = tok0 + wave;
        float* xr = p.out + (size_t)tok * D;
        const float rs = 1.0f / sqrtf(p.sumsq[tok] / (float)D + EPS);
        float xv[D / 64], gv[D / 64];
#pragma unroll
        for (int j = 0; j < D / 64; ++j) { xv[j] = xr[j * 64 + lane]; gv[j] = p.final_g[j * 64 + lane]; }
#pragma unroll
        for (int j = 0; j < D / 64; ++j) xr[j * 64 + lane] = xv[j] * rs * gv[j];
    }
}

#ifndef EMU
namespace pg8 {
#define PG8_LAS __attribute__((address_space(3)))
typedef unsigned short bf16_t;
typedef short bf16x8 __attribute__((ext_vector_type(8)));
typedef float f32x4 __attribute__((ext_vector_type(4)));
typedef unsigned u32x4 __attribute__((ext_vector_type(4)));
constexpr int BM = 256, BK = 64, HALF = 128, HTB = HALF * BK * 2  , STAGE_BYTES = 8 * HTB, NXCD = 8, WGM = 8;

__host__ __device__ __forceinline__ int lds_byte(int r, int c) { const int st = (r >> 4) * 2 + (c >> 5), rr = r & 15, cc = c & 31, ob = rr * 64 + cc * 2; return st * 1024 + (ob ^ (((ob >> 9) & 1) << 5)); }
__host__ __device__ __forceinline__ void stage_rc(int b, int& R, int& C) { const int st = b / 1024, sb = b % 1024, swz = sb ^ (((sb >> 9) & 1) << 5); R = (st >> 1) * 16 + swz / 64; C = (st & 1) * 32 + (swz % 64) / 2; }
__host__ __device__ __forceinline__ int perm32(int rho) { const int n = rho >> 4, i = rho & 15; return 8 * (i >> 2) + 4 * n + (i & 3); }

struct Unit { int pm, pn; };
struct Gemm { const bf16_t* A; const bf16_t* Bt; int M, N, K; };

struct StaticOrder {
    int nM, nN, nwg, G, c;
    __host__ __device__ void init(int M, int N, int G_, int c_) { nM = M / BM; nN = N / BM; nwg = nM * nN; G = G_; c = c_; }
    __host__ __device__ bool next(int i, Unit& u) const {
        const long L = (long)i * G + c; if (L >= nwg) return false;
        int wgid = (int)L; { const int q = nwg / NXCD, r = nwg % NXCD, xcd = wgid % NXCD, off = wgid / NXCD; wgid = (xcd < r ? xcd * (q + 1) : r * (q + 1) + (xcd - r) * q) + off; }
        const int nig = WGM * nN, gid = wgid / nig, fm = gid * WGM, gsz = (nM - fm) < WGM ? (nM - fm) : WGM;
        u.pm = fm + ((wgid % nig) % gsz); u.pn = (wgid % nig) / gsz; return true;
    }
    __device__ __forceinline__ void a_ready(const Unit&) const {}
    __device__ __forceinline__ void done(const Unit&) const {}
};


template <class Epi, class Sched, bool ALIGN_EPI = false, bool SP2 = false>
__device__ __forceinline__ void gemm_phase(PG8_LAS unsigned char* lds, const Gemm g, const Sched& S, const Epi& E) {
    int tid = threadIdx.x; asm volatile("" : "+v"(tid));
    const int wid = __builtin_amdgcn_readfirstlane(tid >> 6), lane = tid & 63, wr = wid >> 2, wc = wid & 3, fr = lane & 15, fq = lane >> 4;
    const int K = g.K, nt = K / BK;
    unsigned voffA[2], voffB[2];
#pragma unroll
    for (int i = 0; i < 2; ++i) { int R, C; stage_rc(tid * 16 + i * 8192, R, C); const int Rb = Epi::PERM ? ((R & ~31) + perm32(R & 31)) : R;
        voffA[i] = (unsigned)(R * K + C) * 2u; voffB[i] = (unsigned)(Rb * K + C) * 2u; }
    const size_t kstep = (size_t)(BK * 2);
    const size_t hstep = (size_t)HALF * K * 2;
    const size_t tstep = 2 * hstep;
    const unsigned ldsw = (unsigned)wid * 1024u;
    const int aoff = lds_byte(wr * 64 + fr, fq * 8), boff = lds_byte(wc * 32 + fr, fq * 8);
#define PG8_SA(b, h) (((b) * 2 + (h)) * HTB)
#define PG8_SB(b, h) ((4 + (b) * 2 + (h)) * HTB)
#define PG8_STAGE(bufoff, gbase, voff) do { _Pragma("unroll") for (int _i = 0; _i < 2; ++_i) \
        __builtin_amdgcn_global_load_lds((const unsigned*)((const char*)(gbase) + (voff)[_i]), (PG8_LAS unsigned*)(lds + (bufoff) + ldsw + _i * 8192), 16, 0, 0); } while (0)
#define PG8_LDA(dst, b, h) do { _Pragma("unroll") for (int m = 0; m < 4; ++m) _Pragma("unroll") for (int k = 0; k < 2; ++k) dst[m][k] = *(const PG8_LAS bf16x8*)(lds + PG8_SA(b, h) + aoff + m * 2048 + k * 1024); } while (0)
#define PG8_LDB(dst, b, h) do { _Pragma("unroll") for (int n = 0; n < 2; ++n) _Pragma("unroll") for (int k = 0; k < 2; ++k) dst[n][k] = *(const PG8_LAS bf16x8*)(lds + PG8_SB(b, h) + boff + n * 2048 + k * 1024); } while (0)
#define PG8_MMA(ai, bj, At, Bt) do { __builtin_amdgcn_s_setprio(1); _Pragma("unroll") for (int m = 0; m < 4; ++m) _Pragma("unroll") for (int n = 0; n < 2; ++n) _Pragma("unroll") for (int k = 0; k < 2; ++k) \
        acc[ai][bj][m][n] = __builtin_amdgcn_mfma_f32_16x16x32_bf16(Bt[n][k], At[m][k], acc[ai][bj][m][n], 0, 0, 0); __builtin_amdgcn_s_setprio(0); } while (0)
#define PG8_WAIT_V(n) asm volatile("s_waitcnt vmcnt(" #n ")" ::: "memory")
#define PG8_WAIT_L(n) asm volatile("s_waitcnt lgkmcnt(" #n ")" ::: "memory")
#define PG8_BAR __builtin_amdgcn_s_barrier()
#define PG8_SCHED __builtin_amdgcn_sched_barrier(0)
    Unit cur, nxt; int ui = 0;
    if (!S.next(0, cur)) return;
    f32x4 acc[2][2][4][2];
#pragma unroll
    for (int a = 0; a < 2; ++a)
#pragma unroll
        for (int b = 0; b < 2; ++b)
#pragma unroll
            for (int m = 0; m < 4; ++m)
#pragma unroll
                for (int n = 0; n < 2; ++n) acc[a][b][m][n] = (f32x4){0.f, 0.f, 0.f, 0.f};
    bf16x8 At[4][2], B0[2][2], B1[2][2];
    const char* cA = (const char*)g.A + (size_t)cur.pm * tstep; const char* cB = (const char*)g.Bt + (size_t)cur.pn * tstep;
    S.a_ready(cur);
    if constexpr (SP2) {
        PG8_STAGE(PG8_SB(0, 0), cB, voffB); PG8_STAGE(PG8_SB(0, 1), cB + hstep, voffB); PG8_STAGE(PG8_SA(0, 0), cA, voffA); PG8_STAGE(PG8_SA(0, 1), cA + hstep, voffA);
        if (wr == 1) PG8_BAR;
        PG8_WAIT_V(2); PG8_BAR;
        PG8_STAGE(PG8_SB(1, 0), cB + kstep, voffB); PG8_STAGE(PG8_SA(1, 0), cA + kstep, voffA); PG8_STAGE(PG8_SB(1, 1), cB + hstep + kstep, voffB);
        PG8_WAIT_V(6); PG8_BAR;
    } else {
        PG8_STAGE(PG8_SB(0, 0), cB, voffB); PG8_STAGE(PG8_SA(0, 0), cA, voffA); PG8_STAGE(PG8_SB(0, 1), cB + hstep, voffB); PG8_STAGE(PG8_SA(0, 1), cA + hstep, voffA);
        if (wr == 1) PG8_BAR;
        PG8_WAIT_V(4); PG8_BAR;
        PG8_STAGE(PG8_SB(1, 0), cB + kstep, voffB); PG8_STAGE(PG8_SA(1, 0), cA + kstep, voffA); PG8_STAGE(PG8_SB(1, 1), cB + hstep + kstep, voffB);
        PG8_WAIT_V(6); PG8_BAR;
    }
    for (;;) {
        const bool has_next = S.next(ui + 1, nxt);
        const char* nA = has_next ? (const char*)g.A + (size_t)nxt.pm * tstep : cA; const char* nB = has_next ? (const char*)g.Bt + (size_t)nxt.pn * tstep : cB;
        for (int t = 0; t < nt; t += 2) {
            const bool last = (t == nt - 2);
            const char* a1 = cA + (size_t)(t + 1) * kstep;
            const char* a2 = last ? nA : cA + (size_t)(t + 2) * kstep; const char* b2 = last ? nB : cB + (size_t)(t + 2) * kstep;
            const char* a3 = a2 + kstep; const char* b3 = b2 + kstep;
            if (last && has_next) S.a_ready(nxt);
            if constexpr (SP2) {
            PG8_LDB(B0, 0, 0); PG8_LDB(B1, 0, 1); PG8_SCHED; PG8_LDA(At, 0, 0); PG8_STAGE(PG8_SA(1, 1), a1 + hstep, voffA);
            PG8_WAIT_V(8); PG8_WAIT_L(0); PG8_BAR; PG8_MMA(0, 0, At, B0); PG8_MMA(0, 1, At, B1); PG8_BAR; PG8_SCHED;
            PG8_LDA(At, 0, 1); PG8_STAGE(PG8_SB(0, 0), b2, voffB); PG8_STAGE(PG8_SB(0, 1), b2 + hstep, voffB); PG8_STAGE(PG8_SA(0, 0), a2, voffA);
            PG8_WAIT_V(8); PG8_WAIT_L(0); PG8_BAR; PG8_MMA(1, 0, At, B0); PG8_MMA(1, 1, At, B1); PG8_BAR; PG8_SCHED;
            PG8_LDB(B0, 1, 0); PG8_LDB(B1, 1, 1); PG8_SCHED; PG8_LDA(At, 1, 0); PG8_STAGE(PG8_SA(0, 1), a2 + hstep, voffA);
            PG8_WAIT_V(8); PG8_WAIT_L(0); PG8_BAR; PG8_MMA(0, 0, At, B0); PG8_MMA(0, 1, At, B1); PG8_BAR; PG8_SCHED;
            PG8_LDA(At, 1, 1); PG8_STAGE(PG8_SB(1, 0), b3, voffB); PG8_STAGE(PG8_SB(1, 1), b3 + hstep, voffB); PG8_STAGE(PG8_SA(1, 0), a3, voffA);
            PG8_WAIT_V(8); PG8_WAIT_L(0); PG8_BAR; PG8_MMA(1, 0, At, B0); PG8_MMA(1, 1, At, B1); PG8_BAR; PG8_SCHED;
            } else {
            PG8_LDB(B0, 0, 0); PG8_SCHED; PG8_LDA(At, 0, 0); PG8_STAGE(PG8_SA(1, 1), a1 + hstep, voffA);
            PG8_WAIT_L(8); PG8_BAR; PG8_WAIT_L(0); PG8_MMA(0, 0, At, B0); PG8_BAR; PG8_SCHED;
            PG8_LDB(B1, 0, 1); PG8_STAGE(PG8_SB(0, 0), b2, voffB);
            PG8_BAR; PG8_WAIT_L(0); PG8_MMA(0, 1, At, B1); PG8_BAR;
            PG8_LDA(At, 0, 1); PG8_STAGE(PG8_SA(0, 0), a2, voffA);
            PG8_BAR; PG8_WAIT_L(0); PG8_MMA(1, 0, At, B0); PG8_BAR; PG8_SCHED;
            PG8_STAGE(PG8_SB(0, 1), b2 + hstep, voffB);
            PG8_WAIT_V(6); PG8_BAR; PG8_MMA(1, 1, At, B1); PG8_BAR;
            PG8_LDB(B0, 1, 0); PG8_SCHED; PG8_LDA(At, 1, 0); PG8_STAGE(PG8_SA(0, 1), a2 + hstep, voffA);
            PG8_WAIT_L(8); PG8_BAR; PG8_WAIT_L(0); PG8_MMA(0, 0, At, B0); PG8_BAR; PG8_SCHED;
            PG8_LDB(B1, 1, 1); PG8_STAGE(PG8_SB(1, 0), b3, voffB);
            PG8_BAR; PG8_WAIT_L(0); PG8_MMA(0, 1, At, B1); PG8_BAR;
            PG8_LDA(At, 1, 1); PG8_STAGE(PG8_SA(1, 0), a3, voffA);
            PG8_BAR; PG8_WAIT_L(0); PG8_MMA(1, 0, At, B0); PG8_BAR; PG8_SCHED;
            PG8_STAGE(PG8_SB(1, 1), b3 + hstep, voffB);
            PG8_WAIT_V(6); PG8_BAR; PG8_MMA(1, 1, At, B1); PG8_BAR;
            }
        }
        if constexpr (ALIGN_EPI) { if (wr == 0) PG8_BAR; }
        if constexpr (!Epi::AFTER_DRAIN) { E(acc, cur, wr, wc, fr, fq); S.done(cur); }
        if (!has_next) break;
#pragma unroll
        for (int a = 0; a < 2; ++a)
#pragma unroll
            for (int b = 0; b < 2; ++b)
#pragma unroll
                for (int m = 0; m < 4; ++m)
#pragma unroll
                    for (int n = 0; n < 2; ++n) acc[a][b][m][n] = (f32x4){0.f, 0.f, 0.f, 0.f};
        cur = nxt; cA = nA; cB = nB; ++ui;
        if constexpr (ALIGN_EPI) { if (wr == 1) PG8_BAR; }
    }
    PG8_WAIT_V(0);
    if constexpr (!ALIGN_EPI) { if (wr == 0) PG8_BAR; }
    PG8_BAR;
    if constexpr (Epi::AFTER_DRAIN) { E.fused(acc, cur, wr, wc, fr, fq, lds, wid, lane); S.done(cur); }
#undef PG8_SA
#undef PG8_SB
#undef PG8_STAGE
#undef PG8_LDA
#undef PG8_LDB
#undef PG8_MMA
#undef PG8_WAIT_V
#undef PG8_WAIT_L
#undef PG8_BAR
#undef PG8_SCHED
}
}

struct EpiProjT {
    static constexpr bool PERM = true, AFTER_DRAIN = false;
    const Params* p; int l;
    __device__ __forceinline__ void operator()(const f32x4 (&acc)[2][2][4][2], const pg8::Unit& u, int wr, int wc, int fr, int fq) const {
#pragma unroll
        for (int ai = 0; ai < 2; ++ai)
#pragma unroll
            for (int m = 0; m < 4; ++m) {
                const int row = u.pm * 256 + ai * 128 + wr * 64 + m * 16 + fr;
                const float rstd = 1.0f / sqrtf(p->sumsq[row] / (float)D + EPS);
                const float* sw = p->sW + ((size_t)l * NCOND + cond_of(row)) * NPAD;
#pragma unroll
                for (int bj = 0; bj < 2; ++bj) {
                    const int c0 = u.pn * 256 + bj * 128 + wc * 32 + 8 * fq;
                    const f32x4 v0 = acc[ai][bj][m][0] * rstd + *(const f32x4*)(sw + c0), v1 = acc[ai][bj][m][1] * rstd + *(const f32x4*)(sw + c0 + 4);
                    const u32x2 w0 = pack4(v0), w1 = pack4(v1);
                    *(u32x4*)(p->proj + (size_t)row * NPROJ + c0) = (u32x4){w0.x, w0.y, w1.x, w1.y};
                }
            }
    }
};
struct EpiOutT {
    static constexpr bool PERM = true, AFTER_DRAIN = false;
    const Params* p; int l;
    __device__ __forceinline__ void operator()(const f32x4 (&acc)[2][2][4][2], const pg8::Unit& u, int wr, int wc, int fr, int fq) const {
#pragma unroll
        for (int ai = 0; ai < 2; ++ai)
#pragma unroll
            for (int m = 0; m < 4; ++m) {
                const int row = u.pm * 256 + ai * 128 + wr * 64 + m * 16 + fr; const int cnd = cond_of(row);
                const float* gt = p->ada + ((size_t)l * NCOND + cnd) * 3 * D + 2 * D; const float* xr = xrow_in(*p, 0, row);
                float ss = 0.f;
#pragma unroll
                for (int bj = 0; bj < 2; ++bj) {
                    const int c0 = u.pn * 256 + bj * 128 + wc * 32 + 8 * fq;
                    f32x4 xi0, xi1;
                    if (l == 0) { xi0 = *(const f32x4*)(xr + c0); xi1 = *(const f32x4*)(xr + c0 + 4); }
                    else { const u32x4 xw = *(const u32x4*)(p->xb + (size_t)row * D + c0); xi0 = unpack4((u32x2){xw.x, xw.y}); xi1 = unpack4((u32x2){xw.z, xw.w}); }
                    const f32x4 x0 = xi0 + *(const f32x4*)(gt + c0) * acc[ai][bj][m][0], x1 = xi1 + *(const f32x4*)(gt + c0 + 4) * acc[ai][bj][m][1];
                    ss += x0[0] * x0[0] + x0[1] * x0[1] + x0[2] * x0[2] + x0[3] * x0[3] + x1[0] * x1[0] + x1[1] * x1[1] + x1[2] * x1[2] + x1[3] * x1[3];
                    if (l + 1 < DEPTH) {
                        const u32x2 b0 = pack4(x0), b1 = pack4(x1);
                        *(u32x4*)(p->xb + (size_t)row * D + c0) = (u32x4){b0.x, b0.y, b1.x, b1.y};
                        const float* gs = p->gsv + ((size_t)(l + 1) * NCOND + cnd) * D + c0;
                        const u32x2 w0 = pack4(x0 * *(const f32x4*)gs), w1 = pack4(x1 * *(const f32x4*)(gs + 4));
                        *(u32x4*)(p->xg + (size_t)row * D + c0) = (u32x4){w0.x, w0.y, w1.x, w1.y};
                    } else { *(f32x4*)(p->out + (size_t)row * D + c0) = x0; *(f32x4*)(p->out + (size_t)row * D + c0 + 4) = x1; }
                }
                ss += __shfl_xor(ss, 16); ss += __shfl_xor(ss, 32);
                if (fq == 0) atomicAdd(p->sumsq + row, ss);
            }
    }
};
#endif
__device__ __forceinline__ void gates_body(const Params& p, int l, const Ctx& c) {
    const int lane = c.lane, wave = c.wave;
    float* red = (float*)c.smem;
    constexpr int KQ = D / 4;
    for (int _k = 0, _b; (_b = item_base<2>(c, _k, NTOK / 32)) >= 0; ++_k) {
        int it = _b + (c.vb & 1); if (it >= NTOK / 32) it = NTOK / 32 - 1;
        f32x4 acc[1][2]; zero_acc(acc);
        mma_tiles_pf<1, 2, KQ / 32, true, true>(acc, p.winT + ((size_t)l * NPAD + NPROJ) * D + wave * KQ, D, p.xg + (size_t)it * 32 * D + wave * KQ, D, lane);
        BLOCK_SYNC();
#pragma unroll
        for (int nt = 0; nt < 2; ++nt) *(f32x4*)(red + (wave * 32 + nt * 16 + (lane & 15)) * 16 + (lane >> 4) * 4) = acc[0][nt];
        BLOCK_SYNC();
        if (wave < 2) {
            const int tk = wave * 16 + (lane & 15), g0 = (lane >> 4) * 4, row = it * 32 + tk;
            const f32x4 s = *(const f32x4*)(red + (0 * 32 + tk) * 16 + g0) + *(const f32x4*)(red + (1 * 32 + tk) * 16 + g0) + *(const f32x4*)(red + (2 * 32 + tk) * 16 + g0) + *(const f32x4*)(red + (3 * 32 + tk) * 16 + g0);
            const float rstd = 1.0f / sqrtf(p.sumsq[row] / (float)D + EPS);
            *(f32x4*)(p.gates + (size_t)row * 16 + g0) = s * rstd + *(const f32x4*)(p.sW + ((size_t)l * NCOND + cond_of(row)) * NPAD + NPROJ + g0);
        }
    }
}

enum { PH_PREP = 0, PH_PREP2, PH_GEMM_IN, PH_DN1, PH_CHAIN, PH_W0, PH_W1, PH_W2, PH_W3, PH_D3, PH_GEMM_OUT, PH_FINAL };
__device__ __forceinline__ int n_chain_wgs() { return gridDim.x >= 64 ? DEC_BATCH * 16 : (int)gridDim.x / 2; }
__device__ __forceinline__ Ctx make_ctx(char* smem) {
    Ctx c; const int hb = UNIFORM((int)(threadIdx.x >> 8));
    c.tid = threadIdx.x & 255; c.lane = c.tid & 63; c.wave = UNIFORM(c.tid >> 6); const int G = gridDim.x, bx = blockIdx.x; const int vcu = (G % 8 == 0) ? (bx % 8) * (G / 8) + bx / 8 : bx;
    c.vb = vcu * 2 + hb; c.nvb = G * 2; c.smem = smem + hb * HALF_LDS; c.q = nullptr; c.qslot = (unsigned*)(smem + 2 * HALF_LDS + 16);
    return c;
}
__device__ __forceinline__ Ctx shifted(const Ctx& c, int by) { Ctx s = c; s.vb = (c.vb + c.nvb - (by % c.nvb)) % c.nvb; return s; }
#if defined(PROBE_SUB) && !defined(EMU)
#define SUBT(k, ...) do { const unsigned long long _s0 = __builtin_amdgcn_s_memrealtime(); __VA_ARGS__; if ((k) == PROBE_SUB && blockIdx.x == PROBE_TB && threadIdx.x == 0) p.bar[200] += (unsigned)(__builtin_amdgcn_s_memrealtime() - _s0); } while (0)
#else
#define SUBT(k, ...) do { __VA_ARGS__; } while (0)
#endif
__device__ __forceinline__ void run_phase(const Params& p, int ph, int l, const Ctx& c0) {
    Ctx c = c0;
    { int t_ = threadIdx.x; LAUNDER_V(t_); c.tid = t_ & 255; }
    c.lane = c.tid & 63; c.wave = UNIFORM(c.tid >> 6); LAUNDER_S(c.vb); LAUNDER_S(l);
    const int ncb = n_chain_wgs();
    Ctx w = c; w.vb = c.vb - 2 * ncb; w.nvb = c.nvb - 2 * ncb;
    unsigned* const qb = p.bar + 8192 + (size_t)l * 16 * 16;
#define WQ(k) (w.q = qb + (k) * 16, w)
    switch (ph) {
    case PH_PREP:
        for (size_t i = (size_t)c.vb * 256 + c.tid; i < (size_t)DEPTH * NCOND * NPAD; i += (size_t)c.nvb * 256) p.sW[i] = 0.f;
        prep_weights_body(p, (size_t)c.vb * 256 + c.tid, (size_t)c.nvb * 256); prep_tiled_body(p, c); break;
    case PH_PREP2: prep2_body(p, c); break;
    case PH_GEMM_IN: {
#ifdef EMU
        EpiProj e{&p, l}; const XSrc xs{p.xg, D, &p, l}; gemm_body<128, 0>(xs, p.winT + (size_t)l * NPAD * D, D, NTOK, NPROJ, D, e, c);
#else
        const pg8::Gemm g{p.xg, p.winT + (size_t)l * NPAD * D, NTOK, NPROJ, D}; pg8::StaticOrder S; S.init(NTOK, NPROJ, (int)gridDim.x, (int)blockIdx.x);
        EpiProjT e{&p, l}; pg8::gemm_phase<EpiProjT, pg8::StaticOrder, true, true>((PG8_LAS unsigned char*)(c.smem - (c.vb & 1) * HALF_LDS), g, S, e);
#endif
        BLOCK_SYNC();
        gates_body(p, l, c);
    } break;
    case PH_DN1:
        { int st_ = c.nvb * 256; LAUNDER_S(st_);
          for (int i = c.vb * 256 + c.tid; i < NTOK; i += st_) p.sumsq[i] = 0.f; }
        dn_d1_body(p, l, c); break;
    case PH_CHAIN: dn_scan_body(p, l, c, BATCH * 8, NSEQ * 8, c.vb >> 1, ncb); break;
    case PH_W0:
        SUBT(1, pool_body(p, l, WQ(0))); BLOCK_SYNC();
        SUBT(3, ft_latA_body(p, WQ(1))); BLOCK_SYNC();
        SUBT(2, ft_ctx_body(p, WQ(2))); BLOCK_SYNC();
        SUBT(0, dn_scan_body(p, l, WQ(3), 0, BATCH * 8, 0, 1)); BLOCK_SYNC();
        SUBT(4, s5_pass1_body(p, l, WQ(4)));
        break;
    case PH_W1:
        w.q = nullptr;
        SUBT(5, ft_latB_body(p, w)); BLOCK_SYNC();
        SUBT(6, s5_carry_body(p, l, shifted(w, DEC_BATCH * 128)));
        break;
    case PH_W2: {
        SUBT(7, s5_pass3_body(p, l, WQ(7))); BLOCK_SYNC();
        EpiFt ef{&p}; const XSrc xs{p.fbuf, 256, &p, l}; SUBT(8, (gemm_body<128, 0>(xs, p.ftwT + (size_t)l * 65536, 256, NTOK, 256, 256, ef, WQ(8))));
    } break;
    case PH_W3: { EpiGlu eg{&p, l}; const XSrc xs{p.ybuf, 256, &p, l}; gemm_body<64, 0>(xs, p.gluT + (size_t)l * 65536, 256, NTOK, 256, 256, eg, WQ(9)); } break;
    case PH_GEMM_OUT: {
#ifdef EMU
        EpiOut e{&p, l}; const XSrc xs{p.mix, DMIX, &p, l}; gemm_body<OUT_TOK, 0>(xs, p.woutT + (size_t)l * D * DMIX, DMIX, NTOK, D, DMIX, e, c);
#else
        const pg8::Gemm g{p.mix, p.woutT + (size_t)l * D * DMIX, NTOK, D, DMIX}; pg8::StaticOrder S; S.init(NTOK, D, (int)gridDim.x, (int)blockIdx.x);
        EpiOutT e{&p, l}; pg8::gemm_phase<EpiOutT, pg8::StaticOrder, true, true>((PG8_LAS unsigned char*)(c.smem - (c.vb & 1) * HALF_LDS), g, S, e);
#endif
    } break;
    case PH_D3: {
        constexpr int GLU_TILES = (NTOK / 64) * 2;
        Ctx dc = c, gc = c; bool do_dn = true, do_gemm = true;
        if (c.nvb * 3 == GLU_TILES * 4) {
            const int vcu = c.vb >> 1, hb = c.vb & 1, a = vcu >> 2, b = vcu & 3;
            if (b == 3) { dc.vb = a * 2 + hb; dc.nvb = c.nvb / 4; do_gemm = false; }
            else { gc.vb = (3 * a + b) * 2 + hb; gc.nvb = GLU_TILES; do_dn = false; }
        } else if (c.nvb - GLU_TILES >= 64) {
            if (c.vb >= GLU_TILES) { dc.vb = c.vb - GLU_TILES; dc.nvb = c.nvb - GLU_TILES; } else do_dn = false;
        }
        if (do_dn) dn_d3_body(p, l, dc);
        BLOCK_SYNC();
        EpiGlu eg{&p, l}; const XSrc xs{p.ybuf, 256, &p, l};
        if (do_gemm) gemm_body<64, 0>(xs, p.gluT + (size_t)l * 65536, 256, NTOK, 256, 256, eg, gc);
    } break;
    case PH_FINAL: final_norm_body(p, c); break;
    }
}
__host__ __device__ inline size_t ws_carve(Params& p, char* ws) {
    size_t off = 0;
    auto take = [&](size_t bytes) { size_t o = off; off += (bytes + 255) & ~(size_t)255; return ws ? ws + o : (char*)nullptr; };
    p.bar = (unsigned*)take(65536);
    p.winT = (bf16*)take((size_t)DEPTH * NPAD * D * 2);
    p.woutT = (bf16*)take((size_t)DEPTH * D * DMIX * 2);
    p.ftwT = (bf16*)take((size_t)DEPTH * 65536 * 2);
    p.gluT = (bf16*)take((size_t)DEPTH * 65536 * 2);
    p.poolwT = (bf16*)take((size_t)DEPTH * 4 * 4096 * 2);
    p.Cmat = (bf16*)take((size_t)DEPTH * 16 * 4096 * 2);
    p.tabDc = (bf16*)take(128 * 64 * 2);
    p.tabE = (bf16*)take(128 * 128 * 2);
    p.tabT = (bf16*)take((size_t)SEQ * 2 * SEQ * 2);
    p.ada = (float*)take((size_t)DEPTH * NCOND * 3 * D * 4);
    p.abar = (float*)take((size_t)DEPTH * 2 * 16 * 64 * 2 * 4);
    p.abar64 = (float*)take((size_t)DEPTH * 2 * 16 * 64 * 2 * 4);
    p.bbar = (float*)take((size_t)DEPTH * 2 * 16 * 64 * 32 * 4);
    p.bbarT = (bf16*)take((size_t)DEPTH * 2 * 16 * 128 * 16 * 2);
    p.hbuf = (bf16*)take((size_t)NTOK * DMIX * 2);
    p.mix = p.hbuf;
    p.proj = (bf16*)take((size_t)NTOK * NPROJ * 2);
    p.fbuf = (bf16*)take((size_t)NTOK * 256 * 2);
    p.ybuf = (bf16*)take((size_t)NTOK * 256 * 2);
    p.obuf = (bf16*)take((size_t)2 * NTOK * 256 * 2);
    p.Zg = (bf16*)take((size_t)DEC_BATCH * 64 * 256 * 128 * 2);
    p.dnAp = (bf16*)take((size_t)NCH * 8 * 4096 * 2);
    p.dnQh = (bf16*)take((size_t)NCH * 8 * 4096 * 2);
    p.dnBT = (bf16*)take((size_t)NCH * 8 * 4096 * 2);
    p.dnOT = (bf16*)take((size_t)NCH * 8 * 4096 * 2);
    p.gates = (float*)take((size_t)NTOK * 16 * 4);
    p.dnEgl = (float*)take((size_t)NCH * 8 * 4);
    p.s5E = (float*)take((size_t)NCH * 16 * 2 * 128 * 4);
    p.s5S = (float*)take((size_t)NCH * 16 * 2 * 128 * 4);
    p.sumsq = (float*)take((size_t)NTOK * 4);
    p.gsv = (float*)take((size_t)DEPTH * NCOND * D * 4);
    p.sW = (float*)take((size_t)DEPTH * NCOND * NPAD * 4);
    p.xg = (bf16*)take((size_t)NTOK * D * 2);
    p.xb = (bf16*)take((size_t)NTOK * D * 2);
    return off;
}

struct KArgs { const float* in[29]; float* out; char* ws; };
__device__ __forceinline__ void build_params(Params& p, const KArgs& a) {
    const float** ip = (const float**)&p;
#pragma unroll
    for (int i = 0; i < 29; ++i) ip[i] = a.in[i];
    p.out = a.out; (void)ws_carve(p, a.ws);
}
#ifndef EMU
#define XB_TMO      128
#define XB_XCNT(j)  (256  + 64 * (j))
#define XB_XSUB(j)  (1280 + 64 * (j))
#define XB_XGEN(j)  (2304 + 64 * (j))
#define XB_TOP      3328
#define XB_TOPGEN   3392
#define XCD_BAR_WORDS 3456
#define XB_SPIN_CAP (1u << 18)
#define LAS __attribute__((address_space(3)))
__device__ __forceinline__ unsigned xb_ld(unsigned* p)              { return __hip_atomic_load(p, __ATOMIC_RELAXED, __HIP_MEMORY_SCOPE_AGENT); }
__device__ __forceinline__ unsigned xb_add(unsigned* p, unsigned v) { return __hip_atomic_fetch_add(p, v, __ATOMIC_RELAXED, __HIP_MEMORY_SCOPE_AGENT); }
__device__ __forceinline__ unsigned xb_xcc_id() { return (unsigned)__builtin_amdgcn_s_getreg((3 << 11) | 20) & 0xFu; }
#define XB_SPIN(cond, bar) do { unsigned _sp = 0; while (cond) { __builtin_amdgcn_s_sleep(1); \
    if ((++_sp & 255u) == 0u) { if (xb_ld(&(bar)[XB_TMO])) break; if (_sp > XB_SPIN_CAP) { atomicAdd(&(bar)[XB_TMO], 1u); break; } } } } while (0)
struct XcdBarrier { unsigned* bar; unsigned x; volatile LAS unsigned* st; unsigned G; };
__device__ __forceinline__ XcdBarrier xcd_barrier_post(unsigned* bar, volatile LAS unsigned* st, unsigned G) {
    XcdBarrier b; b.bar = bar; b.x = xb_xcc_id(); b.st = st; b.G = G;
    if (threadIdx.x == 0) (void)xb_add(&bar[XB_XCNT(b.x)], 1u);
    return b;
}
__device__ __forceinline__ void xcd_barrier_complete(unsigned* bar, unsigned x, unsigned G, unsigned& nloc, unsigned& nx) {
    unsigned sum, cnt, mine, sp = 0u;
    for (;;) {
        sum = 0u; cnt = 0u; mine = 0u;
#pragma unroll
        for (unsigned j = 0; j < 16; ++j) { const unsigned c = xb_ld(&bar[XB_XCNT(j)]); sum += c; cnt += (c > 0u) ? 1u : 0u; mine = (j == x) ? c : mine; }
        if (sum == G) break;
        __builtin_amdgcn_s_sleep(1);
        if ((++sp & 255u) == 0u) { if (xb_ld(&bar[XB_TMO])) break; if (sp > XB_SPIN_CAP) { atomicAdd(&bar[XB_TMO], 1u); break; } }
    }
    nloc = mine > 0u ? mine : 1u; nx = cnt > 0u ? cnt : 1u;
}
__device__ __forceinline__ void xcd_barrier(const XcdBarrier& b) {
    asm volatile("s_waitcnt vmcnt(0)" ::: "memory");
    __syncthreads();
    if (threadIdx.x == 0) {
        unsigned* bar = b.bar; unsigned bx_ = b.x;
        asm volatile("" : "+s"(bx_));
        __builtin_amdgcn_s_waitcnt(0);
        unsigned nloc = b.st[0], nx = b.st[1];
        if (nloc == 0u) { xcd_barrier_complete(bar, bx_, b.G, nloc, nx); b.st[0] = nloc; b.st[1] = nx; }
        const unsigned old = xb_add(&bar[XB_XSUB(bx_)], 1u);
        const unsigned gen = old / nloc;
        if (old + 1u == (gen + 1u) * nloc) {
            __builtin_amdgcn_fence(__ATOMIC_RELEASE, "agent");
            asm volatile("s_waitcnt vmcnt(0)" ::: "memory");
            const unsigned og = xb_add(&bar[XB_TOP], 1u);
            const unsigned tg = og / nx;
            if (og + 1u == (tg + 1u) * nx) xb_add(&bar[XB_TOPGEN], 1u);
            else XB_SPIN(xb_ld(&bar[XB_TOPGEN]) == tg, bar);
            __builtin_amdgcn_fence(__ATOMIC_ACQUIRE, "agent");
            xb_add(&bar[XB_XGEN(bx_)], 1u);
            asm volatile("s_waitcnt vmcnt(0)" ::: "memory");
        } else {
            XB_SPIN(xb_ld(&bar[XB_XGEN(bx_)]) == gen, bar);
            __builtin_amdgcn_fence(__ATOMIC_ACQUIRE, "agent");
            asm volatile("s_waitcnt vmcnt(0)" ::: "memory");
        }
    }
    __syncthreads();
}
#endif
constexpr int MEGA_LDS = 2 * HALF_LDS + 32;
#ifdef EMU
__global__ void __launch_bounds__(512) k_phase(Params p, int ph, int l) {
    DYN_LDS(smem); const Ctx c = make_ctx(smem); const bool worker = (c.vb >> 1) >= n_chain_wgs();
    if (ph == PH_CHAIN && worker) return;
    if (ph >= PH_W0 && ph <= PH_W3 && ph != PH_W2 && !worker) return;
    run_phase(p, ph, l, c);
}
#else
__global__ void __launch_bounds__(512) k_mega(KArgs ka) {
    DYN_LDS(smem);
    Params p; build_params(p, ka);
    volatile LAS unsigned* st = (volatile LAS unsigned*)(smem + 2 * HALF_LDS);
    if (threadIdx.x < 4) st[threadIdx.x] = 0u;
    __syncthreads();
    const int ncb = n_chain_wgs();
    const Ctx c = make_ctx(smem);
    const bool worker = (c.vb >> 1) >= ncb;
    const XcdBarrier bar = xcd_barrier_post(p.bar, st, gridDim.x);
    XcdBarrier wbar = bar;
    if (worker) wbar = xcd_barrier_post(p.bar + 4096, st + 2, gridDim.x - ncb);
#define GRID_SYNC() xcd_barrier(bar)
#define WORKER_SYNC() xcd_barrier(wbar)
#ifdef PROBE_TID
    unsigned long long t_acc = 0;
#define TIMED(ph, ...) do { const unsigned long long _t0 = __builtin_amdgcn_s_memrealtime(); __VA_ARGS__; if ((ph) == PROBE_TID) t_acc += __builtin_amdgcn_s_memrealtime() - _t0; } while (0)
#else
#define TIMED(ph, ...) do { __VA_ARGS__; } while (0)
#endif
    TIMED(PH_PREP, run_phase(p, PH_PREP, 0, c); GRID_SYNC());
    TIMED(PH_PREP2, run_phase(p, PH_PREP2, 0, c); GRID_SYNC());
#pragma unroll 1
    for (int l = 0; l < DEPTH; ++l) {
        TIMED(PH_GEMM_IN, run_phase(p, PH_GEMM_IN, l, c); GRID_SYNC());
        TIMED(PH_DN1, run_phase(p, PH_DN1, l, c); GRID_SYNC());
        if (!worker) {
            TIMED(PH_CHAIN, run_phase(p, PH_CHAIN, l, c));
            if (threadIdx.x == 0) {
                unsigned* wb = p.bar + 4096; const unsigned need = 2u * (unsigned)l + 2u;
                XB_SPIN(xb_ld(&wb[XB_TOPGEN]) < need, wb);
                __builtin_amdgcn_fence(__ATOMIC_ACQUIRE, "agent");
                asm volatile("s_waitcnt vmcnt(0)" ::: "memory");
            }
            __syncthreads();
            TIMED(PH_W2, run_phase(p, PH_W2, l, c));
        }
        else {
#ifdef PROBE_NOWSYNC
            TIMED(PH_W0, run_phase(p, PH_W0, l, c)); WORKER_SYNC();
#else
            TIMED(PH_W0, run_phase(p, PH_W0, l, c); WORKER_SYNC());
#endif
            TIMED(PH_W1, run_phase(p, PH_W1, l, c); WORKER_SYNC());
            TIMED(PH_W2, run_phase(p, PH_W2, l, c));
        }
        TIMED(PH_D3, GRID_SYNC(); run_phase(p, PH_D3, l, c); GRID_SYNC());
        TIMED(PH_GEMM_OUT, run_phase(p, PH_GEMM_OUT, l, c); GRID_SYNC());
    }
    TIMED(PH_FINAL, run_phase(p, PH_FINAL, 0, c));
#ifdef PROBE_SUB
    if (blockIdx.x == PROBE_TB && threadIdx.x == 0) t_acc = p.bar[200];
#endif
#ifdef PROBE_TID
    if (blockIdx.x == PROBE_TB && threadIdx.x == 0) { const unsigned long long t1 = __builtin_amdgcn_s_memrealtime(); while (__builtin_amdgcn_s_memrealtime() - t1 < (unsigned long long)PROBE_TK * t_acc) __builtin_amdgcn_s_sleep(8); }
#endif
}
#endif

#ifdef EMU
void emu_hook(const char* tag, int l, const Params& p);
#define HOOK(tag, l) emu_hook(tag, l, p)
#endif
extern "C" void kernel_launch(void* const* d_in, const int* in_sizes, int n_in, void* d_out, int out_size, void* d_ws, size_t ws_size, hipStream_t stream) {
    Params p;
    memset(&p, 0, sizeof(p));
    const float** ip = (const float**)&p;
    for (int i = 0; i < 29; ++i) ip[i] = (const float*)d_in[i];
    p.out = (float*)d_out;
    const size_t need = ws_carve(p, (char*)d_ws);
    if (need > ws_size || n_in != 29) { fprintf(stderr, "kernel_launch: workspace %zu < %zu or n_in %d\n", ws_size, need, n_in); return; }
#ifdef EMU
    const int G = 6;
    memset(p.bar, 0, 65536);
    LAUNCH(k_phase, G, 512, MEGA_LDS, stream, p, (int)PH_PREP, 0);
    LAUNCH(k_phase, G, 512, MEGA_LDS, stream, p, (int)PH_PREP2, 0);
    for (int l = 0; l < DEPTH; ++l)
        for (int ph = PH_GEMM_IN; ph <= PH_GEMM_OUT; ++ph) {
            if (ph == PH_W3) continue;
            LAUNCH(k_phase, G, 512, MEGA_LDS, stream, p, ph, l);
            if (ph == PH_GEMM_IN) HOOK("proj", l);
            if (ph == PH_D3) HOOK("mix", l);
            if (ph == PH_GEMM_OUT) HOOK("xout", l);
        }
    LAUNCH(k_phase, G, 512, MEGA_LDS, stream, p, (int)PH_FINAL, 0);
#else
    static int grid = 0;
    if (!grid) {
        int dev = 0, cus = 0, per_cu = 0;
        (void)hipGetDevice(&dev);
        (void)hipDeviceGetAttribute(&cus, hipDeviceAttributeMultiprocessorCount, dev);
        (void)hipFuncSetAttribute((const void*)k_mega, hipFuncAttributeMaxDynamicSharedMemorySize, MEGA_LDS);
        (void)hipOccupancyMaxActiveBlocksPerMultiprocessor(&per_cu, (const void*)k_mega, 512, MEGA_LDS);
        if (per_cu < 1) { fprintf(stderr, "kernel_launch: occupancy query says %d blocks/CU\n", per_cu); per_cu = 1; }
        grid = cus * 1;
        fprintf(stderr, "kernel_launch: cus %d per_cu %d grid %d\n", cus, per_cu, grid);
    }
    (void)hipMemsetAsync(p.bar, 0, 65536, stream);
    KArgs ka; memset(&ka, 0, sizeof(ka));
    for (int i = 0; i < 29; ++i) ka.in[i] = (const float*)d_in[i];
    ka.out = (float*)d_out; ka.ws = (char*)d_ws;
    void* args[] = {&ka};
    hipError_t e = hipLaunchCooperativeKernel((const void*)k_mega, dim3(grid), dim3(512), args, MEGA_LDS, stream);
    if (e != hipSuccess) fprintf(stderr, "cooperative launch failed: %s (grid %d)\n", hipGetErrorString(e), grid);
#endif
}
```
